# Optimizing an MI355X kernel written in HIP

```python
import jax, jax.numpy as jnp
from jax import lax
import numpy as np

D_MODEL = 2048
BATCH = 4
SEQ = 2048
DEPTH = 2

D_MIX = D_MODEL
GM_HEADS = 8
GM_HEAD_DIM = D_MIX // 2 // GM_HEADS
GM_WIDTH = GM_HEADS * GM_HEAD_DIM
GM_CHUNK = 128
SSD_WIDTH = D_MIX - GM_WIDTH
SSD_HEAD_DIM = 64
SSD_HEADS = SSD_WIDTH // SSD_HEAD_DIM
SSD_GROUPS = 2
SSD_STATE = 128
SSD_CONV = 4
SSD_CHUNK = 128
SSD_CONV_DIM = SSD_WIDTH + 2 * SSD_GROUPS * SSD_STATE
IN_PROJ_DIM = 2 * GM_WIDTH + SSD_WIDTH + SSD_CONV_DIM + SSD_HEADS
N_EXPERTS = 64
N_EXPERT_GROUPS = 8
EXPERTS_PER_GROUP = N_EXPERTS // N_EXPERT_GROUPS
TOP_K = 2
D_EXPERT = 512
MOE_BLOCK = 128
EPS = 1e-6

kernel_name = 'hybrid_gmlp_ssd_moe_adaln'


def rms_norm(x, w):
    xf = x.astype(jnp.float32)
    y = xf * lax.rsqrt(jnp.mean(xf * xf, -1, keepdims=True) + EPS)
    return (y * w.astype(jnp.float32)).astype(x.dtype)


def layer_norm(x, w, b):
    xf = x.astype(jnp.float32)
    mu = jnp.mean(xf, -1, keepdims=True)
    var = jnp.mean(jnp.square(xf - mu), -1, keepdims=True)
    y = (xf - mu) * lax.rsqrt(var + EPS) * w.astype(jnp.float32) + b.astype(jnp.float32)
    return y.astype(x.dtype)


def gmlp_spatial_gating(u, v, ln_w, ln_b, w_s, b_s):
    bsz, seq, _ = u.shape
    nc = seq // GM_CHUNK
    u = jax.nn.gelu(u, approximate=False)
    v = jax.nn.gelu(v, approximate=False).reshape(bsz, seq, GM_HEADS, GM_HEAD_DIM)
    v = layer_norm(v, ln_w.reshape(GM_HEADS, GM_HEAD_DIM), ln_b.reshape(GM_HEADS, GM_HEAD_DIM))
    v = v.reshape(bsz, nc, GM_CHUNK, GM_HEADS, GM_HEAD_DIM)
    causal = jnp.tril(jnp.ones((GM_CHUNK, GM_CHUNK), dtype=bool))
    w = jnp.where(causal[None], w_s, 0).astype(v.dtype)
    s = jnp.einsum('hts,bcshp->bcthp', w, v) + b_s.T.astype(v.dtype)[None, None, :, :, None]
    return u * s.reshape(bsz, seq, GM_WIDTH)


def causal_depthwise_conv(x, w, b):
    k = w.shape[0]
    y = lax.conv_general_dilated(x, w[:, None, :].astype(x.dtype), window_strides=(1,),
                                 padding=[(k - 1, 0)], dimension_numbers=('NWC', 'WIO', 'NWC'),
                                 feature_group_count=x.shape[-1])
    return y + b.astype(x.dtype)


def segsum_exp(a):
    cs = jnp.cumsum(a, -1)
    diff = cs[..., :, None] - cs[..., None, :]
    mask = jnp.tril(jnp.ones((a.shape[-1], a.shape[-1]), dtype=bool))
    return jnp.where(mask, jnp.exp(jnp.where(mask, diff, 0.0)), 0.0)


def ssd_scan(x, dt, a, bm, cm):
    out_dtype = x.dtype
    bsz, seq = x.shape[:2]
    nc = seq // SSD_CHUNK
    hpg = SSD_HEADS // SSD_GROUPS
    x = x.astype(jnp.float32); dt = dt.astype(jnp.float32)
    a = a.astype(jnp.float32)
    xd = (x * dt[..., None]).reshape(bsz, nc, SSD_CHUNK, SSD_GROUPS, hpg, SSD_HEAD_DIM)
    ad = (dt * a).reshape(bsz, nc, SSD_CHUNK, SSD_GROUPS, hpg).transpose(0, 1, 3, 4, 2)
    bm = bm.astype(jnp.float32).reshape(bsz, nc, SSD_CHUNK, SSD_GROUPS, SSD_STATE)
    cm = cm.astype(jnp.float32).reshape(bsz, nc, SSD_CHUNK, SSD_GROUPS, SSD_STATE)
    a_cs = jnp.cumsum(ad, -1)
    decay = segsum_exp(ad)
    cb = jnp.einsum('bclgn,bcsgn->bcgls', cm, bm)
    y_diag = jnp.einsum('bcgls,bcghls,bcsghp->bclghp', cb, decay, xd)
    decay_states = jnp.exp(a_cs[..., -1:] - a_cs)
    states = jnp.einsum('bclgn,bcghl,bclghp->bcghpn', bm, decay_states, xd)
    chunk_decay = jnp.exp(a_cs[..., -1])

    def step(carry, inp):
        st, dec = inp
        return carry * dec[..., None, None] + st, carry

    init = jnp.zeros((bsz, SSD_GROUPS, hpg, SSD_HEAD_DIM, SSD_STATE), jnp.float32)
    _, prev = lax.scan(step, init, (states.swapaxes(0, 1), chunk_decay.swapaxes(0, 1)))
    prev = prev.swapaxes(0, 1)
    y_off = jnp.einsum('bclgn,bcghpn,bcghl->bclghp', cm, prev, jnp.exp(a_cs))
    y = (y_diag + y_off).reshape(bsz, seq, SSD_HEADS, SSD_HEAD_DIM)
    return y.astype(out_dtype)


def gated_rms_norm(y, z, w):
    g = (y * jax.nn.silu(z)).astype(jnp.float32)
    shp = g.shape
    g = g.reshape(*shp[:-1], SSD_GROUPS, shp[-1] // SSD_GROUPS)
    g = g * lax.rsqrt(jnp.mean(g * g, -1, keepdims=True) + EPS)
    return (g.reshape(shp) * w.astype(jnp.float32)).astype(y.dtype)


def hybrid_mixer(h, w_in, w_out, gm_ln_w, gm_ln_b, gm_ws, gm_bs,
                 conv_w, conv_b, dt_bias, a_log, d_skip, ssd_norm_w):
    bsz, seq, _ = h.shape
    proj = h @ w_in
    c1 = GM_WIDTH
    c2 = 2 * GM_WIDTH
    c3 = c2 + SSD_WIDTH
    c4 = c3 + SSD_CONV_DIM
    u, v, z, xbc, dt = jnp.split(proj, [c1, c2, c3, c4], axis=-1)
    y_gm = gmlp_spatial_gating(u, v, gm_ln_w, gm_ln_b, gm_ws, gm_bs)
    xbc = jax.nn.silu(causal_depthwise_conv(xbc, conv_w, conv_b))
    xs, bm, cm = jnp.split(xbc, [SSD_WIDTH, SSD_WIDTH + SSD_GROUPS * SSD_STATE], axis=-1)
    dt = jax.nn.softplus((dt + dt_bias).astype(jnp.float32))
    a = -jnp.exp(a_log.astype(jnp.float32))
    xs = xs.reshape(bsz, seq, SSD_HEADS, SSD_HEAD_DIM)
    y = ssd_scan(xs, dt, a, bm.reshape(bsz, seq, SSD_GROUPS, SSD_STATE),
                 cm.reshape(bsz, seq, SSD_GROUPS, SSD_STATE))
    y = (y + d_skip[:, None].astype(y.dtype) * xs).reshape(bsz, seq, SSD_WIDTH)
    y_ssd = gated_rms_norm(y, z, ssd_norm_w)
    return jnp.concatenate([y_gm, y_ssd], axis=-1) @ w_out


def route(hf, router_w, router_b):
    t = hf.shape[0]
    scores = jax.nn.sigmoid((hf @ router_w).astype(jnp.float32))
    biased = scores + router_b.astype(jnp.float32)
    grp = biased.reshape(t, N_EXPERT_GROUPS, EXPERTS_PER_GROUP)
    grp_score = lax.top_k(grp, TOP_K)[0].sum(-1)
    g_idx = jnp.argmax(grp_score, -1)
    in_grp = jnp.take_along_axis(grp, g_idx[:, None, None], axis=1)[:, 0]
    _, local = lax.top_k(in_grp, TOP_K)
    e_idx = g_idx[:, None] * EXPERTS_PER_GROUP + local
    w = jnp.take_along_axis(scores, e_idx, axis=1)
    w = w / jnp.sum(w, -1, keepdims=True)
    return e_idx, w


def moe_ffn(h, router_w, router_b, w_gate, w_up, w_down):
    bsz, seq, d = h.shape
    t = bsz * seq
    hf = h.reshape(t, d)
    e_idx, gate_w = route(hf, router_w, router_b)
    n_slots = t * TOP_K
    e_flat = e_idx.reshape(-1)
    tok_flat = jnp.arange(n_slots, dtype=jnp.int32) // TOP_K
    w_flat = gate_w.reshape(-1)
    order = jnp.argsort(e_flat)
    e_sorted = e_flat[order]
    tok_sorted = tok_flat[order]
    w_sorted = w_flat[order]
    counts = jnp.zeros((N_EXPERTS,), jnp.int32).at[e_flat].add(1)
    padded = (counts + MOE_BLOCK - 1) // MOE_BLOCK * MOE_BLOCK
    start = jnp.cumsum(counts) - counts
    pend = jnp.cumsum(padded)
    pstart = pend - padded
    dest = pstart[e_sorted] + jnp.arange(n_slots, dtype=jnp.int32) - start[e_sorted]
    n_blocks = -(-n_slots // MOE_BLOCK) + N_EXPERTS
    rows = jnp.zeros((n_blocks * MOE_BLOCK, d), h.dtype).at[dest].set(hf[tok_sorted])
    block_expert = jnp.minimum(
        jnp.searchsorted(pend, jnp.arange(n_blocks, dtype=jnp.int32) * MOE_BLOCK, side='right'),
        N_EXPERTS - 1)

    def expert_block(args):
        xb, e = args
        return (jax.nn.silu(xb @ w_gate[e]) * (xb @ w_up[e])) @ w_down[e]

    out = lax.map(expert_block, (rows.reshape(n_blocks, MOE_BLOCK, d), block_expert))
    out = out.reshape(n_blocks * MOE_BLOCK, d)
    y = jnp.zeros((t, d), h.dtype).at[tok_sorted].add(out[dest] * w_sorted[:, None].astype(h.dtype))
    return y.reshape(bsz, seq, d)


def setup_inputs(seed: int = 0) -> dict:
    key = jax.random.key(seed)
    ks = jax.random.split(key, 24)
    f = jnp.float32
    nrm = lambda k, shp, s: jax.random.normal(k, shp, f) * s
    dt0 = jnp.exp(jax.random.uniform(ks[12], (DEPTH, SSD_HEADS), f, np.log(1e-3), np.log(1e-1)))
    return {
        'x': nrm(ks[0], (BATCH, SEQ, D_MODEL), 1.0),
        'c': nrm(ks[1], (BATCH, D_MODEL), 1.0),
        'ada_w': nrm(ks[2], (DEPTH, D_MODEL, 6 * D_MODEL), 0.5 * D_MODEL ** -0.5),
        'ada_b': nrm(ks[3], (DEPTH, 6 * D_MODEL), 0.02),
        'norm1_w': 1.0 + nrm(ks[4], (DEPTH, D_MODEL), 0.02),
        'w_in': nrm(ks[5], (DEPTH, D_MODEL, IN_PROJ_DIM), D_MODEL ** -0.5),
        'gm_ln_w': 1.0 + nrm(ks[6], (DEPTH, GM_WIDTH), 0.02),
        'gm_ln_b': nrm(ks[7], (DEPTH, GM_WIDTH), 0.02),
        'gm_ws': nrm(ks[8], (DEPTH, GM_HEADS, GM_CHUNK, GM_CHUNK), 0.5 * GM_CHUNK ** -0.5),
        'gm_bs': 1.0 + nrm(ks[9], (DEPTH, GM_HEADS, GM_CHUNK), 0.1),
        'conv_w': nrm(ks[10], (DEPTH, SSD_CONV, SSD_CONV_DIM), SSD_CONV ** -0.5),
        'conv_b': nrm(ks[11], (DEPTH, SSD_CONV_DIM), 0.02),
        'dt_bias': dt0 + jnp.log(-jnp.expm1(-dt0)),
        'a_log': jnp.log(jax.random.uniform(ks[13], (DEPTH, SSD_HEADS), f, 1.0, 16.0)),
        'd_skip': 1.0 + nrm(ks[14], (DEPTH, SSD_HEADS), 0.1),
        'ssd_norm_w': 1.0 + nrm(ks[15], (DEPTH, SSD_WIDTH), 0.02),
        'w_out': nrm(ks[16], (DEPTH, D_MIX, D_MODEL), D_MIX ** -0.5),
        'norm2_w': 1.0 + nrm(ks[17], (DEPTH, D_MODEL), 0.02),
        'router_w': nrm(ks[18], (D_MODEL, N_EXPERTS), D_MODEL ** -0.5),
        'router_b': nrm(ks[19], (N_EXPERTS,), 0.01),
        'exp_w_gate': nrm(ks[20], (DEPTH, N_EXPERTS, D_MODEL, D_EXPERT), D_MODEL ** -0.5),
        'exp_w_up': nrm(ks[21], (DEPTH, N_EXPERTS, D_MODEL, D_EXPERT), D_MODEL ** -0.5),
        'exp_w_down': nrm(ks[22], (DEPTH, N_EXPERTS, D_EXPERT, D_MODEL), D_EXPERT ** -0.5),
        'final_norm_w': 1.0 + nrm(ks[23], (D_MODEL,), 0.02),
    }


def reference(x, c, ada_w, ada_b, norm1_w, w_in, gm_ln_w, gm_ln_b, gm_ws, gm_bs,
              conv_w, conv_b, dt_bias, a_log, d_skip, ssd_norm_w, w_out, norm2_w,
              router_w, router_b, exp_w_gate, exp_w_up, exp_w_down, final_norm_w):
    sc = jax.nn.silu(c)
    for l in range(DEPTH):
        ada = sc @ ada_w[l] + ada_b[l]
        sh1, s1, g1, sh2, s2, g2 = [a[:, None, :] for a in jnp.split(ada, 6, axis=-1)]
        h = rms_norm(x, norm1_w[l]) * (1 + s1) + sh1
        mix = hybrid_mixer(h, w_in[l], w_out[l], gm_ln_w[l], gm_ln_b[l], gm_ws[l], gm_bs[l],
                           conv_w[l], conv_b[l], dt_bias[l], a_log[l], d_skip[l], ssd_norm_w[l])
        x = x + g1 * mix
        h = rms_norm(x, norm2_w[l]) * (1 + s2) + sh2
        x = x + g2 * moe_ffn(h, router_w, router_b, exp_w_gate[l], exp_w_up[l], exp_w_down[l])
    return rms_norm(x, final_norm_w)
```

```cpp
#include <hip/hip_runtime.h>
#include <stdint.h>
#include <stdio.h>

#ifndef MK_N_LAUNCHES
#define MK_N_LAUNCHES 1
#endif

namespace mk {
constexpr int D = 2048, NB = 4, S = 2048, T = NB * S;
constexpr int GH = 8, CH = 128, NC = S / CH;
constexpr int SW = 1024, SHD = 64, SH = 16, SG = 2, SN = 128, CONVD = 1536, NPROJ = 4624;
constexpr int NPJ = 4608;
constexpr int NPAD = 4864;
constexpr int NE = 64, NGRP = 8, EPG = 8, DE = 512;
constexpr float EPS = 1e-6f;
constexpr int NT = 512;
constexpr int LDS_BYTES = 160 * 1024 - 512;

typedef unsigned short bf16_t;
typedef short bf16x8 __attribute__((ext_vector_type(8)));
typedef float f32x4 __attribute__((ext_vector_type(4)));
typedef float f32x16 __attribute__((ext_vector_type(16)));
typedef unsigned u32x4 __attribute__((ext_vector_type(4)));
typedef unsigned u32x2 __attribute__((ext_vector_type(2)));

constexpr size_t al(size_t x) { return (x + 255) & ~(size_t)255; }
constexpr size_t WS_CTL = 0, CTL_BYTES = 64 * 1024;
constexpr size_t CTL_CNT = 32 * 1024;
constexpr size_t WS_ADA = WS_CTL + CTL_BYTES;
constexpr size_t WS_WTIN = WS_ADA + al((size_t)2 * NB * 6 * D * 4);
constexpr size_t WS_WTOUT = WS_WTIN + al((size_t)2 * NPAD * D * 2);
constexpr size_t WS_RWH = WS_WTOUT + al((size_t)2 * D * D * 2);
constexpr size_t WS_RWL = WS_RWH + al((size_t)NE * D * 2);
constexpr size_t WS_WSB = WS_RWL + al((size_t)NE * D * 2);
constexpr size_t WS_X = WS_WSB + al((size_t)2 * GH * 128 * 128 * 2);
constexpr size_t WS_H = WS_X + al((size_t)T * D * 4);
constexpr size_t WS_PROJ = WS_H + al((size_t)T * D * 2);
constexpr size_t WS_DT = WS_PROJ + al((size_t)T * NPJ * 2);
constexpr size_t WS_ACS = WS_DT + al((size_t)T * SH * 4);
constexpr size_t WS_YD = WS_ACS + al((size_t)T * SH * 4);
constexpr size_t WS_STATES = WS_YD + al((size_t)T * SW * 2);
constexpr size_t WS_PREV = WS_STATES + al((size_t)NB * NC * SH * SHD * SN * 4);
constexpr size_t WS_YMIX = WS_PREV + al((size_t)NB * NC * SH * SHD * SN * 2);
constexpr size_t WS_LIST = WS_YMIX + al((size_t)T * D * 2);
constexpr size_t WS_GW = WS_LIST + al((size_t)NE * T * 4);
constexpr size_t WS_ACT = WS_GW + al((size_t)T * 2 * 4);
constexpr size_t WS_O = WS_ACT + al((size_t)T * 2 * DE * 2);
#ifndef MK_SCAP
#define MK_SCAP 512
#endif
constexpr int SCAP = MK_SCAP;
constexpr size_t WS_HG = WS_O + al((size_t)T * 2 * D * 2);
constexpr size_t WS_ACTS = WS_HG + al((size_t)NE * 64 * SCAP * 64);
constexpr size_t WS_END = WS_ACTS + al((size_t)NE * 16 * SCAP * 64);

struct Params {
    const float* in[24];
    float* out;
    unsigned char* ws;
    int ph_lo, ph_hi;
};

__device__ __forceinline__ float silu_f(float x) { return x * __builtin_amdgcn_rcpf(1.0f + __expf(-x)); }
__device__ __forceinline__ float softplus_f(float x) { return x > 20.f ? x : log1pf(__expf(x)); }
__device__ __forceinline__ unsigned pk_bf16(float lo, float hi) { unsigned r; asm("v_cvt_pk_bf16_f32 %0, %1, %2" : "=v"(r) : "v"(lo), "v"(hi)); return r; }
__device__ __forceinline__ float bf_lo(unsigned u) { return __uint_as_float(u << 16); }
__device__ __forceinline__ float bf_hi(unsigned u) { return __uint_as_float(u & 0xffff0000u); }
__device__ __forceinline__ bf16_t f2bf(float f) { return (bf16_t)(pk_bf16(f, 0.f) & 0xffffu); }
}

namespace pg8 {
#define PG8_LAS __attribute__((address_space(3)))
typedef unsigned short bf16_t;
typedef short bf16x8 __attribute__((ext_vector_type(8)));
typedef float f32x4 __attribute__((ext_vector_type(4)));
typedef unsigned u32x4 __attribute__((ext_vector_type(4)));
constexpr int BM = 256, BK = 64, HALF = 128, HTB = HALF * BK * 2  , STAGE_BYTES = 8 * HTB, NXCD = 8, WGM = 8;

__host__ __device__ __forceinline__ int lds_byte(int r, int c) { const int st = (r >> 4) * 2 + (c >> 5), rr = r & 15, cc = c & 31, ob = rr * 64 + cc * 2; return st * 1024 + (ob ^ (((ob >> 9) & 1) << 5)); }
__host__ __device__ __forceinline__ void stage_rc(int b, int& R, int& C) { const int st = b / 1024, sb = b % 1024, swz = sb ^ (((sb >> 9) & 1) << 5); R = (st >> 1) * 16 + swz / 64; C = (st & 1) * 32 + (swz % 64) / 2; }
__host__ __device__ __forceinline__ int perm32(int rho) { const int n = rho >> 4, i = rho & 15; return 8 * (i >> 2) + 4 * n + (i & 3); }

struct Unit { int pm, pn; };
struct Gemm { const bf16_t* A; const bf16_t* Bt; int M, N, K; };

struct StaticOrder {
    int nM, nN, nwg, G, c;
    __host__ __device__ void init(int M, int N, int G_, int c_) { nM = M / BM; nN = N / BM; nwg = nM * nN; G = G_; c = c_; }
    __host__ __device__ bool next(int i, Unit& u) const {
        const long L = (long)i * G + c; if (L >= nwg) return false;
        int wgid = (int)L; { const int q = nwg / NXCD, r = nwg % NXCD, xcd = wgid % NXCD, off = wgid / NXCD; wgid = (xcd < r ? xcd * (q + 1) : r * (q + 1) + (xcd - r) * q) + off; }
        const int nig = WGM * nN, gid = wgid / nig, fm = gid * WGM, gsz = (nM - fm) < WGM ? (nM - fm) : WGM;
        u.pm = fm + ((wgid % nig) % gsz); u.pn = (wgid % nig) / gsz; return true;
    }
    __device__ __forceinline__ void a_ready(const Unit&) const {}
    __device__ __forceinline__ void done(const Unit&) const {}
};

__device__ __forceinline__ unsigned cvt_pk_bf16(float lo, float hi) { unsigned r; asm volatile("v_cvt_pk_bf16_f32 %0, %1, %2" : "=v"(r) : "v"(lo), "v"(hi)); return r; }
typedef float f32x2 __attribute__((ext_vector_type(2)));
__device__ __forceinline__ f32x2 gelu_pk(f32x2 v) {
    const f32x2 av = __builtin_elementwise_abs(v), d = av * 0.2316418882f + 1.0f;
    f32x2 t; t.x = __builtin_amdgcn_rcpf(d.x); t.y = __builtin_amdgcn_rcpf(d.y);
    f32x2 q = t * 0.5307027145f + (-0.7265760135f); q = q * t + 0.7107068705f; q = q * t + (-0.142248368f); q = q * t + 0.127414796f; q = q * t;
    const f32x2 s = (v * v) * (-0.72134752044f);
    f32x2 e; e.x = __builtin_amdgcn_exp2f(s.x); e.y = __builtin_amdgcn_exp2f(s.y);
    const f32x2 m = v * (q * e), r = v - m;
    f32x2 o; o.x = v.x < 0.f ? m.x : r.x; o.y = v.y < 0.f ? m.y : r.y; return o;
}

template <class Epi, class Sched, bool ALIGN_EPI = false, bool SP2 = false>
__device__ __forceinline__ void gemm_phase(PG8_LAS unsigned char* lds, const Gemm g, const Sched& S, const Epi& E) {
    const int tid = threadIdx.x, wid = __builtin_amdgcn_readfirstlane(tid >> 6), lane = tid & 63, wr = wid >> 2, wc = wid & 3, fr = lane & 15, fq = lane >> 4;
    const int K = g.K, nt = K / BK;
    unsigned voffA[2], voffB[2];
#pragma unroll
    for (int i = 0; i < 2; ++i) { int R, C; stage_rc(tid * 16 + i * 8192, R, C); const int Rb = Epi::PERM ? ((R & ~31) + perm32(R & 31)) : R;
        voffA[i] = (unsigned)(R * K + C) * 2u; voffB[i] = (unsigned)(Rb * K + C) * 2u; }
    const size_t kstep = (size_t)(BK * 2);
    const size_t hstep = (size_t)HALF * K * 2;
    const size_t tstep = 2 * hstep;
    const unsigned ldsw = (unsigned)wid * 1024u;
    const int aoff = lds_byte(wr * 64 + fr, fq * 8), boff = lds_byte(wc * 32 + fr, fq * 8);
#define PG8_SA(b, h) (((b) * 2 + (h)) * HTB)
#define PG8_SB(b, h) ((4 + (b) * 2 + (h)) * HTB)
#define PG8_STAGE(bufoff, gbase, voff) do { _Pragma("unroll") for (int _i = 0; _i < 2; ++_i) \
        __builtin_amdgcn_global_load_lds((const unsigned*)((const char*)(gbase) + (voff)[_i]), (PG8_LAS unsigned*)(lds + (bufoff) + ldsw + _i * 8192), 16, 0, 0); } while (0)
#define PG8_LDA(dst, b, h) do { _Pragma("unroll") for (int m = 0; m < 4; ++m) _Pragma("unroll") for (int k = 0; k < 2; ++k) dst[m][k] = *(const PG8_LAS bf16x8*)(lds + PG8_SA(b, h) + aoff + m * 2048 + k * 1024); } while (0)
#define PG8_LDB(dst, b, h) do { _Pragma("unroll") for (int n = 0; n < 2; ++n) _Pragma("unroll") for (int k = 0; k < 2; ++k) dst[n][k] = *(const PG8_LAS bf16x8*)(lds + PG8_SB(b, h) + boff + n * 2048 + k * 1024); } while (0)
#define PG8_MMA(ai, bj, At, Bt) do { __builtin_amdgcn_s_setprio(1); _Pragma("unroll") for (int m = 0; m < 4; ++m) _Pragma("unroll") for (int n = 0; n < 2; ++n) _Pragma("unroll") for (int k = 0; k < 2; ++k) \
        acc[ai][bj][m][n] = __builtin_amdgcn_mfma_f32_16x16x32_bf16(Bt[n][k], At[m][k], acc[ai][bj][m][n], 0, 0, 0); __builtin_amdgcn_s_setprio(0); } while (0)
#define PG8_WAIT_V(n) asm volatile("s_waitcnt vmcnt(" #n ")" ::: "memory")
#define PG8_WAIT_L(n) asm volatile("s_waitcnt lgkmcnt(" #n ")" ::: "memory")
#define PG8_BAR __builtin_amdgcn_s_barrier()
#define PG8_SCHED __builtin_amdgcn_sched_barrier(0)
    Unit cur, nxt; int ui = 0;
    if (!S.next(0, cur)) return;
    f32x4 acc[2][2][4][2];
#pragma unroll
    for (int a = 0; a < 2; ++a)
#pragma unroll
        for (int b = 0; b < 2; ++b)
#pragma unroll
            for (int m = 0; m < 4; ++m)
#pragma unroll
                for (int n = 0; n < 2; ++n) acc[a][b][m][n] = (f32x4){0.f, 0.f, 0.f, 0.f};
    bf16x8 At[4][2], B0[2][2], B1[2][2];
    const char* cA = (const char*)g.A + (size_t)cur.pm * tstep; const char* cB = (const char*)g.Bt + (size_t)cur.pn * tstep;
    S.a_ready(cur);
    if constexpr (SP2) {
        PG8_STAGE(PG8_SB(0, 0), cB, voffB); PG8_STAGE(PG8_SB(0, 1), cB + hstep, voffB); PG8_STAGE(PG8_SA(0, 0), cA, voffA); PG8_STAGE(PG8_SA(0, 1), cA + hstep, voffA);
        if (wr == 1) PG8_BAR;
        PG8_WAIT_V(2); PG8_BAR;
        PG8_STAGE(PG8_SB(1, 0), cB + kstep, voffB); PG8_STAGE(PG8_SA(1, 0), cA + kstep, voffA); PG8_STAGE(PG8_SB(1, 1), cB + hstep + kstep, voffB);
        PG8_WAIT_V(6); PG8_BAR;
    } else {
        PG8_STAGE(PG8_SB(0, 0), cB, voffB); PG8_STAGE(PG8_SA(0, 0), cA, voffA); PG8_STAGE(PG8_SB(0, 1), cB + hstep, voffB); PG8_STAGE(PG8_SA(0, 1), cA + hstep, voffA);
        if (wr == 1) PG8_BAR;
        PG8_WAIT_V(4); PG8_BAR;
        PG8_STAGE(PG8_SB(1, 0), cB + kstep, voffB); PG8_STAGE(PG8_SA(1, 0), cA + kstep, voffA); PG8_STAGE(PG8_SB(1, 1), cB + hstep + kstep, voffB);
        PG8_WAIT_V(6); PG8_BAR;
    }
    for (;;) {
        const bool has_next = S.next(ui + 1, nxt);
        const char* nA = has_next ? (const char*)g.A + (size_t)nxt.pm * tstep : cA; const char* nB = has_next ? (const char*)g.Bt + (size_t)nxt.pn * tstep : cB;
        for (int t = 0; t < nt; t += 2) {
            const bool last = (t == nt - 2);
            const char* a1 = cA + (size_t)(t + 1) * kstep;
            const char* a2 = last ? nA : cA + (size_t)(t + 2) * kstep; const char* b2 = last ? nB : cB + (size_t)(t + 2) * kstep;
            const char* a3 = a2 + kstep; const char* b3 = b2 + kstep;
            if (last && has_next) S.a_ready(nxt);
            if constexpr (SP2) {
            PG8_LDB(B0, 0, 0); PG8_LDB(B1, 0, 1); PG8_SCHED; PG8_LDA(At, 0, 0); PG8_STAGE(PG8_SA(1, 1), a1 + hstep, voffA);
            PG8_WAIT_V(8); PG8_WAIT_L(0); PG8_BAR; PG8_MMA(0, 0, At, B0); PG8_MMA(0, 1, At, B1); PG8_BAR; PG8_SCHED;
            PG8_LDA(At, 0, 1); PG8_STAGE(PG8_SB(0, 0), b2, voffB); PG8_STAGE(PG8_SB(0, 1), b2 + hstep, voffB); PG8_STAGE(PG8_SA(0, 0), a2, voffA);
            PG8_WAIT_V(8); PG8_WAIT_L(0); PG8_BAR; PG8_MMA(1, 0, At, B0); PG8_MMA(1, 1, At, B1); PG8_BAR; PG8_SCHED;
            PG8_LDB(B0, 1, 0); PG8_LDB(B1, 1, 1); PG8_SCHED; PG8_LDA(At, 1, 0); PG8_STAGE(PG8_SA(0, 1), a2 + hstep, voffA);
            PG8_WAIT_V(8); PG8_WAIT_L(0); PG8_BAR; PG8_MMA(0, 0, At, B0); PG8_MMA(0, 1, At, B1); PG8_BAR; PG8_SCHED;
            PG8_LDA(At, 1, 1); PG8_STAGE(PG8_SB(1, 0), b3, voffB); PG8_STAGE(PG8_SB(1, 1), b3 + hstep, voffB); PG8_STAGE(PG8_SA(1, 0), a3, voffA);
            PG8_WAIT_V(8); PG8_WAIT_L(0); PG8_BAR; PG8_MMA(1, 0, At, B0); PG8_MMA(1, 1, At, B1); PG8_BAR; PG8_SCHED;
            } else {
            PG8_LDB(B0, 0, 0); PG8_SCHED; PG8_LDA(At, 0, 0); PG8_STAGE(PG8_SA(1, 1), a1 + hstep, voffA);
            PG8_WAIT_L(8); PG8_BAR; PG8_WAIT_L(0); PG8_MMA(0, 0, At, B0); PG8_BAR; PG8_SCHED;
            PG8_LDB(B1, 0, 1); PG8_STAGE(PG8_SB(0, 0), b2, voffB);
            PG8_BAR; PG8_WAIT_L(0); PG8_MMA(0, 1, At, B1); PG8_BAR;
            PG8_LDA(At, 0, 1); PG8_STAGE(PG8_SA(0, 0), a2, voffA);
            PG8_BAR; PG8_WAIT_L(0); PG8_MMA(1, 0, At, B0); PG8_BAR; PG8_SCHED;
            PG8_STAGE(PG8_SB(0, 1), b2 + hstep, voffB);
            PG8_WAIT_V(6); PG8_BAR; PG8_MMA(1, 1, At, B1); PG8_BAR;
            PG8_LDB(B0, 1, 0); PG8_SCHED; PG8_LDA(At, 1, 0); PG8_STAGE(PG8_SA(0, 1), a2 + hstep, voffA);
            PG8_WAIT_L(8); PG8_BAR; PG8_WAIT_L(0); PG8_MMA(0, 0, At, B0); PG8_BAR; PG8_SCHED;
            PG8_LDB(B1, 1, 1); PG8_STAGE(PG8_SB(1, 0), b3, voffB);
            PG8_BAR; PG8_WAIT_L(0); PG8_MMA(0, 1, At, B1); PG8_BAR;
            PG8_LDA(At, 1, 1); PG8_STAGE(PG8_SA(1, 0), a3, voffA);
            PG8_BAR; PG8_WAIT_L(0); PG8_MMA(1, 0, At, B0); PG8_BAR; PG8_SCHED;
            PG8_STAGE(PG8_SB(1, 1), b3 + hstep, voffB);
            PG8_WAIT_V(6); PG8_BAR; PG8_MMA(1, 1, At, B1); PG8_BAR;
            }
        }
        if constexpr (ALIGN_EPI) { if (wr == 0) PG8_BAR; }
        if constexpr (!Epi::AFTER_DRAIN) { E(acc, cur, wr, wc, fr, fq); S.done(cur); }
        if (!has_next) break;
#pragma unroll
        for (int a = 0; a < 2; ++a)
#pragma unroll
            for (int b = 0; b < 2; ++b)
#pragma unroll
                for (int m = 0; m < 4; ++m)
#pragma unroll
                    for (int n = 0; n < 2; ++n) acc[a][b][m][n] = (f32x4){0.f, 0.f, 0.f, 0.f};
        cur = nxt; cA = nA; cB = nB; ++ui;
        if constexpr (ALIGN_EPI) { if (wr == 1) PG8_BAR; }
    }
    PG8_WAIT_V(0);
    if constexpr (!ALIGN_EPI) { if (wr == 0) PG8_BAR; }
    PG8_BAR;
    if constexpr (Epi::AFTER_DRAIN) { E.fused(acc, cur, wr, wc, fr, fq, lds, wid, lane); S.done(cur); }
#undef PG8_SA
#undef PG8_SB
#undef PG8_STAGE
#undef PG8_LDA
#undef PG8_LDB
#undef PG8_MMA
#undef PG8_WAIT_V
#undef PG8_WAIT_L
#undef PG8_BAR
#undef PG8_SCHED
}

}

#define XB_TMO      128
#define XB_XCNT(j)  (256  + 64 * (j))
#define XB_XSUB(j)  (1280 + 64 * (j))
#define XB_XGEN(j)  (2304 + 64 * (j))
#define XB_TOP      3328
#define XB_TOPGEN   3392
#define XCD_BAR_WORDS 3456
#define XB_SPIN_CAP (1u << 18)
#define LAS __attribute__((address_space(3)))

__device__ __forceinline__ unsigned xb_ld(unsigned* p)              { return __hip_atomic_load(p, __ATOMIC_RELAXED, __HIP_MEMORY_SCOPE_AGENT); }
__device__ __forceinline__ unsigned xb_add(unsigned* p, unsigned v) { return __hip_atomic_fetch_add(p, v, __ATOMIC_RELAXED, __HIP_MEMORY_SCOPE_AGENT); }
__device__ __forceinline__ unsigned xb_xcc_id() { return (unsigned)__builtin_amdgcn_s_getreg((3 << 11) | 20) & 0xFu; }
#define XB_SPIN(cond, bar) do { unsigned _sp = 0; while (cond) { __builtin_amdgcn_s_sleep(1); \
    if ((++_sp & 255u) == 0u) { if (xb_ld(&(bar)[XB_TMO])) break; if (_sp > XB_SPIN_CAP) { atomicAdd(&(bar)[XB_TMO], 1u); break; } } } } while (0)

struct XcdBarrier {
    unsigned* bar; unsigned x;
    volatile LAS unsigned* st;
};

__device__ __forceinline__ XcdBarrier xcd_barrier_post(unsigned* bar, volatile LAS unsigned* st) {
    XcdBarrier b; b.bar = bar; b.x = xb_xcc_id(); b.st = st;
    if (threadIdx.x == 0) (void)xb_add(&bar[XB_XCNT(b.x)], 1u);
    return b;
}
__device__ __forceinline__ void xcd_barrier_complete(unsigned* bar, unsigned x, unsigned& nloc, unsigned& nx) {
    const unsigned G = gridDim.x * gridDim.y * gridDim.z;
    unsigned sum, cnt, mine, sp = 0u;
    for (;;) {
        sum = 0u; cnt = 0u; mine = 0u;
#pragma unroll
        for (unsigned j = 0; j < 16; ++j) { const unsigned c = xb_ld(&bar[XB_XCNT(j)]); sum += c; cnt += (c > 0u) ? 1u : 0u; mine = (j == x) ? c : mine; }
        if (sum == G) break;
        __builtin_amdgcn_s_sleep(1);
        if ((++sp & 255u) == 0u) { if (xb_ld(&bar[XB_TMO])) break; if (sp > XB_SPIN_CAP) { atomicAdd(&bar[XB_TMO], 1u); break; } }
    }
    nloc = mine > 0u ? mine : 1u; nx = cnt > 0u ? cnt : 1u;
}

__device__ __forceinline__ void xcd_barrier(const XcdBarrier& b) {
    asm volatile("s_waitcnt vmcnt(0)" ::: "memory");
    __syncthreads();
    if (threadIdx.x == 0) {
        unsigned* bar = b.bar;
        __builtin_amdgcn_s_waitcnt(0);
        unsigned nloc = b.st[0], nx = b.st[1];
        if (nloc == 0u) { xcd_barrier_complete(bar, b.x, nloc, nx); b.st[0] = nloc; b.st[1] = nx; }
        const unsigned old = xb_add(&bar[XB_XSUB(b.x)], 1u);
        const unsigned gen = old / nloc;
        if (old + 1u == (gen + 1u) * nloc) {
            __builtin_amdgcn_fence(__ATOMIC_RELEASE, "agent");
            asm volatile("s_waitcnt vmcnt(0)" ::: "memory");
            const unsigned og = xb_add(&bar[XB_TOP], 1u);
            const unsigned tg = og / nx;
            if (og + 1u == (tg + 1u) * nx) xb_add(&bar[XB_TOPGEN], 1u);
            else XB_SPIN(xb_ld(&bar[XB_TOPGEN]) == tg, bar);
            __builtin_amdgcn_fence(__ATOMIC_ACQUIRE, "agent");
            xb_add(&bar[XB_XGEN(b.x)], 1u);
            asm volatile("s_waitcnt vmcnt(0)" ::: "memory");
        } else {
            XB_SPIN(xb_ld(&bar[XB_XGEN(b.x)]) == gen, bar);
            __builtin_amdgcn_fence(__ATOMIC_ACQUIRE, "agent");
            asm volatile("s_waitcnt vmcnt(0)" ::: "memory");
        }
    }
    __syncthreads();
}


namespace mk {
using pg8::cvt_pk_bf16;
typedef LAS unsigned char* ldsp_t;

template <int NT_>
__device__ __forceinline__ void transpose_tiles(const float* __restrict__ src, int ldn, int nvalid, bf16_t* __restrict__ dst_hi, bf16_t* __restrict__ dst_lo, int K, int k0, int n0,
                                                LAS float* tile, int tid) {
    float4 v[NT_][2];
#pragma unroll
    for (int t = 0; t < NT_; ++t)
#pragma unroll
        for (int i = 0; i < 2; ++i) {
            const int r = (tid >> 4) + 32 * i, n = n0 + t * 64 + (tid & 15) * 4;
            v[t][i] = make_float4(0.f, 0.f, 0.f, 0.f);
            if (n < nvalid) v[t][i] = *(const float4*)(src + (size_t)(k0 + r) * ldn + n);
        }
#pragma unroll
    for (int t = 0; t < NT_; ++t) {
        LAS float* tl = tile + (t & 1) * (64 * 65);
#pragma unroll
        for (int i = 0; i < 2; ++i) {
            const int r = (tid >> 4) + 32 * i, c4 = (tid & 15) * 4;
            tl[r * 65 + c4 + 0] = v[t][i].x; tl[r * 65 + c4 + 1] = v[t][i].y; tl[r * 65 + c4 + 2] = v[t][i].z; tl[r * 65 + c4 + 3] = v[t][i].w;
        }
        __syncthreads();
        const int n = tid >> 3, ko = (tid & 7) * 8;
        float f[8];
#pragma unroll
        for (int j = 0; j < 8; ++j) f[j] = tl[(ko + j) * 65 + n];
        u32x4 h; h.x = pk_bf16(f[0], f[1]); h.y = pk_bf16(f[2], f[3]); h.z = pk_bf16(f[4], f[5]); h.w = pk_bf16(f[6], f[7]);
        *(u32x4*)(dst_hi + (size_t)(n0 + t * 64 + n) * K + k0 + ko) = h;
        if (dst_lo) {
            u32x4 lo;
            lo.x = pk_bf16(f[0] - bf_lo(h.x), f[1] - bf_hi(h.x)); lo.y = pk_bf16(f[2] - bf_lo(h.y), f[3] - bf_hi(h.y));
            lo.z = pk_bf16(f[4] - bf_lo(h.z), f[5] - bf_hi(h.z)); lo.w = pk_bf16(f[6] - bf_lo(h.w), f[7] - bf_hi(h.w));
            *(u32x4*)(dst_lo + (size_t)(n0 + t * 64 + n) * K + k0 + ko) = lo;
        }
    }
    __syncthreads();
}

__device__ __forceinline__ void phase_prologue(const Params& p, ldsp_t lds, int which, int rank, int nrank) {
    const int tid = threadIdx.x;
    LAS float* sc = (LAS float*)lds;
    LAS float* red = (LAS float*)(lds + 32768);
    LAS float* tile = (LAS float*)(lds + 65536);
    const float* c = p.in[1]; const float* ada_w = p.in[2]; const float* ada_b = p.in[3];
    float* ADA = (float*)(p.ws + WS_ADA);
    for (int i = tid; i < NB * D; i += NT) sc[i] = silu_f(c[i]);
    __syncthreads();
    constexpr int U_ADA = 768, U_WIN = 32 * 19, U_WOUT = 32 * 8, U_RT = 32, U_WSB = 64;
    constexpr int U_TOT = U_ADA + 2 * U_WIN + 2 * U_WOUT + U_RT + U_WSB;
    for (int u0 = rank; u0 < U_TOT; u0 += nrank) {
        const int u = u0;
        int ul = -1;
        if (u < U_ADA) ul = u / 384; else if (u < U_ADA + 2 * U_WIN) ul = (u - U_ADA) / U_WIN; else if (u < U_ADA + 2 * U_WIN + 2 * U_WOUT) ul = (u - U_ADA - 2 * U_WIN) / U_WOUT;
        if ((which == 0 && ul == 1) || (which == 1 && ul != 1)) continue;
        if (u < U_ADA) {
            const int l = u / 384, cg = u % 384, cl = tid & 7, ks = tid >> 3;
            const float* w = ada_w + ((size_t)l * D + ks * 32) * (6 * D) + cg * 32 + cl * 4;
            float acc[4][4];
#pragma unroll
            for (int b = 0; b < 4; ++b)
#pragma unroll
                for (int i = 0; i < 4; ++i) acc[b][i] = 0.f;
            float4 wq[32];
#pragma unroll
            for (int kk = 0; kk < 32; ++kk) wq[kk] = *(const float4*)(w + (size_t)kk * (6 * D));
#pragma unroll
            for (int kk = 0; kk < 32; ++kk) {
                const float4 wv = wq[kk];
#pragma unroll
                for (int b = 0; b < 4; ++b) { const float s = sc[b * D + ks * 32 + kk]; acc[b][0] += s * wv.x; acc[b][1] += s * wv.y; acc[b][2] += s * wv.z; acc[b][3] += s * wv.w; }
            }
#pragma unroll
            for (int b = 0; b < 4; ++b)
#pragma unroll
                for (int i = 0; i < 4; ++i) red[(ks * 4 + b) * 32 + cl * 4 + i] = acc[b][i];
            __syncthreads();
            if (tid < 128) {
                const int b = tid >> 5, col = tid & 31;
                float s = 0.f;
                for (int k2 = 0; k2 < 64; ++k2) s += red[(k2 * 4 + b) * 32 + col];
                ADA[((size_t)l * NB + b) * (6 * D) + cg * 32 + col] = s + ada_b[l * 6 * D + cg * 32 + col];
            }
            __syncthreads();
        } else if (u < U_ADA + 2 * U_WIN) {
            const int v = u - U_ADA, l = v / U_WIN, tt = v % U_WIN, kt = tt / 19, ng = tt % 19;
            transpose_tiles<4>(p.in[5] + (size_t)l * D * NPROJ, NPROJ, NPROJ, (bf16_t*)(p.ws + WS_WTIN) + (size_t)l * NPAD * D, nullptr, D, kt * 64, ng * 256, tile, tid);
        } else if (u < U_ADA + 2 * U_WIN + 2 * U_WOUT) {
            const int v = u - U_ADA - 2 * U_WIN, l = v / U_WOUT, tt = v % U_WOUT, kt = tt / 8, ng = tt % 8;
            transpose_tiles<4>(p.in[16] + (size_t)l * D * D, D, D, (bf16_t*)(p.ws + WS_WTOUT) + (size_t)l * D * D, nullptr, D, kt * 64, ng * 256, tile, tid);
        } else if (u < U_ADA + 2 * U_WIN + 2 * U_WOUT + U_RT) {
            const int kt = u - (U_ADA + 2 * U_WIN + 2 * U_WOUT);
            transpose_tiles<1>(p.in[18], NE, NE, (bf16_t*)(p.ws + WS_RWH), (bf16_t*)(p.ws + WS_RWL), D, kt * 64, 0, tile, tid);
        } else {
            const int v = u - (U_ADA + 2 * U_WIN + 2 * U_WOUT + U_RT);
            const float* wsrc = p.in[8]; bf16_t* dst = (bf16_t*)(p.ws + WS_WSB);
#pragma unroll
            for (int i = 0; i < 2; ++i) {
                const int e0 = v * 4096 + (tid + i * NT) * 4;
                const int s0 = e0 & 127, t = (e0 >> 7) & 127;
                const float4 wv = *(const float4*)(wsrc + e0);
                u32x2 o; o.x = pk_bf16(s0 + 0 <= t ? wv.x : 0.f, s0 + 1 <= t ? wv.y : 0.f); o.y = pk_bf16(s0 + 2 <= t ? wv.z : 0.f, s0 + 3 <= t ? wv.w : 0.f);
                *(u32x2*)(dst + e0) = o;
            }
        }
    }
}

template <int MODE>
__device__ __forceinline__ void phase_norm(const Params& p, int l) {
    const int tid = threadIdx.x, lane = tid & 63, wid = tid >> 6, G = gridDim.x;
    const float* ADA = (const float*)(p.ws + WS_ADA);
    bf16_t* X = (bf16_t*)(p.ws + WS_X);
    bf16_t* H = (bf16_t*)(p.ws + WS_H);
    const char* O8 = (const char*)(p.ws + WS_O);
    for (int rb = blockIdx.x; rb < T / 32; rb += G) {
        const int b = (rb * 32) / S;
        float4 Av[8], Bv[8], Gv[8];
#pragma unroll
        for (int j = 0; j < 8; ++j) {
            const int d = lane * 4 + 256 * j;
            if (MODE == 2) { Av[j] = *(const float4*)(p.in[23] + d); Bv[j] = make_float4(0.f, 0.f, 0.f, 0.f); }
            else {
                const float4 nw = *(const float4*)(p.in[4] + l * D + d);
                const float4 sh = *(const float4*)(ADA + ((size_t)l * NB + b) * 6 * D + 0 * D + d);
                const float4 s1 = *(const float4*)(ADA + ((size_t)l * NB + b) * 6 * D + 1 * D + d);
                Av[j] = make_float4(nw.x * (1.f + s1.x), nw.y * (1.f + s1.y), nw.z * (1.f + s1.z), nw.w * (1.f + s1.w)); Bv[j] = sh;
            }
            if (MODE >= 1) { const int lp = (MODE == 2) ? 1 : l - 1; Gv[j] = *(const float4*)(ADA + ((size_t)lp * NB + b) * 6 * D + 5 * D + d); }
        }
        constexpr int UNR = (MODE == 1) ? 1 : 2;
#pragma unroll UNR
        for (int rr = 0; rr < 4; ++rr) {
            const int t = rb * 32 + wid * 4 + rr;
            float4 xv[8]; float ss = 0.f;
#pragma unroll
            for (int j = 0; j < 8; ++j) {
                const int d = lane * 4 + 256 * j;
                if (MODE == 0) xv[j] = *(const float4*)(p.in[0] + (size_t)t * D + d);
                else { const u32x2 xb = *(const u32x2*)(X + (size_t)t * D + d); xv[j] = make_float4(bf_lo(xb.x), bf_hi(xb.x), bf_lo(xb.y), bf_hi(xb.y)); }
                if (MODE >= 1) {
                    const int o0 = *(const int*)(O8 + (size_t)(2 * t) * D + d), o1 = *(const int*)(O8 + (size_t)(2 * t + 1) * D + d);
                    typedef float f32x2_t __attribute__((ext_vector_type(2)));
                    const f32x2_t a0 = __builtin_amdgcn_cvt_pk_f32_fp8(o0, false), a1 = __builtin_amdgcn_cvt_pk_f32_fp8(o0, true), b0 = __builtin_amdgcn_cvt_pk_f32_fp8(o1, false), b1 = __builtin_amdgcn_cvt_pk_f32_fp8(o1, true);
                    xv[j].x += Gv[j].x * (a0.x + b0.x); xv[j].y += Gv[j].y * (a0.y + b0.y);
                    xv[j].z += Gv[j].z * (a1.x + b1.x); xv[j].w += Gv[j].w * (a1.y + b1.y);
                }
                ss += xv[j].x * xv[j].x + xv[j].y * xv[j].y + xv[j].z * xv[j].z + xv[j].w * xv[j].w;
            }
#pragma unroll
            for (int o = 32; o > 0; o >>= 1) ss += __shfl_xor(ss, o);
            const float rstd = rsqrtf(ss * (1.0f / D) + EPS);
#pragma unroll
            for (int j = 0; j < 8; ++j) {
                const int d = lane * 4 + 256 * j;
                const float y0 = xv[j].x * rstd * Av[j].x + Bv[j].x, y1 = xv[j].y * rstd * Av[j].y + Bv[j].y, y2 = xv[j].z * rstd * Av[j].z + Bv[j].z, y3 = xv[j].w * rstd * Av[j].w + Bv[j].w;
                if (MODE == 2) *(float4*)(p.out + (size_t)t * D + d) = make_float4(y0, y1, y2, y3);
                else { u32x2 hv; hv.x = pk_bf16(y0, y1); hv.y = pk_bf16(y2, y3); *(u32x2*)(H + (size_t)t * D + d) = hv; }
                if (MODE == 1) { u32x2 xo; xo.x = pk_bf16(xv[j].x, xv[j].y); xo.y = pk_bf16(xv[j].z, xv[j].w); *(u32x2*)(X + (size_t)t * D + d) = xo; }
            }
        }
    }
}

struct EpiProj {
    static constexpr bool PERM = true, AFTER_DRAIN = false;
    bf16_t* PROJ; float* DT; const float* dt_bias;
    __device__ __forceinline__ void operator()(const pg8::f32x4 (&acc)[2][2][4][2], const pg8::Unit& u, int wr, int wc, int fr, int fq) const {
        const int row0 = u.pm * 256 + wr * 64 + fr;
        if (u.pn < 18) {
            const int col0 = u.pn * 256 + wc * 32 + 8 * fq;
            const bool act = u.pn < 8;
#pragma unroll
            for (int ai = 0; ai < 2; ++ai)
#pragma unroll
                for (int m = 0; m < 4; ++m) {
                    bf16_t* rowp = PROJ + (size_t)(row0 + ai * 128 + m * 16) * NPJ + col0;
#pragma unroll
                    for (int bj = 0; bj < 2; ++bj) {
                        pg8::f32x4 v0 = acc[ai][bj][m][0], v1 = acc[ai][bj][m][1];
                        if (act) {
                            const pg8::f32x2 a = pg8::gelu_pk((pg8::f32x2){v0[0], v0[1]}), b2 = pg8::gelu_pk((pg8::f32x2){v0[2], v0[3]}), c2 = pg8::gelu_pk((pg8::f32x2){v1[0], v1[1]}), d2 = pg8::gelu_pk((pg8::f32x2){v1[2], v1[3]});
                            v0 = (pg8::f32x4){a.x, a.y, b2.x, b2.y}; v1 = (pg8::f32x4){c2.x, c2.y, d2.x, d2.y};
                        }
                        pg8::u32x4 w; w.x = cvt_pk_bf16(v0[0], v0[1]); w.y = cvt_pk_bf16(v0[2], v0[3]); w.z = cvt_pk_bf16(v1[0], v1[1]); w.w = cvt_pk_bf16(v1[2], v1[3]);
                        *(pg8::u32x4*)(rowp + bj * 128) = w;
                    }
                }
        } else if (wc == 0 && fq < 2) {
            float db[2][4];
#pragma unroll
            for (int n = 0; n < 2; ++n)
#pragma unroll
                for (int k = 0; k < 4; ++k) db[n][k] = dt_bias[8 * fq + 4 * n + k];
#pragma unroll
            for (int ai = 0; ai < 2; ++ai)
#pragma unroll
                for (int m = 0; m < 4; ++m) {
                    const int row = row0 + ai * 128 + m * 16;
#pragma unroll
                    for (int n = 0; n < 2; ++n) {
                        const int c0 = 8 * fq + 4 * n;
                        const pg8::f32x4 v = acc[ai][0][m][n];
                        float4 o; o.x = softplus_f(v[0] + db[n][0]); o.y = softplus_f(v[1] + db[n][1]); o.z = softplus_f(v[2] + db[n][2]); o.w = softplus_f(v[3] + db[n][3]);
                        *(float4*)(DT + (size_t)row * SH + c0) = o;
                    }
                }
        }
    }
};
template <bool F32R>
struct EpiRes {
    static constexpr bool PERM = true, AFTER_DRAIN = false;
    const float* R32; bf16_t* Xout; const float* gate;
    __device__ __forceinline__ void operator()(const pg8::f32x4 (&acc)[2][2][4][2], const pg8::Unit& u, int wr, int wc, int fr, int fq) const {
        const int row0 = u.pm * 256 + wr * 64 + fr, col0 = u.pn * 256 + wc * 32 + 8 * fq;
        const int b = (u.pm * 256) / S;
        pg8::f32x4 gv[2][2];
#pragma unroll
        for (int bj = 0; bj < 2; ++bj)
#pragma unroll
            for (int n = 0; n < 2; ++n) gv[bj][n] = *(const pg8::f32x4*)(gate + (size_t)b * 6 * D + col0 + bj * 128 + 4 * n);
#pragma unroll
        for (int ai = 0; ai < 2; ++ai) {
            pg8::f32x4 rf[F32R ? 16 : 1]; pg8::u32x4 rb[F32R ? 1 : 8];
#pragma unroll
            for (int m = 0; m < 4; ++m)
#pragma unroll
                for (int bj = 0; bj < 2; ++bj) {
                    const size_t ro = (size_t)(row0 + ai * 128 + m * 16) * D + col0 + bj * 128;
                    if constexpr (F32R) { rf[(m * 2 + bj) * 2] = *(const pg8::f32x4*)(R32 + ro); rf[(m * 2 + bj) * 2 + 1] = *(const pg8::f32x4*)(R32 + ro + 4); }
                    else rb[m * 2 + bj] = *(const pg8::u32x4*)(Xout + ro);
                }
#pragma unroll
            for (int m = 0; m < 4; ++m)
#pragma unroll
                for (int bj = 0; bj < 2; ++bj) {
                    const size_t ro = (size_t)(row0 + ai * 128 + m * 16) * D + col0 + bj * 128;
                    pg8::f32x4 r0, r1;
                    if constexpr (F32R) { r0 = rf[(m * 2 + bj) * 2]; r1 = rf[(m * 2 + bj) * 2 + 1]; }
                    else { const pg8::u32x4 q = rb[m * 2 + bj];
                           r0 = (pg8::f32x4){bf_lo(q.x), bf_hi(q.x), bf_lo(q.y), bf_hi(q.y)}; r1 = (pg8::f32x4){bf_lo(q.z), bf_hi(q.z), bf_lo(q.w), bf_hi(q.w)}; }
                    const pg8::f32x4 v0 = r0 + gv[bj][0] * acc[ai][bj][m][0], v1 = r1 + gv[bj][1] * acc[ai][bj][m][1];
                    pg8::u32x4 w; w.x = cvt_pk_bf16(v0[0], v0[1]); w.y = cvt_pk_bf16(v0[2], v0[3]); w.z = cvt_pk_bf16(v1[0], v1[1]); w.w = cvt_pk_bf16(v1[2], v1[3]);
                    *(pg8::u32x4*)(Xout + ro) = w;
                }
        }
    }
};
}

namespace mk {
#define MFMA16(a, b, c) __builtin_amdgcn_mfma_f32_16x16x32_bf16((a), (b), (c), 0, 0, 0)
constexpr int SP = 272;

struct ConvW { float w[4][8]; float b[8]; };
__device__ __forceinline__ void load_convw(ConvW& cw, const float* __restrict__ conv_w, const float* __restrict__ conv_b, int chx) {
#pragma unroll
    for (int k = 0; k < 4; ++k) {
        const float4 a = *(const float4*)(conv_w + k * CONVD + chx), b2 = *(const float4*)(conv_w + k * CONVD + chx + 4);
        cw.w[k][0] = a.x; cw.w[k][1] = a.y; cw.w[k][2] = a.z; cw.w[k][3] = a.w; cw.w[k][4] = b2.x; cw.w[k][5] = b2.y; cw.w[k][6] = b2.z; cw.w[k][7] = b2.w;
    }
    const float4 a = *(const float4*)(conv_b + chx), b2 = *(const float4*)(conv_b + chx + 4);
    cw.b[0] = a.x; cw.b[1] = a.y; cw.b[2] = a.z; cw.b[3] = a.w; cw.b[4] = b2.x; cw.b[5] = b2.y; cw.b[6] = b2.z; cw.b[7] = b2.w;
}
__device__ __forceinline__ u32x4 ld_raw(const bf16_t* __restrict__ PROJ, int tg, int tl, int pcol) {
    u32x4 z; z.x = z.y = z.z = z.w = 0u;
    if (tl >= 0) z = *(const u32x4*)(PROJ + (size_t)tg * NPJ + pcol);
    return z;
}
__device__ __forceinline__ void conv8(const ConvW& cw, const u32x4& r0, const u32x4& r1, const u32x4& r2, const u32x4& r3, float (&o)[8]) {
#pragma unroll
    for (int j = 0; j < 8; ++j) o[j] = cw.b[j];
    const u32x4 rr[4] = {r0, r1, r2, r3};
#pragma unroll
    for (int k = 0; k < 4; ++k) {
        const float x[8] = {bf_lo(rr[k].x), bf_hi(rr[k].x), bf_lo(rr[k].y), bf_hi(rr[k].y), bf_lo(rr[k].z), bf_hi(rr[k].z), bf_lo(rr[k].w), bf_hi(rr[k].w)};
#pragma unroll
        for (int j = 0; j < 8; ++j) o[j] += cw.w[k][j] * x[j];
    }
#pragma unroll
    for (int j = 0; j < 8; ++j) o[j] = silu_f(o[j]);
}
__device__ __forceinline__ u32x4 pack8(const float (&o)[8]) { u32x4 v; v.x = pk_bf16(o[0], o[1]); v.y = pk_bf16(o[2], o[3]); v.z = pk_bf16(o[4], o[5]); v.w = pk_bf16(o[6], o[7]); return v; }

__device__ __forceinline__ void ssd_unit(const Params& p, ldsp_t lds, int l, int u) {
    const int tid = threadIdx.x, lane = tid & 63, wid = __builtin_amdgcn_readfirstlane(tid >> 6), fr = lane & 15, fq = lane >> 4;
    const int hs = u & 1, g = (u >> 1) & 1, bc = u >> 2, b = bc / NC, c = bc % NC;
    const int tg0 = bc * CH, tl0 = c * CH;
    const bf16_t* PROJ = (const bf16_t*)(p.ws + WS_PROJ);
    const float* DT = (const float*)(p.ws + WS_DT);
    float* ACS = (float*)(p.ws + WS_ACS);
    bf16_t* YD = (bf16_t*)(p.ws + WS_YD);
    bf16_t* STATES = (bf16_t*)(p.ws + WS_STATES);
    const float* conv_w = p.in[10] + (size_t)l * 4 * CONVD; const float* conv_b = p.in[11] + l * CONVD;
    ldsp_t R1 = lds, R2 = lds + 34816, R3 = lds + 69632, R4 = lds + 104448;
    LAS float* acsS = (LAS float*)(lds + 122880); LAS float* dtS = (LAS float*)(lds + 122880 + 2048);
    (void)b;
    {
        const int o = tid & 31, lg = tid >> 5, l0 = lg * 8, is_c = o >> 4, nn = (o & 15) * 8;
        const int chx = 1024 + is_c * 256 + g * SN + nn, pcol = 3072 + chx;
        ConvW cw; load_convw(cw, conv_w, conv_b, chx);
        u32x4 raw[11];
#pragma unroll
        for (int r = 0; r < 11; ++r) raw[r] = ld_raw(PROJ, tg0 + l0 + r - 3, tl0 + l0 + r - 3, pcol);
#pragma unroll
        for (int i = 0; i < 8; ++i) {
            float ov[8]; conv8(cw, raw[i], raw[i + 1], raw[i + 2], raw[i + 3], ov);
            const int ll = l0 + i;
            const u32x4 pk = pack8(ov);
            *(LAS u32x4*)((is_c ? R1 : R2) + ll * SP + nn * 2) = pk;
            if (!is_c) {
                const unsigned pw[4] = {pk.x, pk.y, pk.z, pk.w};
#pragma unroll
                for (int j = 0; j < 8; ++j) *(LAS bf16_t*)(R3 + (nn + j) * SP + ll * 2) = (bf16_t)((j & 1) ? (pw[j >> 1] >> 16) : (pw[j >> 1] & 0xffffu));
            }
        }
    }
    if (wid < 4) {
        const int h = g * 8 + hs * 4 + wid, l2 = lane * 2;
        const float a = -__expf(p.in[13][l * SH + h]);
        const float dt0 = DT[(size_t)(tg0 + l2) * SH + h], dt1 = DT[(size_t)(tg0 + l2 + 1) * SH + h];
        const float ad0 = dt0 * a, ad1 = dt1 * a, s = ad0 + ad1;
        float incl = s;
#pragma unroll
        for (int o = 1; o < 64; o <<= 1) { const float n = __shfl_up(incl, o); if (lane >= o) incl += n; }
        const float excl = incl - s;
        acsS[wid * 128 + l2] = excl + ad0; acsS[wid * 128 + l2 + 1] = incl;
        dtS[wid * 128 + l2] = dt0; dtS[wid * 128 + l2 + 1] = dt1;
        ACS[(size_t)(tg0 + l2) * SH + h] = excl + ad0; ACS[(size_t)(tg0 + l2 + 1) * SH + h] = incl;
    }
    __syncthreads();
    f32x4 CB[8];
#pragma unroll
    for (int nt = 0; nt < 8; ++nt) CB[nt] = (f32x4){0.f, 0.f, 0.f, 0.f};
#pragma unroll
    for (int ks = 0; ks < 4; ++ks) {
        const bf16x8 af = *(const LAS bf16x8*)(R1 + (16 * wid + fr) * SP + (32 * ks + 8 * fq) * 2);
#pragma unroll
        for (int nt = 0; nt < 8; ++nt) if (nt <= wid) {
            const bf16x8 bfr = *(const LAS bf16x8*)(R2 + (16 * nt + fr) * SP + (32 * ks + 8 * fq) * 2);
            CB[nt] = MFMA16(bfr, af, CB[nt]);
        }
    }
    __syncthreads();
    const float dsk_base = 0.f; (void)dsk_base;
    u32x4 raw[5];
    {
        const int o = tid & 7, l0 = (tid >> 3) * 2, pcol = 3072 + (g * 8 + hs * 4) * SHD + o * 8;
#pragma unroll
        for (int r = 0; r < 5; ++r) raw[r] = ld_raw(PROJ, tg0 + l0 + r - 3, tl0 + l0 + r - 3, pcol);
    }
#pragma unroll 1
    for (int hl = 0; hl < 4; ++hl) {
        const int h = g * 8 + hs * 4 + hl;
        {
            const int o = tid & 7, lg = tid >> 3, l0 = lg * 2, chx = h * SHD + o * 8;
            ConvW cw; load_convw(cw, conv_w, conv_b, chx);
            const float alast = acsS[hl * 128 + 127];
#pragma unroll
            for (int i = 0; i < 2; ++i) {
                float ov[8]; conv8(cw, raw[i], raw[i + 1], raw[i + 2], raw[i + 3], ov);
                const int ll = l0 + i;
                *(LAS u32x4*)(R4 + ll * 144 + o * 16) = pack8(ov);
                const float dtl = dtS[hl * 128 + ll], e = __expf(alast - acsS[hl * 128 + ll]);
#pragma unroll
                for (int j = 0; j < 8; ++j) {
                    const float xd = ov[j] * dtl;
                    *(LAS bf16_t*)(R2 + (o * 8 + j) * SP + ll * 2) = f2bf(xd);
                    *(LAS bf16_t*)(R2 + 17408 + (o * 8 + j) * SP + ll * 2) = f2bf(xd * e);
                }
            }
        }
        if (hl < 3) {
            const int o = tid & 7, l0 = (tid >> 3) * 2, pcol = 3072 + (h + 1) * SHD + o * 8;
#pragma unroll
            for (int r = 0; r < 5; ++r) raw[r] = ld_raw(PROJ, tg0 + l0 + r - 3, tl0 + l0 + r - 3, pcol);
        }
        {
            const int lrow = 16 * wid + fr;
            const float al = acsS[hl * 128 + lrow];
#pragma unroll
            for (int nt = 0; nt < 8; ++nt) {
                if (nt <= wid) {
                    const f32x4 as = *(const LAS f32x4*)(acsS + hl * 128 + 16 * nt + 4 * fq);
                    float v[4];
#pragma unroll
                    for (int r = 0; r < 4; ++r) { const float e = __expf(al - as[r]); const bool keep = (nt < wid) || (4 * fq + r <= fr); v[r] = keep ? CB[nt][r] * e : 0.f; }
                    u32x2 w2; w2.x = pk_bf16(v[0], v[1]); w2.y = pk_bf16(v[2], v[3]);
                    *(LAS u32x2*)(R1 + lrow * SP + (16 * nt + 4 * fq) * 2) = w2;
                } else if (nt == wid + 1 && !(wid & 1)) {
                    u32x2 w2; w2.x = 0u; w2.y = 0u;
                    *(LAS u32x2*)(R1 + lrow * SP + (16 * nt + 4 * fq) * 2) = w2;
                }
            }
        }
        __syncthreads();
        {
            f32x4 acc[4];
#pragma unroll
            for (int nt = 0; nt < 4; ++nt) acc[nt] = (f32x4){0.f, 0.f, 0.f, 0.f};
#pragma unroll
            for (int ks = 0; ks < 4; ++ks) if (ks <= (wid >> 1)) {
                const bf16x8 af = *(const LAS bf16x8*)(R1 + (16 * wid + fr) * SP + (32 * ks + 8 * fq) * 2);
#pragma unroll
                for (int nt = 0; nt < 4; ++nt) {
                    const bf16x8 bfr = *(const LAS bf16x8*)(R2 + (16 * nt + fr) * SP + (32 * ks + 8 * fq) * 2);
                    acc[nt] = MFMA16(bfr, af, acc[nt]);
                }
            }
            const int lrow = 16 * wid + fr;
            const float dsk = p.in[14][l * SH + h];
#pragma unroll
            for (int nt = 0; nt < 4; ++nt) {
                const int p0 = 16 * nt + 4 * fq;
                const u32x2 xs2 = *(const LAS u32x2*)(R4 + lrow * 144 + p0 * 2);
                u32x2 o2; o2.x = pk_bf16(acc[nt][0] + dsk * bf_lo(xs2.x), acc[nt][1] + dsk * bf_hi(xs2.x)); o2.y = pk_bf16(acc[nt][2] + dsk * bf_lo(xs2.y), acc[nt][3] + dsk * bf_hi(xs2.y));
                *(u32x2*)(YD + (size_t)(tg0 + lrow) * SW + h * SHD + p0) = o2;
            }
        }
        {
            f32x4 acc[4];
#pragma unroll
            for (int j = 0; j < 4; ++j) acc[j] = (f32x4){0.f, 0.f, 0.f, 0.f};
            const int mp = wid & 3, nb = 4 * (wid >> 2);
#pragma unroll
            for (int ks = 0; ks < 4; ++ks) {
                const bf16x8 af = *(const LAS bf16x8*)(R2 + 17408 + (16 * mp + fr) * SP + (32 * ks + 8 * fq) * 2);
#pragma unroll
                for (int j = 0; j < 4; ++j) {
                    const bf16x8 bfr = *(const LAS bf16x8*)(R3 + (16 * (nb + j) + fr) * SP + (32 * ks + 8 * fq) * 2);
                    acc[j] = MFMA16(bfr, af, acc[j]);
                }
            }
            bf16_t* sp = STATES + (((size_t)bc * SH + h) * SHD + 16 * mp + fr) * SN;
#pragma unroll
            for (int j = 0; j < 4; ++j) { u32x2 o2; o2.x = pk_bf16(acc[j][0], acc[j][1]); o2.y = pk_bf16(acc[j][2], acc[j][3]); *(u32x2*)(sp + 16 * (nb + j) + 4 * fq) = o2; }
        }
        __syncthreads();
    }
}

__device__ __forceinline__ void gmlp_unit(const Params& p, ldsp_t lds, int l, int u) {
    const int tid = threadIdx.x, lane = tid & 63, wid = __builtin_amdgcn_readfirstlane(tid >> 6), fr = lane & 15, fq = lane >> 4;
    const int hh = u & 7, bc = u >> 3, tg0 = bc * CH;
    const bf16_t* PROJ = (const bf16_t*)(p.ws + WS_PROJ);
    bf16_t* YMIX = (bf16_t*)(p.ws + WS_YMIX);
    ldsp_t A = lds, VT = lds + 34816;
    {
        const bf16_t* wsb = (const bf16_t*)(p.ws + WS_WSB) + ((size_t)(l * GH + hh) * 128) * 128;
#pragma unroll
        for (int i = 0; i < 4; ++i) { const int q = tid + NT * i, row = q >> 4, pc = q & 15; *(LAS u32x4*)(A + row * SP + pc * 16) = *(const u32x4*)(wsb + row * 128 + pc * 8); }
    }
    {
        const int s = tid >> 2, q4 = tid & 3;
        const bf16_t* src = PROJ + (size_t)(tg0 + s) * NPJ + 1024 + hh * 128 + q4 * 32;
        float gv[32];
#pragma unroll
        for (int i = 0; i < 4; ++i) { const u32x4 v = *(const u32x4*)(src + i * 8);
            gv[i * 8 + 0] = bf_lo(v.x); gv[i * 8 + 1] = bf_hi(v.x); gv[i * 8 + 2] = bf_lo(v.y); gv[i * 8 + 3] = bf_hi(v.y); gv[i * 8 + 4] = bf_lo(v.z); gv[i * 8 + 5] = bf_hi(v.z); gv[i * 8 + 6] = bf_lo(v.w); gv[i * 8 + 7] = bf_hi(v.w); }
        float sm = 0.f;
#pragma unroll
        for (int i = 0; i < 32; ++i) sm += gv[i];
        sm += __shfl_xor(sm, 1); sm += __shfl_xor(sm, 2);
        const float mu = sm * (1.0f / 128.0f);
        float q = 0.f;
#pragma unroll
        for (int i = 0; i < 32; ++i) { const float d = gv[i] - mu; q += d * d; }
        q += __shfl_xor(q, 1); q += __shfl_xor(q, 2);
        const float rstd = rsqrtf(q * (1.0f / 128.0f) + EPS);
        const float* lw = p.in[6] + l * 1024 + hh * 128 + q4 * 32; const float* lb = p.in[7] + l * 1024 + hh * 128 + q4 * 32;
#pragma unroll
        for (int i = 0; i < 32; ++i) *(LAS bf16_t*)(VT + (q4 * 32 + i) * SP + s * 2) = f2bf((gv[i] - mu) * rstd * lw[i] + lb[i]);
    }
    __syncthreads();
    f32x4 acc[8];
#pragma unroll
    for (int nt = 0; nt < 8; ++nt) acc[nt] = (f32x4){0.f, 0.f, 0.f, 0.f};
#pragma unroll
    for (int ks = 0; ks < 4; ++ks) if (ks <= (wid >> 1)) {
        const bf16x8 af = *(const LAS bf16x8*)(A + (16 * wid + fr) * SP + (32 * ks + 8 * fq) * 2);
#pragma unroll
        for (int nt = 0; nt < 8; ++nt) {
            const bf16x8 bfr = *(const LAS bf16x8*)(VT + (16 * nt + fr) * SP + (32 * ks + 8 * fq) * 2);
            acc[nt] = MFMA16(bfr, af, acc[nt]);
        }
    }
    {
        const int trow = 16 * wid + fr;
        const float bsv = p.in[9][l * 1024 + hh * 128 + trow];
#pragma unroll
        for (int nt = 0; nt < 8; ++nt) {
            const int p0 = 16 * nt + 4 * fq;
            const u32x2 u2 = *(const u32x2*)(PROJ + (size_t)(tg0 + trow) * NPJ + hh * 128 + p0);
            u32x2 o2; o2.x = pk_bf16(bf_lo(u2.x) * (acc[nt][0] + bsv), bf_hi(u2.x) * (acc[nt][1] + bsv)); o2.y = pk_bf16(bf_lo(u2.y) * (acc[nt][2] + bsv), bf_hi(u2.y) * (acc[nt][3] + bsv));
            *(u32x2*)(YMIX + (size_t)(tg0 + trow) * D + hh * 128 + p0) = o2;
        }
    }
    __syncthreads();
}

template <class ZF>
__device__ __forceinline__ void phase_mix(const Params& p, ldsp_t lds, int l, const ZF& zgemm) {
    const int b = (int)blockIdx.x, G = (int)gridDim.x;
    if (G == 256) {
        if (b < 96) {
            zgemm(32 + b);
            __syncthreads();
            const int n = (b < 64) ? 3 : 2, g0 = (b < 64) ? 3 * b : 192 + 2 * (b - 64);
            for (int i = 0; i < n; ++i) gmlp_unit(p, lds, l, g0 + i);
        } else if (b < 192) {
            const int c = b - 96;
            ssd_unit(p, lds, l, 2 * c); ssd_unit(p, lds, l, 2 * c + 1);
        } else {
            const int c = b - 192;
            ssd_unit(p, lds, l, 192 + c);
            for (int i = 0; i < 4; ++i) gmlp_unit(p, lds, l, 256 + 4 * c + i);
        }
    } else {
        for (int u = 32 + b; u < 128; u += G) { zgemm(u); __syncthreads(); }
        for (int u = b; u < 768; u += G) { if (u < 256) ssd_unit(p, lds, l, u); else gmlp_unit(p, lds, l, u - 256); }
    }
}

__device__ __forceinline__ void phase_scan(const Params& p) {
    const bf16_t* STATES = (const bf16_t*)(p.ws + WS_STATES); const float* ACS = (const float*)(p.ws + WS_ACS);
    bf16_t* PREV = (bf16_t*)(p.ws + WS_PREV);
    for (int idx = blockIdx.x * NT + threadIdx.x; idx < NB * SH * SHD * SN / 4; idx += gridDim.x * NT) {
        const int n4 = idx & 31, pp = (idx >> 5) & 63, h = (idx >> 11) & 15, b = idx >> 15;
        float4 st[NC]; float dec[NC];
#pragma unroll
        for (int c = 0; c < NC; ++c) {
            { const u32x2 sb = *(const u32x2*)(STATES + ((((size_t)(b * NC + c)) * SH + h) * SHD + pp) * SN + n4 * 4); st[c] = make_float4(bf_lo(sb.x), bf_hi(sb.x), bf_lo(sb.y), bf_hi(sb.y)); }
            dec[c] = ACS[((size_t)(b * NC + c) * CH + CH - 1) * SH + h];
        }
        float4 carry = make_float4(0.f, 0.f, 0.f, 0.f);
#pragma unroll
        for (int c = 0; c < NC; ++c) {
            u32x2 o; o.x = pk_bf16(carry.x, carry.y); o.y = pk_bf16(carry.z, carry.w);
            *(u32x2*)(PREV + ((((size_t)(b * NC + c)) * SH + h) * SHD + pp) * SN + n4 * 4) = o;
            const float d = __expf(dec[c]);
            carry.x = carry.x * d + st[c].x; carry.y = carry.y * d + st[c].y; carry.z = carry.z * d + st[c].z; carry.w = carry.w * d + st[c].w;
        }
    }
}

__device__ __forceinline__ void phase_yoff(const Params& p, ldsp_t lds, int l) {
    const int tid = threadIdx.x, lane = tid & 63, wid = __builtin_amdgcn_readfirstlane(tid >> 6), fr = lane & 15, fq = lane >> 4;
    const bf16_t* PROJ = (const bf16_t*)(p.ws + WS_PROJ); const float* ACS = (const float*)(p.ws + WS_ACS);
    const bf16_t* YD = (const bf16_t*)(p.ws + WS_YD); const bf16_t* PREV = (const bf16_t*)(p.ws + WS_PREV);
    bf16_t* YMIX = (bf16_t*)(p.ws + WS_YMIX);
    const float* conv_w = p.in[10] + (size_t)l * 4 * CONVD; const float* conv_b = p.in[11] + l * CONVD;
    ldsp_t CmS = lds; LAS float* red = (LAS float*)(lds + 52224);
    for (int u = blockIdx.x; u < 256; u += gridDim.x) {
        const int g = u & 1, tb = (u >> 1) & 31, b = u >> 6;
        const int tl0 = tb * 64, tg0 = b * S + tl0, bc = b * NC + (tb >> 1);
        {
            const int o = tid & 15, lg = tid >> 4, l0 = lg * 2, chx = 1280 + g * SN + o * 8, pcol = 3072 + chx;
            ConvW cw; load_convw(cw, conv_w, conv_b, chx);
            u32x4 raw[5];
#pragma unroll
            for (int r = 0; r < 5; ++r) raw[r] = ld_raw(PROJ, tg0 + l0 + r - 3, tl0 + l0 + r - 3, pcol);
#pragma unroll
            for (int i = 0; i < 2; ++i) { float ov[8]; conv8(cw, raw[i], raw[i + 1], raw[i + 2], raw[i + 3], ov); *(LAS u32x4*)(CmS + (l0 + i) * SP + o * 16) = pack8(ov); }
        }
        const int mt = wid & 3, ntb = 2 * (wid >> 2);
        const int trow = tg0 + 16 * mt + fr;
        f32x4 gval[8][2]; float ssq = 0.f;
        u32x4 pvr[2];
        {
            const bf16_t* src = PREV + (((size_t)bc * SH + g * 8) * SHD) * SN;
#pragma unroll
            for (int i = 0; i < 2; ++i) { const int q = tid + NT * i; pvr[i] = *(const u32x4*)(src + (q >> 4) * 128 + (q & 15) * 8); }
        }
#pragma unroll
        for (int hl = 0; hl < 8; ++hl) {
            const int h = g * 8 + hl;
            ldsp_t Pv = lds + 17408 + (hl & 1) * 17408;
#pragma unroll
            for (int i = 0; i < 2; ++i) { const int q = tid + NT * i; *(LAS u32x4*)(Pv + (q >> 4) * SP + (q & 15) * 16) = pvr[i]; }
            if (hl < 7) {
                const bf16_t* src = PREV + (((size_t)bc * SH + h + 1) * SHD) * SN;
#pragma unroll
                for (int i = 0; i < 2; ++i) { const int q = tid + NT * i; pvr[i] = *(const u32x4*)(src + (q >> 4) * 128 + (q & 15) * 8); }
            }
            __syncthreads();
            f32x4 acc[2] = {(f32x4){0.f, 0.f, 0.f, 0.f}, (f32x4){0.f, 0.f, 0.f, 0.f}};
#pragma unroll
            for (int ks = 0; ks < 4; ++ks) {
                const bf16x8 af = *(const LAS bf16x8*)(CmS + (16 * mt + fr) * SP + (32 * ks + 8 * fq) * 2);
#pragma unroll
                for (int j = 0; j < 2; ++j) {
                    const bf16x8 bfr = *(const LAS bf16x8*)(Pv + (16 * (ntb + j) + fr) * SP + (32 * ks + 8 * fq) * 2);
                    acc[j] = MFMA16(bfr, af, acc[j]);
                }
            }
            const float ea = __expf(ACS[(size_t)trow * SH + h]);
#pragma unroll
            for (int j = 0; j < 2; ++j) {
                const int p0 = 16 * (ntb + j) + 4 * fq;
                const u32x2 yd = *(const u32x2*)(YD + (size_t)trow * SW + h * SHD + p0);
                const u32x2 zz = *(const u32x2*)(PROJ + (size_t)trow * NPJ + 2048 + h * SHD + p0);
                f32x4 gv;
                gv[0] = (bf_lo(yd.x) + ea * acc[j][0]) * silu_f(bf_lo(zz.x)); gv[1] = (bf_hi(yd.x) + ea * acc[j][1]) * silu_f(bf_hi(zz.x));
                gv[2] = (bf_lo(yd.y) + ea * acc[j][2]) * silu_f(bf_lo(zz.y)); gv[3] = (bf_hi(yd.y) + ea * acc[j][3]) * silu_f(bf_hi(zz.y));
                gval[hl][j] = gv;
                ssq += gv[0] * gv[0] + gv[1] * gv[1] + gv[2] * gv[2] + gv[3] * gv[3];
            }
        }
        ssq += __shfl_xor(ssq, 16); ssq += __shfl_xor(ssq, 32);
        if (fq == 0) red[(wid >> 2) * 64 + 16 * mt + fr] = ssq;
        __syncthreads();
        const float tot = red[16 * mt + fr] + red[64 + 16 * mt + fr];
        const float rstd = rsqrtf(tot * (1.0f / 512.0f) + EPS);
        const float* nw = p.in[15] + l * SW;
#pragma unroll
        for (int hl = 0; hl < 8; ++hl) {
            const int h = g * 8 + hl;
#pragma unroll
            for (int j = 0; j < 2; ++j) {
                const int p0 = 16 * (ntb + j) + 4 * fq;
                const float4 w4 = *(const float4*)(nw + h * SHD + p0);
                u32x2 o2; o2.x = pk_bf16(gval[hl][j][0] * rstd * w4.x, gval[hl][j][1] * rstd * w4.y); o2.y = pk_bf16(gval[hl][j][2] * rstd * w4.z, gval[hl][j][3] * rstd * w4.w);
                *(u32x2*)(YMIX + (size_t)trow * D + 1024 + h * SHD + p0) = o2;
            }
        }
        __syncthreads();
    }
}
}

namespace mk {
#define MFMA32(a, b, c) __builtin_amdgcn_mfma_f32_32x32x16_bf16((a), (b), (c), 0, 0, 0)
constexpr int HLP = 4112;
__device__ __forceinline__ void phase_router(const Params& p, ldsp_t lds, int l, bool dummy = false) {
    const int tid = threadIdx.x, lane = tid & 63, wid = __builtin_amdgcn_readfirstlane(tid >> 6), fr = lane & 15, fq = lane >> 4, G = gridDim.x;
    const float* ADA = (const float*)(p.ws + WS_ADA); const bf16_t* X = (const bf16_t*)(p.ws + WS_X);
    bf16_t* H = (bf16_t*)(p.ws + WS_H);
    const bf16_t* RWH = (const bf16_t*)(p.ws + WS_RWH); const bf16_t* RWL = (const bf16_t*)(p.ws + WS_RWL);
    int* CNT = (int*)(p.ws + WS_CTL + CTL_CNT) + l * NE; int* LIST = (int*)(p.ws + WS_LIST); float* GW = (float*)(p.ws + WS_GW);
    if (dummy) { CNT += 4 * NE; LIST = (int*)(p.ws + WS_END); GW = (float*)(p.ws + WS_END + (size_t)NE * T * 4); }
    LAS float* LG = (LAS float*)(lds + 32 * HLP);
    LAS int* lcnt = (LAS int*)(lds + 32 * HLP + 8192);
    LAS int* lbase = lcnt + 64;
    LAS int* sinfo = lcnt + 128;
    const float* rbias = p.in[19];
    if (tid < 64) lcnt[tid] = 0;
    for (int rb = blockIdx.x; rb < T / 32; rb += G) {
        const int b = (rb * 32) / S;
        float4 Av[8], Bv[8];
#pragma unroll
        for (int j = 0; j < 8; ++j) {
            const int d = lane * 4 + 256 * j;
            const float4 nw = *(const float4*)(p.in[17] + l * D + d);
            const float4 sh = *(const float4*)(ADA + ((size_t)l * NB + b) * 6 * D + 3 * D + d);
            const float4 s2 = *(const float4*)(ADA + ((size_t)l * NB + b) * 6 * D + 4 * D + d);
            Av[j] = make_float4(nw.x * (1.f + s2.x), nw.y * (1.f + s2.y), nw.z * (1.f + s2.z), nw.w * (1.f + s2.w)); Bv[j] = sh;
        }
#pragma unroll 1
        for (int half = 0; half < 2; ++half) {
#pragma unroll
            for (int rr = 0; rr < 2; ++rr) {
                const int row = wid * 2 + rr, t = rb * 32 + half * 16 + row;
                float4 xv[8]; float ss = 0.f;
#pragma unroll
                for (int j = 0; j < 8; ++j) { const u32x2 xb = *(const u32x2*)(X + (size_t)t * D + lane * 4 + 256 * j); xv[j] = make_float4(bf_lo(xb.x), bf_hi(xb.x), bf_lo(xb.y), bf_hi(xb.y)); ss += xv[j].x * xv[j].x + xv[j].y * xv[j].y + xv[j].z * xv[j].z + xv[j].w * xv[j].w; }
#pragma unroll
                for (int o = 32; o > 0; o >>= 1) ss += __shfl_xor(ss, o);
                const float rstd = rsqrtf(ss * (1.0f / D) + EPS);
#pragma unroll
                for (int j = 0; j < 8; ++j) {
                    const int d = lane * 4 + 256 * j;
                    const float y0 = xv[j].x * rstd * Av[j].x + Bv[j].x, y1 = xv[j].y * rstd * Av[j].y + Bv[j].y, y2 = xv[j].z * rstd * Av[j].z + Bv[j].z, y3 = xv[j].w * rstd * Av[j].w + Bv[j].w;
                    u32x2 hv; hv.x = pk_bf16(y0, y1); hv.y = pk_bf16(y2, y3);
                    u32x2 lv; lv.x = pk_bf16(y0 - bf_lo(hv.x), y1 - bf_hi(hv.x)); lv.y = pk_bf16(y2 - bf_lo(hv.y), y3 - bf_hi(hv.y));
                    *(LAS u32x2*)(lds + row * HLP + d * 2) = hv;
                    *(LAS u32x2*)(lds + (16 + row) * HLP + d * 2) = lv;
                }
            }
            __syncthreads();
            {
                const int nt = wid & 3, kh = wid >> 2;
                f32x4 acc = (f32x4){0.f, 0.f, 0.f, 0.f};
                const bf16_t* bh = RWH + (size_t)(16 * nt + fr) * D + 8 * fq; const bf16_t* bl = RWL + (size_t)(16 * nt + fr) * D + 8 * fq;
#pragma unroll 8
                for (int ks = 0; ks < 32; ++ks) {
                    const int k0 = (kh * 32 + ks) * 32;
                    const bf16x8 ah = *(const LAS bf16x8*)(lds + fr * HLP + (k0 + 8 * fq) * 2);
                    const bf16x8 alo = *(const LAS bf16x8*)(lds + (16 + fr) * HLP + (k0 + 8 * fq) * 2);
                    const bf16x8 bhv = *(const bf16x8*)(bh + k0); const bf16x8 blv = *(const bf16x8*)(bl + k0);
                    acc = MFMA16(ah, bhv, acc); acc = MFMA16(ah, blv, acc); acc = MFMA16(alo, bhv, acc);
                }
#pragma unroll
                for (int r = 0; r < 4; ++r) LG[(kh * 16 + 4 * fq + r) * 64 + 16 * nt + fr] = acc[r];
            }
            __syncthreads();
#pragma unroll 1
            for (int rr = 0; rr < 2; ++rr) {
                const int row = wid * 2 + rr, t = rb * 32 + half * 16 + row;
                const float lg = LG[row * 64 + lane] + LG[(16 + row) * 64 + lane];
                const float sc = 1.0f / (1.0f + __expf(-lg)), v = sc + rbias[lane];
                float m1 = v; int i1 = lane;
#pragma unroll
                for (int o = 1; o < 8; o <<= 1) { const float ov = __shfl_xor(m1, o); const int oi = __shfl_xor(i1, o); if (ov > m1 || (ov == m1 && oi < i1)) { m1 = ov; i1 = oi; } }
                float m2 = (lane == i1) ? -1e30f : v; int i2 = lane;
#pragma unroll
                for (int o = 1; o < 8; o <<= 1) { const float ov = __shfl_xor(m2, o); const int oi = __shfl_xor(i2, o); if (ov > m2 || (ov == m2 && oi < i2)) { m2 = ov; i2 = oi; } }
                float gs = m1 + m2; int bg = lane >> 3;
#pragma unroll
                for (int o = 8; o < 64; o <<= 1) { const float ov = __shfl_xor(gs, o); const int og = __shfl_xor(bg, o); if (ov > gs || (ov == gs && og < bg)) { gs = ov; bg = og; } }
                const int e1 = __shfl(i1, bg * 8), e2 = __shfl(i2, bg * 8);
                const float u1 = __shfl(sc, e1), u2 = __shfl(sc, e2);
                if (lane == 0) {
                    const float inv = 1.0f / (u1 + u2);
                    GW[t * 2 + 0] = u1 * inv; GW[t * 2 + 1] = u2 * inv;
                    LAS int* si = sinfo + (half * 16 + row) * 4;
                    si[0] = e1; si[1] = __hip_atomic_fetch_add(lcnt + e1, 1, __ATOMIC_RELAXED, __HIP_MEMORY_SCOPE_WORKGROUP); si[2] = e2; si[3] = __hip_atomic_fetch_add(lcnt + e2, 1, __ATOMIC_RELAXED, __HIP_MEMORY_SCOPE_WORKGROUP);
                }
            }
            __syncthreads();
            if (tid < 64) { const int c = lcnt[tid]; lbase[tid] = c ? atomicAdd(&CNT[tid], c) : 0; lcnt[tid] = 0; }
            __syncthreads();
            {
                const int sl = tid >> 4, row = sl >> 1, k = sl & 1, cg = tid & 15;
                const int e = sinfo[(half * 16 + row) * 4 + 2 * k], pos = lbase[e] + sinfo[(half * 16 + row) * 4 + 2 * k + 1];
                if (cg == 0) LIST[e * T + pos] = (rb * 32 + half * 16 + row) * 2 + k;
                if (pos >= SCAP) {
                    const int tk = rb * 32 + half * 16 + row;
                    char* h8 = (char*)(p.ws + WS_H) + (size_t)tk * D;
#pragma unroll
                    for (int cc = 0; cc < 4; ++cc)
#pragma unroll
                        for (int j = 0; j < 4; ++j) {
                            const u32x4 v = *(const LAS u32x4*)(lds + row * HLP + (cg * 4 + cc) * 64 + j * 16);
                            u32x2 o; int t0 = 0, t1 = 0;
                            t0 = __builtin_amdgcn_cvt_pk_fp8_f32(bf_lo(v.x), bf_hi(v.x), t0, false); t0 = __builtin_amdgcn_cvt_pk_fp8_f32(bf_lo(v.y), bf_hi(v.y), t0, true);
                            t1 = __builtin_amdgcn_cvt_pk_fp8_f32(bf_lo(v.z), bf_hi(v.z), t1, false); t1 = __builtin_amdgcn_cvt_pk_fp8_f32(bf_lo(v.w), bf_hi(v.w), t1, true);
                            o.x = (unsigned)t0; o.y = (unsigned)t1;
                            *(u32x2*)(h8 + (cg * 4 + cc) * 32 + j * 8) = o;
                        }
                }
                if (pos < SCAP) {
                    char* hg = (char*)(p.ws + WS_HG);
#pragma unroll
                    for (int cc = 0; cc < 4; ++cc) {
                        const int ck = cg * 4 + cc;
#pragma unroll
                        for (int j = 0; j < 4; ++j) {
                            const u32x4 v = *(const LAS u32x4*)(lds + row * HLP + ck * 64 + j * 16);
                            u32x2 o; int t0 = 0, t1 = 0;
                            t0 = __builtin_amdgcn_cvt_pk_fp8_f32(bf_lo(v.x), bf_hi(v.x), t0, false); t0 = __builtin_amdgcn_cvt_pk_fp8_f32(bf_lo(v.y), bf_hi(v.y), t0, true);
                            t1 = __builtin_amdgcn_cvt_pk_fp8_f32(bf_lo(v.z), bf_hi(v.z), t1, false); t1 = __builtin_amdgcn_cvt_pk_fp8_f32(bf_lo(v.w), bf_hi(v.w), t1, true);
                            o.x = (unsigned)t0; o.y = (unsigned)t1;
                            *(u32x2*)(hg + ((size_t)((e * 64 + ck) * 4 + j) * SCAP + pos) * 8) = o;
                        }
                    }
                }
            }
            __syncthreads();
        }
    }
}

__device__ __forceinline__ void glds16_v(const void* gsrc, unsigned lds_dst) {
    unsigned keep;
    asm volatile("s_mov_b32 %0, m0\n\ts_mov_b32 m0, %2\n\ts_nop 0\n\tglobal_load_lds_dwordx4 %1, off nt\n\ts_mov_b32 m0, %0" : "=&s"(keep) : "v"(gsrc), "s"(lds_dst) : "memory");
}
template <int N> __device__ __forceinline__ void wait_vm() { asm volatile("s_waitcnt vmcnt(%0)" :: "n"(N) : "memory"); }

constexpr int MOE_L0 = 8192;
template <bool UP, int RH> struct K8 {
    static constexpr int KTOT = UP ? D : DE, KC = 32, NCH = KTOT / KC, WLD = UP ? DE : D, WCOLS = 256 / RH;
    static constexpr int S = (RH == 1) ? 3 : 4, DW = S - 1, ROWS = RH * 256, ASZ = ROWS * 32, STG = ASZ + 32 * WCOLS * 4, WP = 4 / RH, NPW = RH;
    static_assert(MOE_L0 + S * STG <= LDS_BYTES - 64, "MoE LDS map");
};
struct MoeCtx { int e, ns, ps, rows, cgi, rh, colw, rot; const char* wsrc; const char* Ablk; };

template <bool UP, int RH>
__device__ __forceinline__ void moe_setup(MoeCtx& c, const Params& p, int l, int e, int ns, int ps, int rows, const char* Ablk) {
    typedef K8<UP, RH> C;
    const int lane = threadIdx.x & 63, wid = __builtin_amdgcn_readfirstlane(threadIdx.x >> 6), r = lane & 31;
    c.e = e; c.ns = ns; c.ps = ps; c.rows = rows; c.Ablk = Ablk;
    if (UP) { if (RH == 1) { c.cgi = wid; c.rh = 0; } else { c.cgi = wid >> 1; c.rh = wid & 1; } c.colw = c.cgi * 16 + ((r >> 4) ? (C::WCOLS / 2 - 16) : 0); }
    else    { if (RH == 1) { c.cgi = wid; c.rh = 0; c.colw = c.cgi * 32; } else { c.cgi = 4 * ps + (wid >> 1); c.rh = wid & 1; c.colw = (wid >> 1) * 32; } }
    if (UP) { const int hl = (RH == 1) ? (lane >> 5) : ((lane >> 4) & 1), cl = (RH == 1) ? (lane & 31) : (lane & 15);
              c.wsrc = (const char*)((hl ? p.in[21] : p.in[20]) + ((size_t)l * NE + e) * D * DE + ns * 128 + (RH == 2 ? ps * 64 : 0) + cl * 4); }
    else c.wsrc = (const char*)(p.in[22] + ((size_t)l * NE + e) * DE * D + ns * 256 + (RH == 2 ? ps * 128 + (lane & 31) * 4 : lane * 4));
    c.wsrc += (size_t)(wid * 4 + (RH == 2 ? (lane >> 5) : 0)) * C::WLD * 4;
    c.rot = (e * 5) & (C::NCH - 1);
}
#define M8_CK(cc) ((((cc) < C::NCH ? (cc) : C::NCH - 1) + c.rot) & (C::NCH - 1))
#define M8_WISSUE(cc, st) do { const unsigned sb_ = ldsbase + (unsigned)(st) * C::STG; const int ck_ = M8_CK(cc); const int live_ = ((cc) < C::NCH) ? RH : 0; \
        _Pragma("unroll") for (int i_ = 0; i_ < C::WP; ++i_) glds16_v((const void*)(c.wsrc + ((size_t)ck_ * C::KC + i_ * live_) * C::WLD * 4), sb_ + wdst + i_ * 1024); } while (0)
template <bool UP, int RH>
__device__ __forceinline__ void moe_early(const MoeCtx& c, ldsp_t lds) {
    typedef K8<UP, RH> C;
    const int wid = __builtin_amdgcn_readfirstlane(threadIdx.x >> 6);
    const unsigned ldsbase = (unsigned)(size_t)lds + (unsigned)MOE_L0;
    const unsigned wdst = (unsigned)C::ASZ + (unsigned)(wid * 4) * (unsigned)(C::WCOLS * 4);
#pragma unroll
    for (int i = 0; i < C::DW - 1; ++i) M8_WISSUE(i, i);
    if constexpr (RH == 2) {
        const int tid = threadIdx.x, w2 = tid & 255, wv = (2 * w2 < c.rows) ? w2 : 0;
        const unsigned off = (unsigned)((tid >> 8) * (SCAP * 8) + wv * 16);
#pragma unroll
        for (int cc = 0; cc < 2; ++cc) {
            const char* ab = c.Ablk + (size_t)M8_CK(cc) * (4 * SCAP * 8) + off;
#pragma unroll
            for (int i = 0; i < C::NPW; ++i) glds16_v((const void*)(ab + i * 2 * (SCAP * 8)), ldsbase + (unsigned)cc * C::STG + (unsigned)wid * 1024u + (unsigned)i * 8192u);
        }
    }
}
template <bool UP, int RH, int NJ, bool GATH>
__device__ __forceinline__ void moe_main(f32x16 (&acc)[8], const MoeCtx& c, ldsp_t lds, const LAS int* rowsS) {
    typedef K8<UP, RH> C;
    constexpr int ROWS = C::ROWS, NPW = C::NPW, WP = C::WP, S = C::S, DW = C::DW, WCOLS = C::WCOLS;
    constexpr float WSC = UP ? 64.f : 32.f;
    const int tid = threadIdx.x, lane = tid & 63, wid = __builtin_amdgcn_readfirstlane(tid >> 6), r = lane & 31, hh = lane >> 5;
    const unsigned ldsbase = (unsigned)(size_t)lds + (unsigned)MOE_L0;
    const unsigned lane16 = (unsigned)lane * 16u, adst = (unsigned)wid * 1024u;
    const unsigned wdst = (unsigned)C::ASZ + (unsigned)(wid * 4) * (unsigned)(WCOLS * 4);
    const unsigned wrd = (unsigned)C::ASZ + (unsigned)((8 * hh) * WCOLS + c.colw + r) * 4u;
    const unsigned ard8 = (unsigned)(hh * (ROWS * 8)) + (unsigned)((32 * c.rh + r) * 8);
    unsigned goff[NPW];
#pragma unroll
    for (int i = 0; i < NPW; ++i) {
        if (GATH) { const int slot = rowsS[tid >> 1]; goff[i] = (unsigned)(UP ? (slot >> 1) : slot) * (unsigned)(UP ? D : DE) + (unsigned)((tid & 1) * 16); }
        else {
            const int w2 = (RH == 1) ? (tid & 127) : (tid & 255), wv = (2 * w2 < c.rows) ? w2 : 0;
            goff[i] = (RH == 1) ? (unsigned)((tid >> 7) * (SCAP * 8) + wv * 16) : (unsigned)((tid >> 8) * (SCAP * 8) + wv * 16 + i * 2 * (SCAP * 8));
        }
    }
    u32x4 ra0[NPW], ra1[NPW];
#define M8_AISSUE(cc, RA) do { const void* ab_ = (const void*)(c.Ablk + (size_t)M8_CK(cc) * (GATH ? 32 : 4 * SCAP * 8)); \
        _Pragma("unroll") for (int i_ = 0; i_ < NPW; ++i_) asm volatile("global_load_dwordx4 %0, %1, %2" : "=v"(RA[i_]) : "v"(goff[i_]), "s"(ab_) : "memory"); } while (0)
#define M8_ALAND(st, RA, N, AOK) do { \
        if (NPW == 1) asm volatile("s_waitcnt vmcnt(%1)" : "+v"(RA[0]) : "n"(N) : "memory"); \
        if (NPW == 2) asm volatile("s_waitcnt vmcnt(%2)" : "+v"(RA[0]), "+v"(RA[NPW > 1 ? 1 : 0]) : "n"(N) : "memory"); \
        if (!(AOK)) { } else \
        if (GATH) { ldsp_t ap_ = lds + MOE_L0 + (st) * C::STG + (unsigned)((tid & 1) * 2 * (ROWS * 8) + (tid >> 1) * 8); \
                    *(LAS u32x2*)(ap_) = (u32x2){RA[0].x, RA[0].y}; *(LAS u32x2*)(ap_ + ROWS * 8) = (u32x2){RA[0].z, RA[0].w}; } \
        else { ldsp_t ap_ = lds + MOE_L0 + (st) * C::STG + adst + lane16; \
               _Pragma("unroll") for (int i_ = 0; i_ < NPW; ++i_) *(LAS u32x4*)(ap_ + i_ * 8192) = RA[i_]; } } while (0)
#define M8_STEP(cq, RAI, RAC, AOK) do { \
        asm volatile("s_waitcnt lgkmcnt(0)" ::: "memory"); \
        __builtin_amdgcn_s_barrier();                       \
        asm volatile("" ::: "memory"); \
        M8_AISSUE((cq) + 2, RAI); \
        { const int sn_ = (st == 0) ? S - 1 : st - 1; M8_WISSUE((cq) + DW, sn_); } \
        { ldsp_t sp = lds + MOE_L0 + st * C::STG; \
          _Pragma("unroll") for (int ks = 0; ks < 2; ++ks) { \
            float w[8]; long af[NJ]; \
            _Pragma("unroll") for (int j = 0; j < 8; ++j) w[j] = *(const LAS float*)(sp + wrd + (ks * 16 + j) * (WCOLS * 4)); \
            _Pragma("unroll") for (int j = 0; j < NJ; ++j) af[j] = *(const LAS long*)(sp + ard8 + ks * (2 * ROWS * 8) + j * (RH * 256)); \
            int lo_ = 0, hi_ = 0; \
            lo_ = __builtin_amdgcn_cvt_pk_fp8_f32(w[0] * WSC, w[1] * WSC, lo_, false); lo_ = __builtin_amdgcn_cvt_pk_fp8_f32(w[2] * WSC, w[3] * WSC, lo_, true); \
            hi_ = __builtin_amdgcn_cvt_pk_fp8_f32(w[4] * WSC, w[5] * WSC, hi_, false); hi_ = __builtin_amdgcn_cvt_pk_fp8_f32(w[6] * WSC, w[7] * WSC, hi_, true); \
            const long wf = (long)(((unsigned long long)(unsigned)hi_ << 32) | (unsigned long long)(unsigned)lo_); \
            _Pragma("unroll") for (int j = 0; j < NJ; ++j) acc[j] = __builtin_amdgcn_mfma_f32_32x32x16_fp8_fp8(wf, af[j], acc[j], 0, 0, 0); } } \
        st = (st == S - 1) ? 0 : st + 1; \
        M8_ALAND(st, RAC, 2 * WP + NPW, AOK);               \
        if (DW == 2) wait_vm<WP + NPW>();                    \
    } while (0)
    int st = 0;
    constexpr bool EARLYA = (RH == 2) && !GATH;
    if constexpr (EARLYA) {
#pragma unroll
        for (int i = 0; i < NPW; ++i) ra1[i] = (u32x4){0u, 0u, 0u, 0u};
        M8_WISSUE(DW - 1, DW - 1);
        wait_vm<WP>();
    } else {
        M8_AISSUE(0, ra0); M8_AISSUE(1, ra1); M8_WISSUE(DW - 1, DW - 1);
        M8_ALAND(0, ra0, NPW + WP, true);
    }
#pragma unroll 1
    for (int cq = 0; cq < C::NCH; cq += 2) {
        M8_STEP(cq, ra0, ra1, !EARLYA || cq > 0);
        M8_STEP(cq + 1, ra1, ra0, true);
    }
    wait_vm<0>();
    asm volatile("s_waitcnt lgkmcnt(0)" ::: "memory");
#undef M8_STEP
#undef M8_ALAND
#undef M8_AISSUE
}
#undef M8_WISSUE
#undef M8_CK

template <bool UP, int RH, bool SRT>
__device__ __forceinline__ void moe_epilogue(const f32x16 (&acc)[8], const MoeCtx& c, const Params& p, const LAS int* rowsS) {
    const int lane = threadIdx.x & 63, hh = lane >> 5;
    int r_e = lane & 31; asm volatile("" : "+v"(r_e));
    const int e = c.e, ns = c.ns, ps = c.ps, rows = c.rows, cgi = c.cgi, rh = c.rh;
    if (UP) {
        const int cis = (RH == 2 ? ps * 64 : 0) + cgi * 16;
        char* actsb = (char*)(p.ws + WS_ACTS) + ((size_t)(e * 16 + ns * 4 + (cis >> 5)) * 4 + ((cis >> 3) & 3)) * (SCAP * 8);
        char* act8 = (char*)(p.ws + WS_ACT);
#pragma unroll
        for (int mt = 0; mt < 8; ++mt) {
            const int row = 32 * (RH * mt + rh) + r_e;
            const int slot = rowsS[row & 511];
#pragma unroll
            for (int q = 0; q < 2; ++q) {
                constexpr float ISC = 1.0f / 64.0f;
                const float a0 = silu_f(acc[mt][q * 4 + 0] * ISC) * (acc[mt][(q + 2) * 4 + 0] * ISC), a1 = silu_f(acc[mt][q * 4 + 1] * ISC) * (acc[mt][(q + 2) * 4 + 1] * ISC);
                const float a2 = silu_f(acc[mt][q * 4 + 2] * ISC) * (acc[mt][(q + 2) * 4 + 2] * ISC), a3 = silu_f(acc[mt][q * 4 + 3] * ISC) * (acc[mt][(q + 2) * 4 + 3] * ISC);
                int t8 = 0; t8 = __builtin_amdgcn_cvt_pk_fp8_f32(a0, a1, t8, false); t8 = __builtin_amdgcn_cvt_pk_fp8_f32(a2, a3, t8, true);
                if (row < rows) {
                    if (SRT) *(int*)(actsb + ((unsigned)(q * (SCAP * 8)) + (unsigned)row * 8u + 4u * (unsigned)hh)) = t8;
                    else *(int*)(act8 + (size_t)slot * DE + ns * 128 + cis + 8 * q + 4 * hh) = t8;
                }
            }
        }
    } else {
        char* O8 = (char*)(p.ws + WS_O);
#pragma unroll
        for (int mt = 0; mt < 8; ++mt) {
            const int row = 32 * (RH * mt + rh) + r_e;
            const int slot = rowsS[row & 511];
            const float gwv = ((const LAS float*)(rowsS + 1024))[row & 511] * (1.0f / 32.0f);
            int t8[4];
#pragma unroll
            for (int q = 0; q < 4; ++q) { int t = 0; t = __builtin_amdgcn_cvt_pk_fp8_f32(acc[mt][q * 4 + 0] * gwv, acc[mt][q * 4 + 1] * gwv, t, false); t = __builtin_amdgcn_cvt_pk_fp8_f32(acc[mt][q * 4 + 2] * gwv, acc[mt][q * 4 + 3] * gwv, t, true); t8[q] = t; }
            const int s0 = hh ? t8[0] : t8[2], s1 = hh ? t8[1] : t8[3];
            const int r0 = __shfl_xor(s0, 32), r1 = __shfl_xor(s1, 32);
            u32x4 o4;
            if (hh) { o4.x = (unsigned)r0; o4.y = (unsigned)t8[2]; o4.z = (unsigned)r1; o4.w = (unsigned)t8[3]; }
            else    { o4.x = (unsigned)t8[0]; o4.y = (unsigned)r0; o4.z = (unsigned)t8[1]; o4.w = (unsigned)r1; }
            if (row < rows) *(u32x4*)(O8 + (size_t)slot * D + ns * 256 + cgi * 32 + 16 * hh) = o4;
        }
    }
}
template <bool UP, int RH, bool GATH>
__device__ __forceinline__ void moe_run(f32x16 (&acc)[8], const MoeCtx& c, ldsp_t lds, const LAS int* rowsS) {
#pragma unroll
    for (int mt = 0; mt < 8; ++mt)
#pragma unroll
        for (int i = 0; i < 16; ++i) acc[mt][i] = 0.f;
    const int nmt = (c.rows + 31) >> 5, njmax = (RH == 2) ? ((nmt + 1) >> 1) : nmt;
    if (njmax <= 4)      moe_main<UP, RH, 4, GATH>(acc, c, lds, rowsS);
    else if (njmax <= 5) moe_main<UP, RH, 5, GATH>(acc, c, lds, rowsS);
    else if (njmax <= 6) moe_main<UP, RH, 6, GATH>(acc, c, lds, rowsS);
    else                 moe_main<UP, RH, 8, GATH>(acc, c, lds, rowsS);
}

template <bool UP>
__device__ __forceinline__ void phase_moe(const Params& p, ldsp_t lds, int l) {
    constexpr int NSL2 = UP ? 8 : 16, NUN = NE * NSL2;
    const int tid = threadIdx.x, G = gridDim.x;
    const int* CNT = (const int*)(p.ws + WS_CTL + CTL_CNT) + l * NE; const int* LIST = (const int*)(p.ws + WS_LIST);
    const char* Agat = UP ? (const char*)(p.ws + WS_H) : (const char*)(p.ws + WS_ACT);
    LAS int* rowsS = (LAS int*)lds;
    const int vid = *(const LAS int*)(lds + LDS_BYTES - 32);
    LAS int* perm = (LAS int*)(lds + LDS_BYTES - 64 - 256);
    __syncthreads();
    if (tid < 64) {
        const int cj = CNT[tid];
        int rank = 0;
#pragma unroll
        for (int i = 0; i < 64; ++i) { const int ci = __builtin_amdgcn_readlane(cj, i); rank += (ci > cj || (ci == cj && i < tid)) ? 1 : 0; }
        const int t = rank >> 3, pos = rank & 7;
        perm[((t & 1) ? 7 - pos : pos) * 8 + t] = tid;
    }
    __syncthreads();
#define MOE_SLOT(s_) (UP ? ((s_) < 4 ? (s_) : 11 - (s_)) : ((s_) ^ (((s_) >> 1) & 1)))
#define MOE_UNIT(u, e_, ns_, ps_, cnt_) do { const int xq_ = (u) & 7, jq_ = (u) >> 3, sub_ = jq_ % NSL2, sl_ = jq_ / NSL2; e_ = perm[xq_ * 8 + MOE_SLOT(sl_)]; ns_ = sub_ >> 1; ps_ = sub_ & 1; cnt_ = CNT[e_]; } while (0)
#define MOE_ROWS(buf, e_, m0_, rows_) do { const int sl_ = LIST[(e_) * T + (m0_) + (tid < (rows_) ? tid : 0)]; rowsS[(buf) * 512 + tid] = sl_; \
        if (!UP) ((LAS float*)(rowsS + 1024))[(buf) * 512 + tid] = ((const float*)(p.ws + WS_GW))[sl_]; } while (0)
#define MOE_ASRT(e_) ((const char*)(p.ws + (UP ? WS_HG : WS_ACTS) + (size_t)(e_) * (UP ? 64 : 16) * (4 * SCAP * 8)))
    int u = vid, e = 0, ns = 0, ps = 0, cnt = 0;
    while (u < NUN) { MOE_UNIT(u, e, ns, ps, cnt); if (cnt > 0) break; u += G; }
    if (u >= NUN) return;
    int buf = 0;
    MoeCtx ctx;
    { const int rows = cnt < SCAP ? cnt : SCAP; __syncthreads(); MOE_ROWS(buf, e, 0, rows); moe_setup<UP, 2>(ctx, p, l, e, ns, ps, rows, MOE_ASRT(e)); wait_vm<0>(); moe_early<UP, 2>(ctx, lds); }
    for (;;) {
        int un = u + G, en = 0, nsn = 0, psn = 0, cntn = 0;
        while (un < NUN) { MOE_UNIT(un, en, nsn, psn, cntn); if (cntn > 0) break; un += G; }
        const bool haven = un < NUN;
        f32x16 acc[8];
        moe_run<UP, 2, false>(acc, ctx, lds, rowsS + buf * 512);
        __syncthreads();
        MoeCtx nctx = ctx;
        const bool chain = haven && cnt <= SCAP;
        if (chain) { const int rows = cntn < SCAP ? cntn : SCAP; MOE_ROWS(buf ^ 1, en, 0, rows); moe_setup<UP, 2>(nctx, p, l, en, nsn, psn, rows, MOE_ASRT(en)); moe_early<UP, 2>(nctx, lds); }
        moe_epilogue<UP, 2, true>(acc, ctx, p, rowsS + buf * 512);
        if (cnt > SCAP) {
#pragma unroll 1
            for (int m0 = SCAP; m0 < cnt; m0 += 256) {
                const int rows = (cnt - m0 < 256) ? (cnt - m0) : 256;
                __syncthreads();
                MOE_ROWS(buf, e, m0, rows);
                __syncthreads();
                if (ps == 0) {
                    MoeCtx fc; moe_setup<UP, 1>(fc, p, l, e, ns, 0, rows, Agat);
                    wait_vm<0>(); moe_early<UP, 1>(fc, lds);
                    moe_run<UP, 1, true>(acc, fc, lds, rowsS + buf * 512);
                    __syncthreads();
                    moe_epilogue<UP, 1, false>(acc, fc, p, rowsS + buf * 512);
                }
            }
        }
        if (!haven) break;
        if (!chain) { const int rows = cntn < SCAP ? cntn : SCAP; __syncthreads(); MOE_ROWS(buf ^ 1, en, 0, rows); moe_setup<UP, 2>(nctx, p, l, en, nsn, psn, rows, MOE_ASRT(en)); wait_vm<0>(); moe_early<UP, 2>(nctx, lds); }
        ctx = nctx; u = un; e = en; ns = nsn; ps = psn; cnt = cntn; buf ^= 1;
    }
#undef MOE_ASRT
#undef MOE_ROWS
#undef MOE_UNIT
#undef MOE_SLOT
}
}

#ifndef MK_KIND_MASK
#define MK_KIND_MASK 0x3ff
#endif
#define KIND(k) (((MK_KIND_MASK) >> (k)) & 1)
#ifndef MK_REP_MASK
#define MK_REP_MASK 0
#endif
#define NREP(k) (1 + (((MK_REP_MASK) >> (k)) & 1))
namespace mk {
constexpr int N_PHASES = 20;
constexpr int LDS_MISC = LDS_BYTES - 64;

#ifdef MK_STREAMTEST
__device__ __forceinline__ void phase_streamtest(const Params& p) {
    const int tid = threadIdx.x, w = blockIdx.x;
    const float* base = p.in[20];
    float4 acc = make_float4(0.f, 0.f, 0.f, 0.f);
    if (MK_STREAMTEST == 1) {
        const float4* src = (const float4*)(base + (size_t)w * 262144) + tid;
#pragma unroll 8
        for (int i = 0; i < 128; ++i) { const float4 v = src[(size_t)i * 512]; acc.x += v.x; acc.y += v.y; acc.z += v.z; acc.w += v.w; }
    } else {
        const int e = w >> 2, ns = w & 3;
        const float4* src = (const float4*)(base + (size_t)e * D * DE + ns * 128 + (size_t)(tid >> 5) * DE) + (tid & 31);
#pragma unroll 8
        for (int i = 0; i < 128; ++i) { const float4 v = src[(size_t)i * 16 * DE / 4]; acc.x += v.x; acc.y += v.y; acc.z += v.z; acc.w += v.w; }
    }
    const float s = acc.x + acc.y + acc.z + acc.w;
    if (s != s) ((float*)(p.ws + WS_END))[tid] = s;
}
#endif
struct SkipZOrder : pg8::StaticOrder {
    __device__ bool next(int i, pg8::Unit& u) const {
        const long L = (long)i * G + c;
        if (L < 480) { if (!pg8::StaticOrder::next(i, u)) return false; if (u.pn >= 8) u.pn += 4; return true; }
        if (L < 512) { const int z = (int)L - 480; u.pm = z >> 2; u.pn = 8 + (z & 3); return true; }
        return false;
    }
};
struct OneUnitOrder {
    int pm, pn;
    __device__ bool next(int i, pg8::Unit& u) const { if (i) return false; u.pm = pm; u.pn = pn; return true; }
    __device__ __forceinline__ void a_ready(const pg8::Unit&) const {}
    __device__ __forceinline__ void done(const pg8::Unit&) const {}
};
template <int L>
__device__ __forceinline__ void run_layer(const Params& p, ldsp_t lds, const XcdBarrier& bar, int lo, int hi) {
    constexpr int PB = 1 + 9 * L;
#define IN(k) (lo <= (k) && (k) < hi)
#define SEAM(k) do { if (IN(k) && IN((k) + 1)) xcd_barrier(bar); } while (0)
    if (KIND(1) && IN(PB + 0)) { if (L == 0) { { phase_norm<0>(p, 0); if constexpr ((NREP(1)) > 1) { __syncthreads(); phase_norm<0>(p, 0); __syncthreads(); } } } else phase_norm<1>(p, L); }
    SEAM(PB + 0);
    if (KIND(2) && IN(PB + 1)) {
        pg8::Gemm g{(const pg8::bf16_t*)(p.ws + WS_H), (const pg8::bf16_t*)(p.ws + WS_WTIN) + (size_t)L * NPAD * D, T, NPAD, D};
        SkipZOrder So; So.init(T, NPAD - 1024, (int)gridDim.x, (int)blockIdx.x);
        EpiProj E{(bf16_t*)(p.ws + WS_PROJ), (float*)(p.ws + WS_DT), p.in[12] + L * SH};
        { pg8::gemm_phase<EpiProj, SkipZOrder, true, true>((PG8_LAS unsigned char*)lds, g, So, E); if constexpr ((NREP(2)) > 1) { __syncthreads(); pg8::gemm_phase<EpiProj, SkipZOrder, true, true>((PG8_LAS unsigned char*)lds, g, So, E); __syncthreads(); } }
    }
    SEAM(PB + 1);
    if (KIND(3) && IN(PB + 2)) {
        auto zgemm = [&](int zu) {
            pg8::Gemm g{(const pg8::bf16_t*)(p.ws + WS_H), (const pg8::bf16_t*)(p.ws + WS_WTIN) + (size_t)L * NPAD * D, T, NPAD, D};
            OneUnitOrder So{zu >> 2, 8 + (zu & 3)};
            EpiProj E{(bf16_t*)(p.ws + WS_PROJ), (float*)(p.ws + WS_DT), p.in[12] + L * SH};
            pg8::gemm_phase<EpiProj, OneUnitOrder, true, true>((PG8_LAS unsigned char*)lds, g, So, E);
        };
        phase_mix(p, lds, L, zgemm); if constexpr ((NREP(3)) > 1) { __syncthreads(); phase_mix(p, lds, L, zgemm); __syncthreads(); }
    }
    SEAM(PB + 2);
    if (KIND(4) && IN(PB + 3)) { phase_scan(p); if constexpr ((NREP(4)) > 1) { __syncthreads(); phase_scan(p); __syncthreads(); } }
    SEAM(PB + 3);
    if (KIND(5) && IN(PB + 4)) { phase_yoff(p, lds, L); if constexpr ((NREP(5)) > 1) { __syncthreads(); phase_yoff(p, lds, L); __syncthreads(); } }
    SEAM(PB + 4);
    if (KIND(6) && IN(PB + 5)) {
        pg8::Gemm g{(const pg8::bf16_t*)(p.ws + WS_YMIX), (const pg8::bf16_t*)(p.ws + WS_WTOUT) + (size_t)L * D * D, T, D, D};
        pg8::StaticOrder So; So.init(T, D, (int)gridDim.x, (int)blockIdx.x);
        EpiRes<(L == 0)> E{(L == 0) ? p.in[0] : (const float*)nullptr, (bf16_t*)(p.ws + WS_X), (const float*)(p.ws + WS_ADA) + (size_t)L * NB * 6 * D + 2 * D};
        { pg8::gemm_phase<EpiRes<(L == 0)>, pg8::StaticOrder, true, true>((PG8_LAS unsigned char*)lds, g, So, E); if constexpr (((L == 0 ? NREP(6) : 1)) > 1) { __syncthreads(); pg8::gemm_phase<EpiRes<(L == 0)>, pg8::StaticOrder, true, true>((PG8_LAS unsigned char*)lds, g, So, E); __syncthreads(); } }
    }
    SEAM(PB + 5);
    if (KIND(7) && IN(PB + 6)) { phase_router(p, lds, L); if constexpr ((NREP(7)) > 1) { __syncthreads(); phase_router(p, lds, L, true); __syncthreads(); } }
    SEAM(PB + 6);
    if (KIND(8) && IN(PB + 7)) { phase_moe<true>(p, lds, L); if constexpr ((NREP(8)) > 1) { __syncthreads(); phase_moe<true>(p, lds, L); __syncthreads(); } }
    SEAM(PB + 7);
    if (KIND(9) && IN(PB + 8)) { phase_moe<false>(p, lds, L); if constexpr ((NREP(9)) > 1) { __syncthreads(); phase_moe<false>(p, lds, L); __syncthreads(); } }
    SEAM(PB + 8);
#undef IN
#undef SEAM
}

__global__ void __launch_bounds__(NT, 2) mk_fwd(Params p) {
    extern __shared__ __attribute__((aligned(16))) unsigned char lds_raw[];
    ldsp_t lds = (ldsp_t)lds_raw;
    const int lo = p.ph_lo, hi = p.ph_hi;
    volatile LAS unsigned* misc = (volatile LAS unsigned*)(lds + LDS_MISC);
    if (threadIdx.x < 16) misc[threadIdx.x] = 0u;
    __syncthreads();
    XcdBarrier bar; bar.bar = (unsigned*)(p.ws + WS_CTL); bar.x = 0; bar.st = misc;
    if (hi - lo > 1) bar = xcd_barrier_post((unsigned*)(p.ws + WS_CTL), misc);
    if (threadIdx.x == 0) { const unsigned myx = xb_xcc_id() & 7u; misc[9] = myx; misc[10] = __hip_atomic_fetch_add((unsigned*)(p.ws + WS_CTL + CTL_CNT + 4096) + myx * 16 + (lo > 0 ? 8 : 0), 1u, __ATOMIC_RELAXED, __HIP_MEMORY_SCOPE_AGENT); misc[8] = blockIdx.x; }
#ifdef MK_STREAMTEST
    if (lo <= 0) { phase_streamtest(p); __syncthreads(); }
#endif
    if (KIND(0) && lo <= 0 && 0 < hi) { phase_prologue(p, lds, 2, (int)blockIdx.x, (int)gridDim.x); if constexpr ((NREP(0)) > 1) { __syncthreads(); phase_prologue(p, lds, 2, (int)blockIdx.x, (int)gridDim.x); __syncthreads(); } }
    if (lo <= 0 && 1 < hi) xcd_barrier(bar);
    if (hi - lo > 1 && threadIdx.x == 0) {
        bool even = (gridDim.x & 7u) == 0u;
        for (int j = 0; j < 16; ++j) { const unsigned c = xb_ld(&bar.bar[XB_XCNT(j)]); if (c != ((j < 8) ? gridDim.x / 8u : 0u)) even = false; }
        if (even) misc[8] = misc[9] + 8u * misc[10];
    }
    __syncthreads();
    run_layer<0>(p, lds, bar, lo, hi);
#ifdef MK_XBAR
    for (int xb = 0; xb < MK_XBAR; ++xb) xcd_barrier(bar);
#endif
    run_layer<1>(p, lds, bar, lo, hi);
    if (KIND(1) && lo <= 19 && 19 < hi) { phase_norm<2>(p, 1); if constexpr ((NREP(1)) > 1) { __syncthreads(); phase_norm<2>(p, 1); __syncthreads(); } }
}
}

extern "C" void kernel_launch(void* const* d_in, const int* in_sizes, int n_in, void* d_out, int out_size, void* d_ws, size_t ws_size, hipStream_t stream) {
    using namespace mk;
    static int grid = 0;
    if (grid == 0) {
        if (n_in != 24 || ws_size < WS_END) { fprintf(stderr, "kernel_launch: unexpected inputs (n_in %d, ws %zu < %zu)\n", n_in, ws_size, (size_t)WS_END); grid = -1; return; }
        int dev = 0, cus = 0, per_cu = 0;
        if (hipGetDevice(&dev) != hipSuccess || hipDeviceGetAttribute(&cus, hipDeviceAttributeMultiprocessorCount, dev) != hipSuccess) { grid = -1; return; }
        if (hipFuncSetAttribute((const void*)mk_fwd, hipFuncAttributeMaxDynamicSharedMemorySize, LDS_BYTES) != hipSuccess) { fprintf(stderr, "kernel_launch: hipFuncSetAttribute failed\n"); grid = -1; return; }
        if (hipOccupancyMaxActiveBlocksPerMultiprocessor(&per_cu, (const void*)mk_fwd, NT, LDS_BYTES) != hipSuccess || per_cu < 1) fprintf(stderr, "kernel_launch: occupancy query says %d\n", per_cu);
        (void)hipGetLastError();
        grid = cus;
    }
    if (grid < 0) return;
    (void)in_sizes; (void)out_size;
    if (hipMemsetAsync((char*)d_ws + WS_CTL, 0, CTL_BYTES, stream) != hipSuccess) return;
    Params prm{};
    for (int i = 0; i < 24; ++i) prm.in[i] = (const float*)d_in[i];
    prm.out = (float*)d_out; prm.ws = (unsigned char*)d_ws;
#if MK_N_LAUNCHES == 1
    prm.ph_lo = 0; prm.ph_hi = N_PHASES;
    hipLaunchKernelGGL(mk_fwd, dim3(grid), dim3(NT), LDS_BYTES, stream, prm);
#else
    for (int k = 0; k < N_PHASES; ++k) { prm.ph_lo = k; prm.ph_hi = k + 1; hipLaunchKernelGGL(mk_fwd, dim3(grid), dim3(NT), LDS_BYTES, stream, prm); }
#endif
    const hipError_t le = hipPeekAtLastError();
    if (le != hipSuccess) fprintf(stderr, "kernel_launch: launch failed: %s\n", hipGetErrorName(le));
}
```

```cpp
#include <hip/hip_runtime.h>
#include <stdint.h>
#include <stdio.h>

#ifndef MK_N_LAUNCHES
#define MK_N_LAUNCHES 1
#endif

namespace mk {
constexpr int D = 2048, NB = 4, S = 2048, T = NB * S;
constexpr int GH = 8, CH = 128, NC = S / CH;
constexpr int SW = 1024, SHD = 64, SH = 16, SG = 2, SN = 128, CONVD = 1536, NPROJ = 4624;
constexpr int NPJ = 4608;
constexpr int NPAD = 4864;
constexpr int NE = 64, NGRP = 8, EPG = 8, DE = 512;
constexpr float EPS = 1e-6f;
constexpr int NT = 512;
constexpr int LDS_BYTES = 160 * 1024 - 512;

typedef unsigned short bf16_t;
typedef short bf16x8 __attribute__((ext_vector_type(8)));
typedef float f32x4 __attribute__((ext_vector_type(4)));
typedef float f32x16 __attribute__((ext_vector_type(16)));
typedef unsigned u32x4 __attribute__((ext_vector_type(4)));
typedef unsigned u32x2 __attribute__((ext_vector_type(2)));

constexpr size_t al(size_t x) { return (x + 255) & ~(size_t)255; }
constexpr size_t WS_CTL = 0, CTL_BYTES = 64 * 1024;
constexpr size_t CTL_CNT = 32 * 1024;
constexpr size_t WS_ADA = WS_CTL + CTL_BYTES;
constexpr size_t WS_WTIN = WS_ADA + al((size_t)2 * NB * 6 * D * 4);
constexpr size_t WS_WTOUT = WS_WTIN + al((size_t)2 * NPAD * D * 2);
constexpr size_t WS_RWH = WS_WTOUT + al((size_t)2 * D * D * 2);
constexpr size_t WS_RWL = WS_RWH + al((size_t)NE * D * 2);
constexpr size_t WS_WSB = WS_RWL + al((size_t)NE * D * 2);
constexpr size_t WS_X = WS_WSB + al((size_t)2 * GH * 128 * 128 * 2);
constexpr size_t WS_H = WS_X + al((size_t)T * D * 4);
constexpr size_t WS_PROJ = WS_H + al((size_t)T * D * 2);
constexpr size_t WS_DT = WS_PROJ + al((size_t)T * NPJ * 2);
constexpr size_t WS_ACS = WS_DT + al((size_t)T * SH * 4);
constexpr size_t WS_YD = WS_ACS + al((size_t)T * SH * 4);
constexpr size_t WS_STATES = WS_YD + al((size_t)T * SW * 2);
constexpr size_t WS_PREV = WS_STATES + al((size_t)NB * NC * SH * SHD * SN * 4);
constexpr size_t WS_YMIX = WS_PREV + al((size_t)NB * NC * SH * SHD * SN * 2);
constexpr size_t WS_LIST = WS_YMIX + al((size_t)T * D * 2);
constexpr size_t WS_GW = WS_LIST + al((size_t)NE * T * 4);
constexpr size_t WS_ACT = WS_GW + al((size_t)T * 2 * 4);
constexpr size_t WS_O = WS_ACT + al((size_t)T * 2 * DE * 2);
#ifndef MK_SCAP
#define MK_SCAP 512
#endif
constexpr int SCAP = MK_SCAP;
constexpr size_t WS_HG = WS_O + al((size_t)T * 2 * D * 2);
constexpr size_t WS_ACTS = WS_HG + al((size_t)NE * 64 * SCAP * 64);
constexpr size_t WS_END = WS_ACTS + al((size_t)NE * 16 * SCAP * 64);

struct Params {
    const float* in[24];
    float* out;
    unsigned char* ws;
    int ph_lo, ph_hi;
};

__device__ __forceinline__ float silu_f(float x) { return x * __builtin_amdgcn_rcpf(1.0f + __expf(-x)); }
__device__ __forceinline__ float softplus_f(float x) { return x > 20.f ? x : log1pf(__expf(x)); }
typedef __bf16 bf16x2_t __attribute__((ext_vector_type(2)));
__device__ __forceinline__ unsigned pk_bf16(float lo, float hi) { bf16x2_t v; v.x = (__bf16)lo; v.y = (__bf16)hi; return __builtin_bit_cast(unsigned, v); }
__device__ __forceinline__ float bf_lo(unsigned u) { return __uint_as_float(u << 16); }
__device__ __forceinline__ float bf_hi(unsigned u) { return __uint_as_float(u & 0xffff0000u); }
__device__ __forceinline__ bf16_t f2bf(float f) { return (bf16_t)(pk_bf16(f, 0.f) & 0xffffu); }
}

namespace pg8 {
#define PG8_LAS __attribute__((address_space(3)))
typedef unsigned short bf16_t;
typedef short bf16x8 __attribute__((ext_vector_type(8)));
typedef float f32x4 __attribute__((ext_vector_type(4)));
typedef unsigned u32x4 __attribute__((ext_vector_type(4)));
constexpr int BM = 256, BK = 64, HALF = 128, HTB = HALF * BK * 2  , STAGE_BYTES = 8 * HTB, NXCD = 8, WGM = 8;

__host__ __device__ __forceinline__ int lds_byte(int r, int c) { const int st = (r >> 4) * 2 + (c >> 5), rr = r & 15, cc = c & 31, ob = rr * 64 + cc * 2; return st * 1024 + (ob ^ (((ob >> 9) & 1) << 5)); }
__host__ __device__ __forceinline__ void stage_rc(int b, int& R, int& C) { const int st = b / 1024, sb = b % 1024, swz = sb ^ (((sb >> 9) & 1) << 5); R = (st >> 1) * 16 + swz / 64; C = (st & 1) * 32 + (swz % 64) / 2; }
__host__ __device__ __forceinline__ int perm32(int rho) { const int n = rho >> 4, i = rho & 15; return 8 * (i >> 2) + 4 * n + (i & 3); }

struct Unit { int pm, pn; };
struct Gemm { const bf16_t* A; const bf16_t* Bt; int M, N, K; };

struct StaticOrder {
    int nM, nN, nwg, G, c;
    __host__ __device__ void init(int M, int N, int G_, int c_) { nM = M / BM; nN = N / BM; nwg = nM * nN; G = G_; c = c_; }
    __host__ __device__ bool next(int i, Unit& u) const {
        const long L = (long)i * G + c; if (L >= nwg) return false;
        int wgid = (int)L; { const int q = nwg / NXCD, r = nwg % NXCD, xcd = wgid % NXCD, off = wgid / NXCD; wgid = (xcd < r ? xcd * (q + 1) : r * (q + 1) + (xcd - r) * q) + off; }
        const int nig = WGM * nN, gid = wgid / nig, fm = gid * WGM, gsz = (nM - fm) < WGM ? (nM - fm) : WGM;
        u.pm = fm + ((wgid % nig) % gsz); u.pn = (wgid % nig) / gsz; return true;
    }
    __device__ __forceinline__ void a_ready(const Unit&) const {}
    __device__ __forceinline__ void done(const Unit&) const {}
};

__device__ __forceinline__ unsigned cvt_pk_bf16(float lo, float hi) { unsigned r; asm volatile("v_cvt_pk_bf16_f32 %0, %1, %2" : "=v"(r) : "v"(lo), "v"(hi)); return r; }
typedef float f32x2 __attribute__((ext_vector_type(2)));
__device__ __forceinline__ f32x2 gelu_pk(f32x2 v) {
    const f32x2 av = __builtin_elementwise_abs(v), d = av * 0.2316418882f + 1.0f;
    f32x2 t; t.x = __builtin_amdgcn_rcpf(d.x); t.y = __builtin_amdgcn_rcpf(d.y);
    f32x2 q = t * 0.5307027145f + (-0.7265760135f); q = q * t + 0.7107068705f; q = q * t + (-0.142248368f); q = q * t + 0.127414796f; q = q * t;
    const f32x2 s = (v * v) * (-0.72134752044f);
    f32x2 e; e.x = __builtin_amdgcn_exp2f(s.x); e.y = __builtin_amdgcn_exp2f(s.y);
    const f32x2 m = v * (q * e), r = v - m;
    f32x2 o; o.x = v.x < 0.f ? m.x : r.x; o.y = v.y < 0.f ? m.y : r.y; return o;
}

template <class Epi, class Sched, bool ALIGN_EPI = false, bool SP2 = false>
__device__ __forceinline__ void gemm_phase(PG8_LAS unsigned char* lds, const Gemm g, const Sched& S, const Epi& E) {
    const int tid = threadIdx.x, wid = __builtin_amdgcn_readfirstlane(tid >> 6), lane = tid & 63, wr = wid >> 2, wc = wid & 3, fr = lane & 15, fq = lane >> 4;
    const int K = g.K, nt = K / BK;
    unsigned voffA[2], voffB[2];
#pragma unroll
    for (int i = 0; i < 2; ++i) { int R, C; stage_rc(tid * 16 + i * 8192, R, C); const int Rb = Epi::PERM ? ((R & ~31) + perm32(R & 31)) : R;
        voffA[i] = (unsigned)(R * K + C) * 2u; voffB[i] = (unsigned)(Rb * K + C) * 2u; }
    const size_t kstep = (size_t)(BK * 2);
    const size_t hstep = (size_t)HALF * K * 2;
    const size_t tstep = 2 * hstep;
    const unsigned ldsw = (unsigned)wid * 1024u;
    const int aoff = lds_byte(wr * 64 + fr, fq * 8), boff = lds_byte(wc * 32 + fr, fq * 8);
#define PG8_SA(b, h) (((b) * 2 + (h)) * HTB)
#define PG8_SB(b, h) ((4 + (b) * 2 + (h)) * HTB)
#define PG8_STAGE(bufoff, gbase, voff) do { _Pragma("unroll") for (int _i = 0; _i < 2; ++_i) \
        __builtin_amdgcn_global_load_lds((const unsigned*)((const char*)(gbase) + (voff)[_i]), (PG8_LAS unsigned*)(lds + (bufoff) + ldsw + _i * 8192), 16, 0, 0); } while (0)
#define PG8_LDA(dst, b, h) do { _Pragma("unroll") for (int m = 0; m < 4; ++m) _Pragma("unroll") for (int k = 0; k < 2; ++k) dst[m][k] = *(const PG8_LAS bf16x8*)(lds + PG8_SA(b, h) + aoff + m * 2048 + k * 1024); } while (0)
#define PG8_LDB(dst, b, h) do { _Pragma("unroll") for (int n = 0; n < 2; ++n) _Pragma("unroll") for (int k = 0; k < 2; ++k) dst[n][k] = *(const PG8_LAS bf16x8*)(lds + PG8_SB(b, h) + boff + n * 2048 + k * 1024); } while (0)
#define PG8_MMA(ai, bj, At, Bt) do { __builtin_amdgcn_s_setprio(1); _Pragma("unroll") for (int m = 0; m < 4; ++m) _Pragma("unroll") for (int n = 0; n < 2; ++n) _Pragma("unroll") for (int k = 0; k < 2; ++k) \
        acc[ai][bj][m][n] = __builtin_amdgcn_mfma_f32_16x16x32_bf16(Bt[n][k], At[m][k], acc[ai][bj][m][n], 0, 0, 0); __builtin_amdgcn_s_setprio(0); } while (0)
#define PG8_WAIT_V(n) asm volatile("s_waitcnt vmcnt(" #n ")" ::: "memory")
#define PG8_WAIT_L(n) asm volatile("s_waitcnt lgkmcnt(" #n ")" ::: "memory")
#define PG8_BAR __builtin_amdgcn_s_barrier()
#define PG8_SCHED __builtin_amdgcn_sched_barrier(0)
    Unit cur, nxt; int ui = 0;
    if (!S.next(0, cur)) return;
    f32x4 acc[2][2][4][2];
#pragma unroll
    for (int a = 0; a < 2; ++a)
#pragma unroll
        for (int b = 0; b < 2; ++b)
#pragma unroll
            for (int m = 0; m < 4; ++m)
#pragma unroll
                for (int n = 0; n < 2; ++n) acc[a][b][m][n] = (f32x4){0.f, 0.f, 0.f, 0.f};
    bf16x8 At[4][2], B0[2][2], B1[2][2];
    const char* cA = (const char*)g.A + (size_t)cur.pm * tstep; const char* cB = (const char*)g.Bt + (size_t)cur.pn * tstep;
    S.a_ready(cur);
    if constexpr (SP2) {
        PG8_STAGE(PG8_SB(0, 0), cB, voffB); PG8_STAGE(PG8_SB(0, 1), cB + hstep, voffB); PG8_STAGE(PG8_SA(0, 0), cA, voffA); PG8_STAGE(PG8_SA(0, 1), cA + hstep, voffA);
        if (wr == 1) PG8_BAR;
        PG8_WAIT_V(2); PG8_BAR;
        PG8_STAGE(PG8_SB(1, 0), cB + kstep, voffB); PG8_STAGE(PG8_SA(1, 0), cA + kstep, voffA); PG8_STAGE(PG8_SB(1, 1), cB + hstep + kstep, voffB);
        PG8_WAIT_V(6); PG8_BAR;
    } else {
        PG8_STAGE(PG8_SB(0, 0), cB, voffB); PG8_STAGE(PG8_SA(0, 0), cA, voffA); PG8_STAGE(PG8_SB(0, 1), cB + hstep, voffB); PG8_STAGE(PG8_SA(0, 1), cA + hstep, voffA);
        if (wr == 1) PG8_BAR;
        PG8_WAIT_V(4); PG8_BAR;
        PG8_STAGE(PG8_SB(1, 0), cB + kstep, voffB); PG8_STAGE(PG8_SA(1, 0), cA + kstep, voffA); PG8_STAGE(PG8_SB(1, 1), cB + hstep + kstep, voffB);
        PG8_WAIT_V(6); PG8_BAR;
    }
    for (;;) {
        const bool has_next = S.next(ui + 1, nxt);
        const char* nA = has_next ? (const char*)g.A + (size_t)nxt.pm * tstep : cA; const char* nB = has_next ? (const char*)g.Bt + (size_t)nxt.pn * tstep : cB;
        for (int t = 0; t < nt; t += 2) {
            const bool last = (t == nt - 2);
            const char* a1 = cA + (size_t)(t + 1) * kstep;
            const char* a2 = last ? nA : cA + (size_t)(t + 2) * kstep; const char* b2 = last ? nB : cB + (size_t)(t + 2) * kstep;
            const char* a3 = a2 + kstep; const char* b3 = b2 + kstep;
            if (last && has_next) S.a_ready(nxt);
            if constexpr (SP2) {
            PG8_LDB(B0, 0, 0); PG8_LDB(B1, 0, 1); PG8_SCHED; PG8_LDA(At, 0, 0); PG8_STAGE(PG8_SA(1, 1), a1 + hstep, voffA);
            PG8_WAIT_V(8); PG8_WAIT_L(0); PG8_BAR; PG8_MMA(0, 0, At, B0); PG8_MMA(0, 1, At, B1); PG8_BAR; PG8_SCHED;
            PG8_LDA(At, 0, 1); PG8_STAGE(PG8_SB(0, 0), b2, voffB); PG8_STAGE(PG8_SB(0, 1), b2 + hstep, voffB); PG8_STAGE(PG8_SA(0, 0), a2, voffA);
            PG8_WAIT_V(8); PG8_WAIT_L(0); PG8_BAR; PG8_MMA(1, 0, At, B0); PG8_MMA(1, 1, At, B1); PG8_BAR; PG8_SCHED;
            PG8_LDB(B0, 1, 0); PG8_LDB(B1, 1, 1); PG8_SCHED; PG8_LDA(At, 1, 0); PG8_STAGE(PG8_SA(0, 1), a2 + hstep, voffA);
            PG8_WAIT_V(8); PG8_WAIT_L(0); PG8_BAR; PG8_MMA(0, 0, At, B0); PG8_MMA(0, 1, At, B1); PG8_BAR; PG8_SCHED;
            PG8_LDA(At, 1, 1); PG8_STAGE(PG8_SB(1, 0), b3, voffB); PG8_STAGE(PG8_SB(1, 1), b3 + hstep, voffB); PG8_STAGE(PG8_SA(1, 0), a3, voffA);
            PG8_WAIT_V(8); PG8_WAIT_L(0); PG8_BAR; PG8_MMA(1, 0, At, B0); PG8_MMA(1, 1, At, B1); PG8_BAR; PG8_SCHED;
            } else {
            PG8_LDB(B0, 0, 0); PG8_SCHED; PG8_LDA(At, 0, 0); PG8_STAGE(PG8_SA(1, 1), a1 + hstep, voffA);
            PG8_WAIT_L(8); PG8_BAR; PG8_WAIT_L(0); PG8_MMA(0, 0, At, B0); PG8_BAR; PG8_SCHED;
            PG8_LDB(B1, 0, 1); PG8_STAGE(PG8_SB(0, 0), b2, voffB);
            PG8_BAR; PG8_WAIT_L(0); PG8_MMA(0, 1, At, B1); PG8_BAR;
            PG8_LDA(At, 0, 1); PG8_STAGE(PG8_SA(0, 0), a2, voffA);
            PG8_BAR; PG8_WAIT_L(0); PG8_MMA(1, 0, At, B0); PG8_BAR; PG8_SCHED;
            PG8_STAGE(PG8_SB(0, 1), b2 + hstep, voffB);
            PG8_WAIT_V(6); PG8_BAR; PG8_MMA(1, 1, At, B1); PG8_BAR;
            PG8_LDB(B0, 1, 0); PG8_SCHED; PG8_LDA(At, 1, 0); PG8_STAGE(PG8_SA(0, 1), a2 + hstep, voffA);
            PG8_WAIT_L(8); PG8_BAR; PG8_WAIT_L(0); PG8_MMA(0, 0, At, B0); PG8_BAR; PG8_SCHED;
            PG8_LDB(B1, 1, 1); PG8_STAGE(PG8_SB(1, 0), b3, voffB);
            PG8_BAR; PG8_WAIT_L(0); PG8_MMA(0, 1, At, B1); PG8_BAR;
            PG8_LDA(At, 1, 1); PG8_STAGE(PG8_SA(1, 0), a3, voffA);
            PG8_BAR; PG8_WAIT_L(0); PG8_MMA(1, 0, At, B0); PG8_BAR; PG8_SCHED;
            PG8_STAGE(PG8_SB(1, 1), b3 + hstep, voffB);
            PG8_WAIT_V(6); PG8_BAR; PG8_MMA(1, 1, At, B1); PG8_BAR;
            }
        }
        if constexpr (ALIGN_EPI) { if (wr == 0) PG8_BAR; }
        if constexpr (!Epi::AFTER_DRAIN) { E(acc, cur, wr, wc, fr, fq); S.done(cur); }
        if (!has_next) break;
#pragma unroll
        for (int a = 0; a < 2; ++a)
#pragma unroll
            for (int b = 0; b < 2; ++b)
#pragma unroll
                for (int m = 0; m < 4; ++m)
#pragma unroll
                    for (int n = 0; n < 2; ++n) acc[a][b][m][n] = (f32x4){0.f, 0.f, 0.f, 0.f};
        cur = nxt; cA = nA; cB = nB; ++ui;
        if constexpr (ALIGN_EPI) { if (wr == 1) PG8_BAR; }
    }
    PG8_WAIT_V(0);
    if constexpr (!ALIGN_EPI) { if (wr == 0) PG8_BAR; }
    PG8_BAR;
    if constexpr (Epi::AFTER_DRAIN) { E.fused(acc, cur, wr, wc, fr, fq, lds, wid, lane); S.done(cur); }
#undef PG8_SA
#undef PG8_SB
#undef PG8_STAGE
#undef PG8_LDA
#undef PG8_LDB
#undef PG8_MMA
#undef PG8_WAIT_V
#undef PG8_WAIT_L
#undef PG8_BAR
#undef PG8_SCHED
}

}

#define XB_TMO      128
#define XB_XCNT(j)  (256  + 64 * (j))
#define XB_XSUB(j)  (1280 + 64 * (j))
#define XB_XGEN(j)  (2304 + 64 * (j))
#define XB_TOP      3328
#define XB_TOPGEN   3392
#define XCD_BAR_WORDS 3456
#define XB_SPIN_CAP (1u << 18)
#define LAS __attribute__((address_space(3)))

__device__ __forceinline__ unsigned xb_ld(unsigned* p)              { return __hip_atomic_load(p, __ATOMIC_RELAXED, __HIP_MEMORY_SCOPE_AGENT); }
__device__ __forceinline__ unsigned xb_add(unsigned* p, unsigned v) { return __hip_atomic_fetch_add(p, v, __ATOMIC_RELAXED, __HIP_MEMORY_SCOPE_AGENT); }
__device__ __forceinline__ unsigned xb_xcc_id() { return (unsigned)__builtin_amdgcn_s_getreg((3 << 11) | 20) & 0xFu; }
#define XB_SPIN(cond, bar) do { unsigned _sp = 0; while (cond) { __builtin_amdgcn_s_sleep(1); \
    if ((++_sp & 255u) == 0u) { if (xb_ld(&(bar)[XB_TMO])) break; if (_sp > XB_SPIN_CAP) { atomicAdd(&(bar)[XB_TMO], 1u); break; } } } } while (0)

struct XcdBarrier {
    unsigned* bar; unsigned x;
    volatile LAS unsigned* st;
};

__device__ __forceinline__ XcdBarrier xcd_barrier_post(unsigned* bar, volatile LAS unsigned* st) {
    XcdBarrier b; b.bar = bar; b.x = xb_xcc_id(); b.st = st;
    if (threadIdx.x == 0) (void)xb_add(&bar[XB_XCNT(b.x)], 1u);
    return b;
}
__device__ __forceinline__ void xcd_barrier_complete(unsigned* bar, unsigned x, unsigned& nloc, unsigned& nx) {
    const unsigned G = gridDim.x * gridDim.y * gridDim.z;
    unsigned sum, cnt, mine, sp = 0u;
    for (;;) {
        sum = 0u; cnt = 0u; mine = 0u;
#pragma unroll
        for (unsigned j = 0; j < 16; ++j) { const unsigned c = xb_ld(&bar[XB_XCNT(j)]); sum += c; cnt += (c > 0u) ? 1u : 0u; mine = (j == x) ? c : mine; }
        if (sum == G) break;
        __builtin_amdgcn_s_sleep(1);
        if ((++sp & 255u) == 0u) { if (xb_ld(&bar[XB_TMO])) break; if (sp > XB_SPIN_CAP) { atomicAdd(&bar[XB_TMO], 1u); break; } }
    }
    nloc = mine > 0u ? mine : 1u; nx = cnt > 0u ? cnt : 1u;
}

__device__ __forceinline__ void xcd_barrier(const XcdBarrier& b) {
    asm volatile("s_waitcnt vmcnt(0)" ::: "memory");
    __syncthreads();
    if (threadIdx.x == 0) {
        unsigned* bar = b.bar;
        __builtin_amdgcn_s_waitcnt(0);
        unsigned nloc = b.st[0], nx = b.st[1];
        if (nloc == 0u) { xcd_barrier_complete(bar, b.x, nloc, nx); b.st[0] = nloc; b.st[1] = nx; }
        const unsigned old = xb_add(&bar[XB_XSUB(b.x)], 1u);
        const unsigned gen = old / nloc;
        if (old + 1u == (gen + 1u) * nloc) {
            __builtin_amdgcn_fence(__ATOMIC_RELEASE, "agent");
            asm volatile("s_waitcnt vmcnt(0)" ::: "memory");
            const unsigned og = xb_add(&bar[XB_TOP], 1u);
            const unsigned tg = og / nx;
            if (og + 1u == (tg + 1u) * nx) xb_add(&bar[XB_TOPGEN], 1u);
            else XB_SPIN(xb_ld(&bar[XB_TOPGEN]) == tg, bar);
            __builtin_amdgcn_fence(__ATOMIC_ACQUIRE, "agent");
            xb_add(&bar[XB_XGEN(b.x)], 1u);
            asm volatile("s_waitcnt vmcnt(0)" ::: "memory");
        } else {
            XB_SPIN(xb_ld(&bar[XB_XGEN(b.x)]) == gen, bar);
            __builtin_amdgcn_fence(__ATOMIC_ACQUIRE, "agent");
            asm volatile("s_waitcnt vmcnt(0)" ::: "memory");
        }
    }
    __syncthreads();
}


namespace mk {
using pg8::cvt_pk_bf16;
typedef LAS unsigned char* ldsp_t;

template <int NT_>
__device__ __forceinline__ void transpose_tiles(const float* __restrict__ src, int ldn, int nvalid, bf16_t* __restrict__ dst_hi, bf16_t* __restrict__ dst_lo, int K, int k0, int n0,
                                                LAS float* tile, int tid) {
    float4 v[NT_][2];
#pragma unroll
    for (int t = 0; t < NT_; ++t)
#pragma unroll
        for (int i = 0; i < 2; ++i) {
            const int r = (tid >> 4) + 32 * i, n = n0 + t * 64 + (tid & 15) * 4;
            v[t][i] = make_float4(0.f, 0.f, 0.f, 0.f);
            if (n < nvalid) v[t][i] = *(const float4*)(src + (size_t)(k0 + r) * ldn + n);
        }
#pragma unroll
    for (int t = 0; t < NT_; ++t) {
        LAS float* tl = tile + (t & 1) * (64 * 65);
#pragma unroll
        for (int i = 0; i < 2; ++i) {
            const int r = (tid >> 4) + 32 * i, c4 = (tid & 15) * 4;
            tl[r * 65 + c4 + 0] = v[t][i].x; tl[r * 65 + c4 + 1] = v[t][i].y; tl[r * 65 + c4 + 2] = v[t][i].z; tl[r * 65 + c4 + 3] = v[t][i].w;
        }
        __syncthreads();
        const int n = tid >> 3, ko = (tid & 7) * 8;
        float f[8];
#pragma unroll
        for (int j = 0; j < 8; ++j) f[j] = tl[(ko + j) * 65 + n];
        u32x4 h; h.x = pk_bf16(f[0], f[1]); h.y = pk_bf16(f[2], f[3]); h.z = pk_bf16(f[4], f[5]); h.w = pk_bf16(f[6], f[7]);
        *(u32x4*)(dst_hi + (size_t)(n0 + t * 64 + n) * K + k0 + ko) = h;
        if (dst_lo) {
            u32x4 lo;
            lo.x = pk_bf16(f[0] - bf_lo(h.x), f[1] - bf_hi(h.x)); lo.y = pk_bf16(f[2] - bf_lo(h.y), f[3] - bf_hi(h.y));
            lo.z = pk_bf16(f[4] - bf_lo(h.z), f[5] - bf_hi(h.z)); lo.w = pk_bf16(f[6] - bf_lo(h.w), f[7] - bf_hi(h.w));
            *(u32x4*)(dst_lo + (size_t)(n0 + t * 64 + n) * K + k0 + ko) = lo;
        }
    }
    __syncthreads();
}

__device__ __forceinline__ void phase_prologue(const Params& p, ldsp_t lds, int which, int rank, int nrank) {
    const int tid = threadIdx.x;
    LAS float* sc = (LAS float*)lds;
    LAS float* red = (LAS float*)(lds + 32768);
    LAS float* tile = (LAS float*)(lds + 65536);
    const float* c = p.in[1]; const float* ada_w = p.in[2]; const float* ada_b = p.in[3];
    float* ADA = (float*)(p.ws + WS_ADA);
    for (int i = tid; i < NB * D; i += NT) sc[i] = silu_f(c[i]);
    __syncthreads();
    constexpr int U_ADA = 768, U_WIN = 32 * 19, U_WOUT = 32 * 8, U_RT = 32, U_WSB = 64;
    constexpr int U_TOT = U_ADA + 2 * U_WIN + 2 * U_WOUT + U_RT + U_WSB;
    for (int u0 = rank; u0 < U_TOT; u0 += nrank) {
        const int u = u0;
        int ul = -1;
        if (u < U_ADA) ul = u / 384; else if (u < U_ADA + 2 * U_WIN) ul = (u - U_ADA) / U_WIN; else if (u < U_ADA + 2 * U_WIN + 2 * U_WOUT) ul = (u - U_ADA - 2 * U_WIN) / U_WOUT;
        if ((which == 0 && ul == 1) || (which == 1 && ul != 1)) continue;
        if (u < U_ADA) {
            const int l = u / 384, cg = u % 384, cl = tid & 7, ks = tid >> 3;
            const float* w = ada_w + ((size_t)l * D + ks * 32) * (6 * D) + cg * 32 + cl * 4;
            float acc[4][4];
#pragma unroll
            for (int b = 0; b < 4; ++b)
#pragma unroll
                for (int i = 0; i < 4; ++i) acc[b][i] = 0.f;
#pragma unroll 16
            for (int kk = 0; kk < 32; ++kk) {
                const float4 wv = *(const float4*)(w + (size_t)kk * (6 * D));
#pragma unroll
                for (int b = 0; b < 4; ++b) { const float s = sc[b * D + ks * 32 + kk]; acc[b][0] += s * wv.x; acc[b][1] += s * wv.y; acc[b][2] += s * wv.z; acc[b][3] += s * wv.w; }
            }
#pragma unroll
            for (int b = 0; b < 4; ++b)
#pragma unroll
                for (int i = 0; i < 4; ++i) red[(ks * 4 + b) * 32 + cl * 4 + i] = acc[b][i];
            __syncthreads();
            if (tid < 128) {
                const int b = tid >> 5, col = tid & 31;
                float s = 0.f;
                for (int k2 = 0; k2 < 64; ++k2) s += red[(k2 * 4 + b) * 32 + col];
                ADA[((size_t)l * NB + b) * (6 * D) + cg * 32 + col] = s + ada_b[l * 6 * D + cg * 32 + col];
            }
            __syncthreads();
        } else if (u < U_ADA + 2 * U_WIN) {
            const int v = u - U_ADA, l = v / U_WIN, tt = v % U_WIN, kt = tt / 19, ng = tt % 19;
            transpose_tiles<4>(p.in[5] + (size_t)l * D * NPROJ, NPROJ, NPROJ, (bf16_t*)(p.ws + WS_WTIN) + (size_t)l * NPAD * D, nullptr, D, kt * 64, ng * 256, tile, tid);
        } else if (u < U_ADA + 2 * U_WIN + 2 * U_WOUT) {
            const int v = u - U_ADA - 2 * U_WIN, l = v / U_WOUT, tt = v % U_WOUT, kt = tt / 8, ng = tt % 8;
            transpose_tiles<4>(p.in[16] + (size_t)l * D * D, D, D, (bf16_t*)(p.ws + WS_WTOUT) + (size_t)l * D * D, nullptr, D, kt * 64, ng * 256, tile, tid);
        } else if (u < U_ADA + 2 * U_WIN + 2 * U_WOUT + U_RT) {
            const int kt = u - (U_ADA + 2 * U_WIN + 2 * U_WOUT);
            transpose_tiles<1>(p.in[18], NE, NE, (bf16_t*)(p.ws + WS_RWH), (bf16_t*)(p.ws + WS_RWL), D, kt * 64, 0, tile, tid);
        } else {
            const int v = u - (U_ADA + 2 * U_WIN + 2 * U_WOUT + U_RT);
            const float* wsrc = p.in[8]; bf16_t* dst = (bf16_t*)(p.ws + WS_WSB);
#pragma unroll
            for (int i = 0; i < 2; ++i) {
                const int e0 = v * 4096 + (tid + i * NT) * 4;
                const int s0 = e0 & 127, t = (e0 >> 7) & 127;
                const float4 wv = *(const float4*)(wsrc + e0);
                u32x2 o; o.x = pk_bf16(s0 + 0 <= t ? wv.x : 0.f, s0 + 1 <= t ? wv.y : 0.f); o.y = pk_bf16(s0 + 2 <= t ? wv.z : 0.f, s0 + 3 <= t ? wv.w : 0.f);
                *(u32x2*)(dst + e0) = o;
            }
        }
    }
}

template <int MODE>
__device__ __forceinline__ void phase_norm(const Params& p, int l) {
    const int tid = threadIdx.x, lane = tid & 63, wid = tid >> 6, G = gridDim.x;
    const float* ADA = (const float*)(p.ws + WS_ADA);
    bf16_t* X = (bf16_t*)(p.ws + WS_X);
    bf16_t* H = (bf16_t*)(p.ws + WS_H);
    const char* O8 = (const char*)(p.ws + WS_O);
    for (int rb = blockIdx.x; rb < T / 32; rb += G) {
        const int b = (rb * 32) / S;
        float4 Av[8], Bv[8], Gv[8];
#pragma unroll
        for (int j = 0; j < 8; ++j) {
            const int d = lane * 4 + 256 * j;
            if (MODE == 2) { Av[j] = *(const float4*)(p.in[23] + d); Bv[j] = make_float4(0.f, 0.f, 0.f, 0.f); }
            else {
                const float4 nw = *(const float4*)(p.in[4] + l * D + d);
                const float4 sh = *(const float4*)(ADA + ((size_t)l * NB + b) * 6 * D + 0 * D + d);
                const float4 s1 = *(const float4*)(ADA + ((size_t)l * NB + b) * 6 * D + 1 * D + d);
                Av[j] = make_float4(nw.x * (1.f + s1.x), nw.y * (1.f + s1.y), nw.z * (1.f + s1.z), nw.w * (1.f + s1.w)); Bv[j] = sh;
            }
            if (MODE >= 1) { const int lp = (MODE == 2) ? 1 : l - 1; Gv[j] = *(const float4*)(ADA + ((size_t)lp * NB + b) * 6 * D + 5 * D + d); }
        }
        constexpr int UNR = (MODE == 1) ? 1 : 2;
#pragma unroll UNR
        for (int rr = 0; rr < 4; ++rr) {
            const int t = rb * 32 + wid * 4 + rr;
            float4 xv[8]; float ss = 0.f;
#pragma unroll
            for (int j = 0; j < 8; ++j) {
                const int d = lane * 4 + 256 * j;
                if (MODE == 0) xv[j] = *(const float4*)(p.in[0] + (size_t)t * D + d);
                else { const u32x2 xb = *(const u32x2*)(X + (size_t)t * D + d); xv[j] = make_float4(bf_lo(xb.x), bf_hi(xb.x), bf_lo(xb.y), bf_hi(xb.y)); }
                if (MODE >= 1) {
                    const int o0 = *(const int*)(O8 + (size_t)(2 * t) * D + d), o1 = *(const int*)(O8 + (size_t)(2 * t + 1) * D + d);
                    typedef float f32x2_t __attribute__((ext_vector_type(2)));
                    const f32x2_t a0 = __builtin_amdgcn_cvt_pk_f32_fp8(o0, false), a1 = __builtin_amdgcn_cvt_pk_f32_fp8(o0, true), b0 = __builtin_amdgcn_cvt_pk_f32_fp8(o1, false), b1 = __builtin_amdgcn_cvt_pk_f32_fp8(o1, true);
                    xv[j].x += Gv[j].x * (a0.x + b0.x); xv[j].y += Gv[j].y * (a0.y + b0.y);
                    xv[j].z += Gv[j].z * (a1.x + b1.x); xv[j].w += Gv[j].w * (a1.y + b1.y);
                }
                ss += xv[j].x * xv[j].x + xv[j].y * xv[j].y + xv[j].z * xv[j].z + xv[j].w * xv[j].w;
            }
#pragma unroll
            for (int o = 32; o > 0; o >>= 1) ss += __shfl_xor(ss, o);
            const float rstd = rsqrtf(ss * (1.0f / D) + EPS);
#pragma unroll
            for (int j = 0; j < 8; ++j) {
                const int d = lane * 4 + 256 * j;
                const float y0 = xv[j].x * rstd * Av[j].x + Bv[j].x, y1 = xv[j].y * rstd * Av[j].y + Bv[j].y, y2 = xv[j].z * rstd * Av[j].z + Bv[j].z, y3 = xv[j].w * rstd * Av[j].w + Bv[j].w;
                if (MODE == 2) *(float4*)(p.out + (size_t)t * D + d) = make_float4(y0, y1, y2, y3);
                else { u32x2 hv; hv.x = pk_bf16(y0, y1); hv.y = pk_bf16(y2, y3); *(u32x2*)(H + (size_t)t * D + d) = hv; }
                if (MODE == 1) { u32x2 xo; xo.x = pk_bf16(xv[j].x, xv[j].y); xo.y = pk_bf16(xv[j].z, xv[j].w); *(u32x2*)(X + (size_t)t * D + d) = xo; }
            }
        }
    }
}

struct EpiProj {
    static constexpr bool PERM = true, AFTER_DRAIN = false;
    bf16_t* PROJ; float* DT; const float* dt_bias;
    __device__ __forceinline__ void operator()(const pg8::f32x4 (&acc)[2][2][4][2], const pg8::Unit& u, int wr, int wc, int fr, int fq) const {
        const int row0 = u.pm * 256 + wr * 64 + fr;
        if (u.pn < 18) {
            const int col0 = u.pn * 256 + wc * 32 + 8 * fq;
            const bool act = u.pn < 8;
#pragma unroll
            for (int ai = 0; ai < 2; ++ai)
#pragma unroll
                for (int m = 0; m < 4; ++m) {
                    bf16_t* rowp = PROJ + (size_t)(row0 + ai * 128 + m * 16) * NPJ + col0;
#pragma unroll
                    for (int bj = 0; bj < 2; ++bj) {
                        pg8::f32x4 v0 = acc[ai][bj][m][0], v1 = acc[ai][bj][m][1];
                        if (act) {
                            const pg8::f32x2 a = pg8::gelu_pk((pg8::f32x2){v0[0], v0[1]}), b2 = pg8::gelu_pk((pg8::f32x2){v0[2], v0[3]}), c2 = pg8::gelu_pk((pg8::f32x2){v1[0], v1[1]}), d2 = pg8::gelu_pk((pg8::f32x2){v1[2], v1[3]});
                            v0 = (pg8::f32x4){a.x, a.y, b2.x, b2.y}; v1 = (pg8::f32x4){c2.x, c2.y, d2.x, d2.y};
                        }
                        pg8::u32x4 w; w.x = cvt_pk_bf16(v0[0], v0[1]); w.y = cvt_pk_bf16(v0[2], v0[3]); w.z = cvt_pk_bf16(v1[0], v1[1]); w.w = cvt_pk_bf16(v1[2], v1[3]);
                        *(pg8::u32x4*)(rowp + bj * 128) = w;
                    }
                }
        } else if (wc == 0 && fq < 2) {
            float db[2][4];
#pragma unroll
            for (int n = 0; n < 2; ++n)
#pragma unroll
                for (int k = 0; k < 4; ++k) db[n][k] = dt_bias[8 * fq + 4 * n + k];
#pragma unroll
            for (int ai = 0; ai < 2; ++ai)
#pragma unroll
                for (int m = 0; m < 4; ++m) {
                    const int row = row0 + ai * 128 + m * 16;
#pragma unroll
                    for (int n = 0; n < 2; ++n) {
                        const int c0 = 8 * fq + 4 * n;
                        const pg8::f32x4 v = acc[ai][0][m][n];
                        float4 o; o.x = softplus_f(v[0] + db[n][0]); o.y = softplus_f(v[1] + db[n][1]); o.z = softplus_f(v[2] + db[n][2]); o.w = softplus_f(v[3] + db[n][3]);
                        *(float4*)(DT + (size_t)row * SH + c0) = o;
                    }
                }
        }
    }
};
template <bool F32R>
struct EpiRes {
    static constexpr bool PERM = true, AFTER_DRAIN = false;
    const float* R32; bf16_t* Xout; const float* gate;
    __device__ __forceinline__ void operator()(const pg8::f32x4 (&acc)[2][2][4][2], const pg8::Unit& u, int wr, int wc, int fr, int fq) const {
        const int row0 = u.pm * 256 + wr * 64 + fr, col0 = u.pn * 256 + wc * 32 + 8 * fq;
        const int b = (u.pm * 256) / S;
        pg8::f32x4 gv[2][2];
#pragma unroll
        for (int bj = 0; bj < 2; ++bj)
#pragma unroll
            for (int n = 0; n < 2; ++n) gv[bj][n] = *(const pg8::f32x4*)(gate + (size_t)b * 6 * D + col0 + bj * 128 + 4 * n);
#pragma unroll
        for (int ai = 0; ai < 2; ++ai) {
            pg8::f32x4 rf[F32R ? 16 : 1]; pg8::u32x4 rb[F32R ? 1 : 8];
#pragma unroll
            for (int m = 0; m < 4; ++m)
#pragma unroll
                for (int bj = 0; bj < 2; ++bj) {
                    const size_t ro = (size_t)(row0 + ai * 128 + m * 16) * D + col0 + bj * 128;
                    if constexpr (F32R) { rf[(m * 2 + bj) * 2] = *(const pg8::f32x4*)(R32 + ro); rf[(m * 2 + bj) * 2 + 1] = *(const pg8::f32x4*)(R32 + ro + 4); }
                    else rb[m * 2 + bj] = *(const pg8::u32x4*)(Xout + ro);
                }
#pragma unroll
            for (int m = 0; m < 4; ++m)
#pragma unroll
                for (int bj = 0; bj < 2; ++bj) {
                    const size_t ro = (size_t)(row0 + ai * 128 + m * 16) * D + col0 + bj * 128;
                    pg8::f32x4 r0, r1;
                    if constexpr (F32R) { r0 = rf[(m * 2 + bj) * 2]; r1 = rf[(m * 2 + bj) * 2 + 1]; }
                    else { const pg8::u32x4 q = rb[m * 2 + bj];
                           r0 = (pg8::f32x4){bf_lo(q.x), bf_hi(q.x), bf_lo(q.y), bf_hi(q.y)}; r1 = (pg8::f32x4){bf_lo(q.z), bf_hi(q.z), bf_lo(q.w), bf_hi(q.w)}; }
                    const pg8::f32x4 v0 = r0 + gv[bj][0] * acc[ai][bj][m][0], v1 = r1 + gv[bj][1] * acc[ai][bj][m][1];
                    pg8::u32x4 w; w.x = cvt_pk_bf16(v0[0], v0[1]); w.y = cvt_pk_bf16(v0[2], v0[3]); w.z = cvt_pk_bf16(v1[0], v1[1]); w.w = cvt_pk_bf16(v1[2], v1[3]);
                    *(pg8::u32x4*)(Xout + ro) = w;
                }
        }
    }
};
}

namespace mk {
#define MFMA16(a, b, c) __builtin_amdgcn_mfma_f32_16x16x32_bf16((a), (b), (c), 0, 0, 0)
constexpr int SP = 272;

struct ConvW { float w[4][8]; float b[8]; };
__device__ __forceinline__ void load_convw(ConvW& cw, const float* __restrict__ conv_w, const float* __restrict__ conv_b, int chx) {
#pragma unroll
    for (int k = 0; k < 4; ++k) {
        const float4 a = *(const float4*)(conv_w + k * CONVD + chx), b2 = *(const float4*)(conv_w + k * CONVD + chx + 4);
        cw.w[k][0] = a.x; cw.w[k][1] = a.y; cw.w[k][2] = a.z; cw.w[k][3] = a.w; cw.w[k][4] = b2.x; cw.w[k][5] = b2.y; cw.w[k][6] = b2.z; cw.w[k][7] = b2.w;
    }
    const float4 a = *(const float4*)(conv_b + chx), b2 = *(const float4*)(conv_b + chx + 4);
    cw.b[0] = a.x; cw.b[1] = a.y; cw.b[2] = a.z; cw.b[3] = a.w; cw.b[4] = b2.x; cw.b[5] = b2.y; cw.b[6] = b2.z; cw.b[7] = b2.w;
}
__device__ __forceinline__ u32x4 ld_raw(const bf16_t* __restrict__ PROJ, int tg, int tl, int pcol) {
    u32x4 z; z.x = z.y = z.z = z.w = 0u;
    if (tl >= 0) z = *(const u32x4*)(PROJ + (size_t)tg * NPJ + pcol);
    return z;
}
__device__ __forceinline__ void conv8(const ConvW& cw, const u32x4& r0, const u32x4& r1, const u32x4& r2, const u32x4& r3, float (&o)[8]) {
#pragma unroll
    for (int j = 0; j < 8; ++j) o[j] = cw.b[j];
    const u32x4 rr[4] = {r0, r1, r2, r3};
#pragma unroll
    for (int k = 0; k < 4; ++k) {
        const float x[8] = {bf_lo(rr[k].x), bf_hi(rr[k].x), bf_lo(rr[k].y), bf_hi(rr[k].y), bf_lo(rr[k].z), bf_hi(rr[k].z), bf_lo(rr[k].w), bf_hi(rr[k].w)};
#pragma unroll
        for (int j = 0; j < 8; ++j) o[j] += cw.w[k][j] * x[j];
    }
#pragma unroll
    for (int j = 0; j < 8; ++j) o[j] = silu_f(o[j]);
}
__device__ __forceinline__ u32x4 pack8(const float (&o)[8]) { u32x4 v; v.x = pk_bf16(o[0], o[1]); v.y = pk_bf16(o[2], o[3]); v.z = pk_bf16(o[4], o[5]); v.w = pk_bf16(o[6], o[7]); return v; }

__device__ __forceinline__ void ssd_unit(const Params& p, ldsp_t lds, int l, int u) {
    const int tid = threadIdx.x, lane = tid & 63, wid = __builtin_amdgcn_readfirstlane(tid >> 6), fr = lane & 15, fq = lane >> 4;
    const int hs = u & 1, g = (u >> 1) & 1, bc = u >> 2, b = bc / NC, c = bc % NC;
    const int tg0 = bc * CH, tl0 = c * CH;
    const bf16_t* PROJ = (const bf16_t*)(p.ws + WS_PROJ);
    const float* DT = (const float*)(p.ws + WS_DT);
    float* ACS = (float*)(p.ws + WS_ACS);
    bf16_t* YD = (bf16_t*)(p.ws + WS_YD);
    bf16_t* STATES = (bf16_t*)(p.ws + WS_STATES);
    const float* conv_w = p.in[10] + (size_t)l * 4 * CONVD; const float* conv_b = p.in[11] + l * CONVD;
    ldsp_t R1 = lds, R2 = lds + 34816, R3 = lds + 69632, R4 = lds + 104448;
    LAS float* acsS = (LAS float*)(lds + 122880); LAS float* dtS = (LAS float*)(lds + 122880 + 2048);
    LAS float* cwS = (LAS float*)(lds + 122880 + 4096);
    for (int i = tid; i < 1284; i += NT) {
        float v;
        if (i < 1280) { const int hq = i / 320, rem = i - hq * 320, k = rem >> 6, ch = (g * 8 + hs * 4 + hq) * SHD + (rem & 63); v = (k < 4) ? conv_w[k * CONVD + ch] : conv_b[ch]; }
        else v = p.in[14][l * SH + g * 8 + hs * 4 + (i - 1280)];
        cwS[i] = v;
    }
    (void)b;
    {
        const int o = tid & 31, lg = tid >> 5, l0 = lg * 8, is_c = o >> 4, nn = (o & 15) * 8;
        const int chx = 1024 + is_c * 256 + g * SN + nn, pcol = 3072 + chx;
        ConvW cw; load_convw(cw, conv_w, conv_b, chx);
        u32x4 raw[11];
#pragma unroll
        for (int r = 0; r < 11; ++r) raw[r] = ld_raw(PROJ, tg0 + l0 + r - 3, tl0 + l0 + r - 3, pcol);
#pragma unroll
        for (int i = 0; i < 8; ++i) {
            float ov[8]; conv8(cw, raw[i], raw[i + 1], raw[i + 2], raw[i + 3], ov);
            const int ll = l0 + i;
            const u32x4 pk = pack8(ov);
            *(LAS u32x4*)((is_c ? R1 : R2) + ll * SP + nn * 2) = pk;
            if (!is_c) {
                const unsigned pw[4] = {pk.x, pk.y, pk.z, pk.w};
#pragma unroll
                for (int j = 0; j < 8; ++j) *(LAS bf16_t*)(R3 + (nn + j) * SP + ll * 2) = (bf16_t)((j & 1) ? (pw[j >> 1] >> 16) : (pw[j >> 1] & 0xffffu));
            }
        }
    }
    if (wid < 4) {
        const int h = g * 8 + hs * 4 + wid, l2 = lane * 2;
        const float a = -__expf(p.in[13][l * SH + h]);
        const float dt0 = DT[(size_t)(tg0 + l2) * SH + h], dt1 = DT[(size_t)(tg0 + l2 + 1) * SH + h];
        const float ad0 = dt0 * a, ad1 = dt1 * a, s = ad0 + ad1;
        float incl = s;
#pragma unroll
        for (int o = 1; o < 64; o <<= 1) { const float n = __shfl_up(incl, o); if (lane >= o) incl += n; }
        const float excl = incl - s;
        acsS[wid * 128 + l2] = excl + ad0; acsS[wid * 128 + l2 + 1] = incl;
        dtS[wid * 128 + l2] = dt0; dtS[wid * 128 + l2 + 1] = dt1;
        ACS[(size_t)(tg0 + l2) * SH + h] = excl + ad0; ACS[(size_t)(tg0 + l2 + 1) * SH + h] = incl;
    }
    __syncthreads();
    f32x4 CB[8];
#pragma unroll
    for (int nt = 0; nt < 8; ++nt) CB[nt] = (f32x4){0.f, 0.f, 0.f, 0.f};
#pragma unroll
    for (int ks = 0; ks < 4; ++ks) {
        const bf16x8 af = *(const LAS bf16x8*)(R1 + (16 * wid + fr) * SP + (32 * ks + 8 * fq) * 2);
#pragma unroll
        for (int nt = 0; nt < 8; ++nt) if (nt <= wid) {
            const bf16x8 bfr = *(const LAS bf16x8*)(R2 + (16 * nt + fr) * SP + (32 * ks + 8 * fq) * 2);
            CB[nt] = MFMA16(bfr, af, CB[nt]);
        }
    }
    __syncthreads();
    const float dsk_base = 0.f; (void)dsk_base;
    u32x4 raw[5];
    {
        const int o = tid & 7, l0 = (tid >> 3) * 2, pcol = 3072 + (g * 8 + hs * 4) * SHD + o * 8;
#pragma unroll
        for (int r = 0; r < 5; ++r) raw[r] = ld_raw(PROJ, tg0 + l0 + r - 3, tl0 + l0 + r - 3, pcol);
    }
#pragma unroll 1
    for (int hl = 0; hl < 4; ++hl) {
        const int h = g * 8 + hs * 4 + hl;
        {
            const int o = tid & 7, lg = tid >> 3, l0 = lg * 2;
            ConvW cw;
#pragma unroll
            for (int k = 0; k < 4; ++k) {
                const f32x4 a = *(const LAS f32x4*)(cwS + hl * 320 + k * 64 + o * 8), b2 = *(const LAS f32x4*)(cwS + hl * 320 + k * 64 + o * 8 + 4);
                cw.w[k][0] = a[0]; cw.w[k][1] = a[1]; cw.w[k][2] = a[2]; cw.w[k][3] = a[3]; cw.w[k][4] = b2[0]; cw.w[k][5] = b2[1]; cw.w[k][6] = b2[2]; cw.w[k][7] = b2[3];
            }
            { const f32x4 a = *(const LAS f32x4*)(cwS + hl * 320 + 256 + o * 8), b2 = *(const LAS f32x4*)(cwS + hl * 320 + 256 + o * 8 + 4);
              cw.b[0] = a[0]; cw.b[1] = a[1]; cw.b[2] = a[2]; cw.b[3] = a[3]; cw.b[4] = b2[0]; cw.b[5] = b2[1]; cw.b[6] = b2[2]; cw.b[7] = b2[3]; }
            const float alast = acsS[hl * 128 + 127];
#pragma unroll
            for (int i = 0; i < 2; ++i) {
                float ov[8]; conv8(cw, raw[i], raw[i + 1], raw[i + 2], raw[i + 3], ov);
                const int ll = l0 + i;
                *(LAS u32x4*)(R4 + ll * 144 + o * 16) = pack8(ov);
                const float dtl = dtS[hl * 128 + ll], e = __expf(alast - acsS[hl * 128 + ll]);
#pragma unroll
                for (int j = 0; j < 8; ++j) {
                    const float xd = ov[j] * dtl;
                    *(LAS bf16_t*)(R2 + (o * 8 + j) * SP + ll * 2) = f2bf(xd);
                    *(LAS bf16_t*)(R2 + 17408 + (o * 8 + j) * SP + ll * 2) = f2bf(xd * e);
                }
            }
        }
        if (hl < 3) {
            const int o = tid & 7, l0 = (tid >> 3) * 2, pcol = 3072 + (h + 1) * SHD + o * 8;
#pragma unroll
            for (int r = 0; r < 5; ++r) raw[r] = ld_raw(PROJ, tg0 + l0 + r - 3, tl0 + l0 + r - 3, pcol);
        }
        {
            const int lrow = 16 * wid + fr;
            const float al = acsS[hl * 128 + lrow];
#pragma unroll
            for (int nt = 0; nt < 8; ++nt) {
                if (nt <= wid) {
                    const f32x4 as = *(const LAS f32x4*)(acsS + hl * 128 + 16 * nt + 4 * fq);
                    float v[4];
#pragma unroll
                    for (int r = 0; r < 4; ++r) { const float e = __expf(al - as[r]); const bool keep = (nt < wid) || (4 * fq + r <= fr); v[r] = keep ? CB[nt][r] * e : 0.f; }
                    u32x2 w2; w2.x = pk_bf16(v[0], v[1]); w2.y = pk_bf16(v[2], v[3]);
                    *(LAS u32x2*)(R1 + lrow * SP + (16 * nt + 4 * fq) * 2) = w2;
                } else if (nt == wid + 1 && !(wid & 1)) {
                    u32x2 w2; w2.x = 0u; w2.y = 0u;
                    *(LAS u32x2*)(R1 + lrow * SP + (16 * nt + 4 * fq) * 2) = w2;
                }
            }
        }
        __syncthreads();
        {
            f32x4 acc[4];
#pragma unroll
            for (int nt = 0; nt < 4; ++nt) acc[nt] = (f32x4){0.f, 0.f, 0.f, 0.f};
#pragma unroll
            for (int ks = 0; ks < 4; ++ks) if (ks <= (wid >> 1)) {
                const bf16x8 af = *(const LAS bf16x8*)(R1 + (16 * wid + fr) * SP + (32 * ks + 8 * fq) * 2);
#pragma unroll
                for (int nt = 0; nt < 4; ++nt) {
                    const bf16x8 bfr = *(const LAS bf16x8*)(R2 + (16 * nt + fr) * SP + (32 * ks + 8 * fq) * 2);
                    acc[nt] = MFMA16(bfr, af, acc[nt]);
                }
            }
            const int lrow = 16 * wid + fr;
            const float dsk = cwS[1280 + hl];
#pragma unroll
            for (int nt = 0; nt < 4; ++nt) {
                const int p0 = 16 * nt + 4 * fq;
                const u32x2 xs2 = *(const LAS u32x2*)(R4 + lrow * 144 + p0 * 2);
                u32x2 o2; o2.x = pk_bf16(acc[nt][0] + dsk * bf_lo(xs2.x), acc[nt][1] + dsk * bf_hi(xs2.x)); o2.y = pk_bf16(acc[nt][2] + dsk * bf_lo(xs2.y), acc[nt][3] + dsk * bf_hi(xs2.y));
                *(u32x2*)(YD + (size_t)(tg0 + lrow) * SW + h * SHD + p0) = o2;
            }
        }
        {
            f32x4 acc[4];
#pragma unroll
            for (int j = 0; j < 4; ++j) acc[j] = (f32x4){0.f, 0.f, 0.f, 0.f};
            const int mp = wid & 3, nb = 4 * (wid >> 2);
#pragma unroll
            for (int ks = 0; ks < 4; ++ks) {
                const bf16x8 af = *(const LAS bf16x8*)(R2 + 17408 + (16 * mp + fr) * SP + (32 * ks + 8 * fq) * 2);
#pragma unroll
                for (int j = 0; j < 4; ++j) {
                    const bf16x8 bfr = *(const LAS bf16x8*)(R3 + (16 * (nb + j) + fr) * SP + (32 * ks + 8 * fq) * 2);
                    acc[j] = MFMA16(bfr, af, acc[j]);
                }
            }
            bf16_t* sp = STATES + (((size_t)bc * SH + h) * SHD + 16 * mp + fr) * SN;
#pragma unroll
            for (int j = 0; j < 4; ++j) { u32x2 o2; o2.x = pk_bf16(acc[j][0], acc[j][1]); o2.y = pk_bf16(acc[j][2], acc[j][3]); *(u32x2*)(sp + 16 * (nb + j) + 4 * fq) = o2; }
        }
        __syncthreads();
    }
}

__device__ __forceinline__ void gmlp_unit(const Params& p, ldsp_t lds, int l, int u) {
    const int tid = threadIdx.x, lane = tid & 63, wid = __builtin_amdgcn_readfirstlane(tid >> 6), fr = lane & 15, fq = lane >> 4;
    const int hh = u & 7, bc = u >> 3, tg0 = bc * CH;
    const bf16_t* PROJ = (const bf16_t*)(p.ws + WS_PROJ);
    bf16_t* YMIX = (bf16_t*)(p.ws + WS_YMIX);
    ldsp_t A = lds, VT = lds + 34816;
    {
        const bf16_t* wsb = (const bf16_t*)(p.ws + WS_WSB) + ((size_t)(l * GH + hh) * 128) * 128;
#pragma unroll
        for (int i = 0; i < 4; ++i) { const int q = tid + NT * i, row = q >> 4, pc = q & 15; *(LAS u32x4*)(A + row * SP + pc * 16) = *(const u32x4*)(wsb + row * 128 + pc * 8); }
    }
    {
        const int s = tid >> 2, q4 = tid & 3;
        const bf16_t* src = PROJ + (size_t)(tg0 + s) * NPJ + 1024 + hh * 128 + q4 * 32;
        float gv[32];
#pragma unroll
        for (int i = 0; i < 4; ++i) { const u32x4 v = *(const u32x4*)(src + i * 8);
            gv[i * 8 + 0] = bf_lo(v.x); gv[i * 8 + 1] = bf_hi(v.x); gv[i * 8 + 2] = bf_lo(v.y); gv[i * 8 + 3] = bf_hi(v.y); gv[i * 8 + 4] = bf_lo(v.z); gv[i * 8 + 5] = bf_hi(v.z); gv[i * 8 + 6] = bf_lo(v.w); gv[i * 8 + 7] = bf_hi(v.w); }
        float sm = 0.f;
#pragma unroll
        for (int i = 0; i < 32; ++i) sm += gv[i];
        sm += __shfl_xor(sm, 1); sm += __shfl_xor(sm, 2);
        const float mu = sm * (1.0f / 128.0f);
        float q = 0.f;
#pragma unroll
        for (int i = 0; i < 32; ++i) { const float d = gv[i] - mu; q += d * d; }
        q += __shfl_xor(q, 1); q += __shfl_xor(q, 2);
        const float rstd = rsqrtf(q * (1.0f / 128.0f) + EPS);
        const float* lw = p.in[6] + l * 1024 + hh * 128 + q4 * 32; const float* lb = p.in[7] + l * 1024 + hh * 128 + q4 * 32;
#pragma unroll
        for (int i = 0; i < 32; ++i) *(LAS bf16_t*)(VT + (q4 * 32 + i) * SP + s * 2) = f2bf((gv[i] - mu) * rstd * lw[i] + lb[i]);
    }
    __syncthreads();
    f32x4 acc[8];
#pragma unroll
    for (int nt = 0; nt < 8; ++nt) acc[nt] = (f32x4){0.f, 0.f, 0.f, 0.f};
#pragma unroll
    for (int ks = 0; ks < 4; ++ks) if (ks <= (wid >> 1)) {
        const bf16x8 af = *(const LAS bf16x8*)(A + (16 * wid + fr) * SP + (32 * ks + 8 * fq) * 2);
#pragma unroll
        for (int nt = 0; nt < 8; ++nt) {
            const bf16x8 bfr = *(const LAS bf16x8*)(VT + (16 * nt + fr) * SP + (32 * ks + 8 * fq) * 2);
            acc[nt] = MFMA16(bfr, af, acc[nt]);
        }
    }
    {
        const int trow = 16 * wid + fr;
        const float bsv = p.in[9][l * 1024 + hh * 128 + trow];
        u32x2 uu[8];
#pragma unroll
        for (int nt = 0; nt < 8; ++nt) uu[nt] = *(const u32x2*)(PROJ + (size_t)(tg0 + trow) * NPJ + hh * 128 + 16 * nt + 4 * fq);
#pragma unroll
        for (int nt = 0; nt < 8; ++nt) {
            const int p0 = 16 * nt + 4 * fq;
            const u32x2 u2 = uu[nt];
            u32x2 o2; o2.x = pk_bf16(bf_lo(u2.x) * (acc[nt][0] + bsv), bf_hi(u2.x) * (acc[nt][1] + bsv)); o2.y = pk_bf16(bf_lo(u2.y) * (acc[nt][2] + bsv), bf_hi(u2.y) * (acc[nt][3] + bsv));
            *(u32x2*)(YMIX + (size_t)(tg0 + trow) * D + hh * 128 + p0) = o2;
        }
    }
    __syncthreads();
}

template <class ZF>
__device__ __forceinline__ void phase_mix(const Params& p, ldsp_t lds, int l, const ZF& zgemm) {
    const int b = (int)blockIdx.x, G = (int)gridDim.x;
    if (G == 256) {
        if (b < 96) {
            zgemm(32 + b);
            __syncthreads();
            const int n = (b < 64) ? 3 : 2, g0 = (b < 64) ? 3 * b : 192 + 2 * (b - 64);
            for (int i = 0; i < n; ++i) gmlp_unit(p, lds, l, g0 + i);
        } else if (b < 192) {
            const int c = b - 96;
            ssd_unit(p, lds, l, 2 * c); ssd_unit(p, lds, l, 2 * c + 1);
        } else {
            const int c = b - 192;
            ssd_unit(p, lds, l, 192 + c);
            for (int i = 0; i < 4; ++i) gmlp_unit(p, lds, l, 256 + 4 * c + i);
        }
    } else {
        for (int u = 32 + b; u < 128; u += G) { zgemm(u); __syncthreads(); }
        for (int u = b; u < 768; u += G) { if (u < 256) ssd_unit(p, lds, l, u); else gmlp_unit(p, lds, l, u - 256); }
    }
}

__device__ __forceinline__ void phase_scan(const Params& p) {
    const bf16_t* STATES = (const bf16_t*)(p.ws + WS_STATES); const float* ACS = (const float*)(p.ws + WS_ACS);
    bf16_t* PREV = (bf16_t*)(p.ws + WS_PREV);
    for (int idx = blockIdx.x * NT + threadIdx.x; idx < NB * SH * SHD * SN / 4; idx += gridDim.x * NT) {
        const int n4 = idx & 31, pp = (idx >> 5) & 63, h = (idx >> 11) & 15, b = idx >> 15;
        float4 st[NC]; float dec[NC];
#pragma unroll
        for (int c = 0; c < NC; ++c) {
            { const u32x2 sb = *(const u32x2*)(STATES + ((((size_t)(b * NC + c)) * SH + h) * SHD + pp) * SN + n4 * 4); st[c] = make_float4(bf_lo(sb.x), bf_hi(sb.x), bf_lo(sb.y), bf_hi(sb.y)); }
            dec[c] = ACS[((size_t)(b * NC + c) * CH + CH - 1) * SH + h];
        }
        float4 carry = make_float4(0.f, 0.f, 0.f, 0.f);
#pragma unroll
        for (int c = 0; c < NC; ++c) {
            u32x2 o; o.x = pk_bf16(carry.x, carry.y); o.y = pk_bf16(carry.z, carry.w);
            *(u32x2*)(PREV + ((((size_t)(b * NC + c)) * SH + h) * SHD + pp) * SN + n4 * 4) = o;
            const float d = __expf(dec[c]);
            carry.x = carry.x * d + st[c].x; carry.y = carry.y * d + st[c].y; carry.z = carry.z * d + st[c].z; carry.w = carry.w * d + st[c].w;
        }
    }
}

__device__ __forceinline__ void phase_yoff(const Params& p, ldsp_t lds, int l) {
    const int tid = threadIdx.x, lane = tid & 63, wid = __builtin_amdgcn_readfirstlane(tid >> 6), fr = lane & 15, fq = lane >> 4;
    const bf16_t* PROJ = (const bf16_t*)(p.ws + WS_PROJ); const float* ACS = (const float*)(p.ws + WS_ACS);
    const bf16_t* YD = (const bf16_t*)(p.ws + WS_YD); const bf16_t* PREV = (const bf16_t*)(p.ws + WS_PREV);
    bf16_t* YMIX = (bf16_t*)(p.ws + WS_YMIX);
    const float* conv_w = p.in[10] + (size_t)l * 4 * CONVD; const float* conv_b = p.in[11] + l * CONVD;
    ldsp_t CmS = lds; LAS float* red = (LAS float*)(lds + 52224);
    for (int u = blockIdx.x; u < 256; u += gridDim.x) {
        const int g = u & 1, tb = (u >> 1) & 31, b = u >> 6;
        const int tl0 = tb * 64, tg0 = b * S + tl0, bc = b * NC + (tb >> 1);
        {
            const int o = tid & 15, lg = tid >> 4, l0 = lg * 2, chx = 1280 + g * SN + o * 8, pcol = 3072 + chx;
            ConvW cw; load_convw(cw, conv_w, conv_b, chx);
            u32x4 raw[5];
#pragma unroll
            for (int r = 0; r < 5; ++r) raw[r] = ld_raw(PROJ, tg0 + l0 + r - 3, tl0 + l0 + r - 3, pcol);
#pragma unroll
            for (int i = 0; i < 2; ++i) { float ov[8]; conv8(cw, raw[i], raw[i + 1], raw[i + 2], raw[i + 3], ov); *(LAS u32x4*)(CmS + (l0 + i) * SP + o * 16) = pack8(ov); }
        }
        const int mt = wid & 3, ntb = 2 * (wid >> 2);
        const int trow = tg0 + 16 * mt + fr;
        f32x4 gval[8][2]; float ssq = 0.f;
        u32x4 pvr[2];
        {
            const bf16_t* src = PREV + (((size_t)bc * SH + g * 8) * SHD) * SN;
#pragma unroll
            for (int i = 0; i < 2; ++i) { const int q = tid + NT * i; pvr[i] = *(const u32x4*)(src + (q >> 4) * 128 + (q & 15) * 8); }
        }
#pragma unroll
        for (int hl = 0; hl < 8; ++hl) {
            const int h = g * 8 + hl;
            ldsp_t Pv = lds + 17408 + (hl & 1) * 17408;
#pragma unroll
            for (int i = 0; i < 2; ++i) { const int q = tid + NT * i; *(LAS u32x4*)(Pv + (q >> 4) * SP + (q & 15) * 16) = pvr[i]; }
            if (hl < 7) {
                const bf16_t* src = PREV + (((size_t)bc * SH + h + 1) * SHD) * SN;
#pragma unroll
                for (int i = 0; i < 2; ++i) { const int q = tid + NT * i; pvr[i] = *(const u32x4*)(src + (q >> 4) * 128 + (q & 15) * 8); }
            }
            __syncthreads();
            f32x4 acc[2] = {(f32x4){0.f, 0.f, 0.f, 0.f}, (f32x4){0.f, 0.f, 0.f, 0.f}};
#pragma unroll
            for (int ks = 0; ks < 4; ++ks) {
                const bf16x8 af = *(const LAS bf16x8*)(CmS + (16 * mt + fr) * SP + (32 * ks + 8 * fq) * 2);
#pragma unroll
                for (int j = 0; j < 2; ++j) {
                    const bf16x8 bfr = *(const LAS bf16x8*)(Pv + (16 * (ntb + j) + fr) * SP + (32 * ks + 8 * fq) * 2);
                    acc[j] = MFMA16(bfr, af, acc[j]);
                }
            }
            const float ea = __expf(ACS[(size_t)trow * SH + h]);
#pragma unroll
            for (int j = 0; j < 2; ++j) {
                const int p0 = 16 * (ntb + j) + 4 * fq;
                const u32x2 yd = *(const u32x2*)(YD + (size_t)trow * SW + h * SHD + p0);
                const u32x2 zz = *(const u32x2*)(PROJ + (size_t)trow * NPJ + 2048 + h * SHD + p0);
                f32x4 gv;
                gv[0] = (bf_lo(yd.x) + ea * acc[j][0]) * silu_f(bf_lo(zz.x)); gv[1] = (bf_hi(yd.x) + ea * acc[j][1]) * silu_f(bf_hi(zz.x));
                gv[2] = (bf_lo(yd.y) + ea * acc[j][2]) * silu_f(bf_lo(zz.y)); gv[3] = (bf_hi(yd.y) + ea * acc[j][3]) * silu_f(bf_hi(zz.y));
                gval[hl][j] = gv;
                ssq += gv[0] * gv[0] + gv[1] * gv[1] + gv[2] * gv[2] + gv[3] * gv[3];
            }
        }
        ssq += __shfl_xor(ssq, 16); ssq += __shfl_xor(ssq, 32);
        if (fq == 0) red[(wid >> 2) * 64 + 16 * mt + fr] = ssq;
        __syncthreads();
        const float tot = red[16 * mt + fr] + red[64 + 16 * mt + fr];
        const float rstd = rsqrtf(tot * (1.0f / 512.0f) + EPS);
        const float* nw = p.in[15] + l * SW;
#pragma unroll
        for (int hl = 0; hl < 8; ++hl) {
            const int h = g * 8 + hl;
#pragma unroll
            for (int j = 0; j < 2; ++j) {
                const int p0 = 16 * (ntb + j) + 4 * fq;
                const float4 w4 = *(const float4*)(nw + h * SHD + p0);
                u32x2 o2; o2.x = pk_bf16(gval[hl][j][0] * rstd * w4.x, gval[hl][j][1] * rstd * w4.y); o2.y = pk_bf16(gval[hl][j][2] * rstd * w4.z, gval[hl][j][3] * rstd * w4.w);
                *(u32x2*)(YMIX + (size_t)trow * D + 1024 + h * SHD + p0) = o2;
            }
        }
        __syncthreads();
    }
}
}

namespace mk {
#define MFMA32(a, b, c) __builtin_amdgcn_mfma_f32_32x32x16_bf16((a), (b), (c), 0, 0, 0)
constexpr int HLP = 4112;
__device__ __forceinline__ void phase_router(const Params& p, ldsp_t lds, int l, bool dummy = false) {
    const int tid = threadIdx.x, lane = tid & 63, wid = __builtin_amdgcn_readfirstlane(tid >> 6), fr = lane & 15, fq = lane >> 4, G = gridDim.x;
    const float* ADA = (const float*)(p.ws + WS_ADA); const bf16_t* X = (const bf16_t*)(p.ws + WS_X);
    bf16_t* H = (bf16_t*)(p.ws + WS_H);
    const bf16_t* RWH = (const bf16_t*)(p.ws + WS_RWH); const bf16_t* RWL = (const bf16_t*)(p.ws + WS_RWL);
    int* CNT = (int*)(p.ws + WS_CTL + CTL_CNT) + l * NE; int* LIST = (int*)(p.ws + WS_LIST); float* GW = (float*)(p.ws + WS_GW);
    if (dummy) { CNT += 4 * NE; LIST = (int*)(p.ws + WS_END); GW = (float*)(p.ws + WS_END + (size_t)NE * T * 4); }
    LAS float* LG = (LAS float*)(lds + 32 * HLP);
    LAS int* lcnt = (LAS int*)(lds + 32 * HLP + 8192);
    LAS int* lbase = lcnt + 64;
    LAS int* sinfo = lcnt + 128;
    const float* rbias = p.in[19];
    if (tid < 64) lcnt[tid] = 0;
    for (int rb = blockIdx.x; rb < T / 32; rb += G) {
        const int b = (rb * 32) / S;
        float4 Av[8], Bv[8];
#pragma unroll
        for (int j = 0; j < 8; ++j) {
            const int d = lane * 4 + 256 * j;
            const float4 nw = *(const float4*)(p.in[17] + l * D + d);
            const float4 sh = *(const float4*)(ADA + ((size_t)l * NB + b) * 6 * D + 3 * D + d);
            const float4 s2 = *(const float4*)(ADA + ((size_t)l * NB + b) * 6 * D + 4 * D + d);
            Av[j] = make_float4(nw.x * (1.f + s2.x), nw.y * (1.f + s2.y), nw.z * (1.f + s2.z), nw.w * (1.f + s2.w)); Bv[j] = sh;
        }
#pragma unroll 1
        for (int half = 0; half < 2; ++half) {
#pragma unroll
            for (int rr = 0; rr < 2; ++rr) {
                const int row = wid * 2 + rr, t = rb * 32 + half * 16 + row;
                float4 xv[8]; float ss = 0.f;
#pragma unroll
                for (int j = 0; j < 8; ++j) { const u32x2 xb = *(const u32x2*)(X + (size_t)t * D + lane * 4 + 256 * j); xv[j] = make_float4(bf_lo(xb.x), bf_hi(xb.x), bf_lo(xb.y), bf_hi(xb.y)); ss += xv[j].x * xv[j].x + xv[j].y * xv[j].y + xv[j].z * xv[j].z + xv[j].w * xv[j].w; }
#pragma unroll
                for (int o = 32; o > 0; o >>= 1) ss += __shfl_xor(ss, o);
                const float rstd = rsqrtf(ss * (1.0f / D) + EPS);
#pragma unroll
                for (int j = 0; j < 8; ++j) {
                    const int d = lane * 4 + 256 * j;
                    const float y0 = xv[j].x * rstd * Av[j].x + Bv[j].x, y1 = xv[j].y * rstd * Av[j].y + Bv[j].y, y2 = xv[j].z * rstd * Av[j].z + Bv[j].z, y3 = xv[j].w * rstd * Av[j].w + Bv[j].w;
                    u32x2 hv; hv.x = pk_bf16(y0, y1); hv.y = pk_bf16(y2, y3);
                    u32x2 lv; lv.x = pk_bf16(y0 - bf_lo(hv.x), y1 - bf_hi(hv.x)); lv.y = pk_bf16(y2 - bf_lo(hv.y), y3 - bf_hi(hv.y));
                    *(LAS u32x2*)(lds + row * HLP + d * 2) = hv;
                    *(LAS u32x2*)(lds + (16 + row) * HLP + d * 2) = lv;
                }
            }
            __syncthreads();
            {
                const int nt = wid & 3, kh = wid >> 2;
                f32x4 acc = (f32x4){0.f, 0.f, 0.f, 0.f};
                const bf16_t* bh = RWH + (size_t)(16 * nt + fr) * D + 8 * fq; const bf16_t* bl = RWL + (size_t)(16 * nt + fr) * D + 8 * fq;
#pragma unroll 8
                for (int ks = 0; ks < 32; ++ks) {
                    const int k0 = (kh * 32 + ks) * 32;
                    const bf16x8 ah = *(const LAS bf16x8*)(lds + fr * HLP + (k0 + 8 * fq) * 2);
                    const bf16x8 alo = *(const LAS bf16x8*)(lds + (16 + fr) * HLP + (k0 + 8 * fq) * 2);
                    const bf16x8 bhv = *(const bf16x8*)(bh + k0); const bf16x8 blv = *(const bf16x8*)(bl + k0);
                    acc = MFMA16(ah, bhv, acc); acc = MFMA16(ah, blv, acc); acc = MFMA16(alo, bhv, acc);
                }
#pragma unroll
                for (int r = 0; r < 4; ++r) LG[(kh * 16 + 4 * fq + r) * 64 + 16 * nt + fr] = acc[r];
            }
            __syncthreads();
#pragma unroll 1
            for (int rr = 0; rr < 2; ++rr) {
                const int row = wid * 2 + rr, t = rb * 32 + half * 16 + row;
                const float lg = LG[row * 64 + lane] + LG[(16 + row) * 64 + lane];
                const float sc = 1.0f / (1.0f + __expf(-lg)), v = sc + rbias[lane];
                float m1 = v; int i1 = lane;
#pragma unroll
                for (int o = 1; o < 8; o <<= 1) { const float ov = __shfl_xor(m1, o); const int oi = __shfl_xor(i1, o); if (ov > m1 || (ov == m1 && oi < i1)) { m1 = ov; i1 = oi; } }
                float m2 = (lane == i1) ? -1e30f : v; int i2 = lane;
#pragma unroll
                for (int o = 1; o < 8; o <<= 1) { const float ov = __shfl_xor(m2, o); const int oi = __shfl_xor(i2, o); if (ov > m2 || (ov == m2 && oi < i2)) { m2 = ov; i2 = oi; } }
                float gs = m1 + m2; int bg = lane >> 3;
#pragma unroll
                for (int o = 8; o < 64; o <<= 1) { const float ov = __shfl_xor(gs, o); const int og = __shfl_xor(bg, o); if (ov > gs || (ov == gs && og < bg)) { gs = ov; bg = og; } }
                const int e1 = __shfl(i1, bg * 8), e2 = __shfl(i2, bg * 8);
                const float u1 = __shfl(sc, e1), u2 = __shfl(sc, e2);
                if (lane == 0) {
                    const float inv = 1.0f / (u1 + u2);
                    GW[t * 2 + 0] = u1 * inv; GW[t * 2 + 1] = u2 * inv;
                    LAS int* si = sinfo + (half * 16 + row) * 4;
                    si[0] = e1; si[1] = __hip_atomic_fetch_add(lcnt + e1, 1, __ATOMIC_RELAXED, __HIP_MEMORY_SCOPE_WORKGROUP); si[2] = e2; si[3] = __hip_atomic_fetch_add(lcnt + e2, 1, __ATOMIC_RELAXED, __HIP_MEMORY_SCOPE_WORKGROUP);
                }
            }
            __syncthreads();
            if (tid < 64) { const int c = lcnt[tid]; lbase[tid] = c ? atomicAdd(&CNT[tid], c) : 0; lcnt[tid] = 0; }
            __syncthreads();
            {
                const int sl = tid >> 4, row = sl >> 1, k = sl & 1, cg = tid & 15;
                const int e = sinfo[(half * 16 + row) * 4 + 2 * k], pos = lbase[e] + sinfo[(half * 16 + row) * 4 + 2 * k + 1];
                if (cg == 0) LIST[e * T + pos] = (rb * 32 + half * 16 + row) * 2 + k;
                if (pos >= SCAP) {
                    const int tk = rb * 32 + half * 16 + row;
                    char* h8 = (char*)(p.ws + WS_H) + (size_t)tk * D;
#pragma unroll
                    for (int cc = 0; cc < 4; ++cc)
#pragma unroll
                        for (int j = 0; j < 4; ++j) {
                            const u32x4 v = *(const LAS u32x4*)(lds + row * HLP + (cg * 4 + cc) * 64 + j * 16);
                            u32x2 o; int t0 = 0, t1 = 0;
                            t0 = __builtin_amdgcn_cvt_pk_fp8_f32(bf_lo(v.x), bf_hi(v.x), t0, false); t0 = __builtin_amdgcn_cvt_pk_fp8_f32(bf_lo(v.y), bf_hi(v.y), t0, true);
                            t1 = __builtin_amdgcn_cvt_pk_fp8_f32(bf_lo(v.z), bf_hi(v.z), t1, false); t1 = __builtin_amdgcn_cvt_pk_fp8_f32(bf_lo(v.w), bf_hi(v.w), t1, true);
                            o.x = (unsigned)t0; o.y = (unsigned)t1;
                            *(u32x2*)(h8 + (cg * 4 + cc) * 32 + j * 8) = o;
                        }
                }
                if (pos < SCAP) {
                    char* hg = (char*)(p.ws + WS_HG);
#pragma unroll
                    for (int cc = 0; cc < 4; ++cc) {
                        const int ck = cg * 4 + cc;
#pragma unroll
                        for (int j = 0; j < 4; ++j) {
                            const u32x4 v = *(const LAS u32x4*)(lds + row * HLP + ck * 64 + j * 16);
                            u32x2 o; int t0 = 0, t1 = 0;
                            t0 = __builtin_amdgcn_cvt_pk_fp8_f32(bf_lo(v.x), bf_hi(v.x), t0, false); t0 = __builtin_amdgcn_cvt_pk_fp8_f32(bf_lo(v.y), bf_hi(v.y), t0, true);
                            t1 = __builtin_amdgcn_cvt_pk_fp8_f32(bf_lo(v.z), bf_hi(v.z), t1, false); t1 = __builtin_amdgcn_cvt_pk_fp8_f32(bf_lo(v.w), bf_hi(v.w), t1, true);
                            o.x = (unsigned)t0; o.y = (unsigned)t1;
                            *(u32x2*)(hg + ((size_t)((e * 64 + ck) * 4 + j) * SCAP + pos) * 8) = o;
                        }
                    }
                }
            }
            __syncthreads();
        }
    }
}

__device__ __forceinline__ void glds16_v(const void* gsrc, unsigned lds_dst) {
    unsigned keep;
    asm volatile("s_mov_b32 %0, m0\n\ts_mov_b32 m0, %2\n\ts_nop 0\n\tglobal_load_lds_dwordx4 %1, off nt\n\ts_mov_b32 m0, %0" : "=&s"(keep) : "v"(gsrc), "s"(lds_dst) : "memory");
}
template <int N> __device__ __forceinline__ void wait_vm() { asm volatile("s_waitcnt vmcnt(%0)" :: "n"(N) : "memory"); }

constexpr int MOE_L0 = 8192;
template <bool UP, int RH> struct K8 {
    static constexpr int KTOT = UP ? D : DE, KC = 32, NCH = KTOT / KC, WLD = UP ? DE : D, WCOLS = 256 / RH;
    static constexpr int S = (RH == 1) ? 3 : 4, DW = S - 1, ROWS = RH * 256, ASZ = ROWS * 32, STG = ASZ + 32 * WCOLS * 4, WP = 4 / RH, NPW = RH;
    static_assert(MOE_L0 + S * STG <= LDS_BYTES - 64, "MoE LDS map");
};
struct MoeCtx { int e, ns, ps, rows, cgi, rh, colw, rot; const char* wsrc; const char* Ablk; };

template <bool UP, int RH>
__device__ __forceinline__ void moe_setup(MoeCtx& c, const Params& p, int l, int e, int ns, int ps, int rows, const char* Ablk) {
    typedef K8<UP, RH> C;
    const int lane = threadIdx.x & 63, wid = __builtin_amdgcn_readfirstlane(threadIdx.x >> 6), r = lane & 31;
    c.e = e; c.ns = ns; c.ps = ps; c.rows = rows; c.Ablk = Ablk;
    if (UP) { if (RH == 1) { c.cgi = wid; c.rh = 0; } else { c.cgi = wid >> 1; c.rh = wid & 1; } c.colw = c.cgi * 16 + ((r >> 4) ? (C::WCOLS / 2 - 16) : 0); }
    else    { if (RH == 1) { c.cgi = wid; c.rh = 0; c.colw = c.cgi * 32; } else { c.cgi = 4 * ps + (wid >> 1); c.rh = wid & 1; c.colw = (wid >> 1) * 32; } }
    if (UP) { const int hl = (RH == 1) ? (lane >> 5) : ((lane >> 4) & 1), cl = (RH == 1) ? (lane & 31) : (lane & 15);
              c.wsrc = (const char*)((hl ? p.in[21] : p.in[20]) + ((size_t)l * NE + e) * D * DE + ns * 128 + (RH == 2 ? ps * 64 : 0) + cl * 4); }
    else c.wsrc = (const char*)(p.in[22] + ((size_t)l * NE + e) * DE * D + ns * 256 + (RH == 2 ? ps * 128 + (lane & 31) * 4 : lane * 4));
    c.wsrc += (size_t)(wid * 4 + (RH == 2 ? (lane >> 5) : 0)) * C::WLD * 4;
    c.rot = (e * 5) & (C::NCH - 1);
}
#define M8_CK(cc) ((((cc) < C::NCH ? (cc) : C::NCH - 1) + c.rot) & (C::NCH - 1))
#define M8_WISSUE(cc, st) do { const unsigned sb_ = ldsbase + (unsigned)(st) * C::STG; const int ck_ = M8_CK(cc); const int live_ = ((cc) < C::NCH) ? RH : 0; \
        _Pragma("unroll") for (int i_ = 0; i_ < C::WP; ++i_) glds16_v((const void*)(c.wsrc + ((size_t)ck_ * C::KC + i_ * live_) * C::WLD * 4), sb_ + wdst + i_ * 1024); } while (0)
template <bool UP, int RH>
__device__ __forceinline__ void moe_early(const MoeCtx& c, ldsp_t lds) {
    typedef K8<UP, RH> C;
    const int wid = __builtin_amdgcn_readfirstlane(threadIdx.x >> 6);
    const unsigned ldsbase = (unsigned)(size_t)lds + (unsigned)MOE_L0;
    const unsigned wdst = (unsigned)C::ASZ + (unsigned)(wid * 4) * (unsigned)(C::WCOLS * 4);
#pragma unroll
    for (int i = 0; i < C::DW - 1; ++i) M8_WISSUE(i, i);
    if constexpr (RH == 2) {
        const int tid = threadIdx.x, w2 = tid & 255, wv = (2 * w2 < c.rows) ? w2 : 0;
        const unsigned off = (unsigned)((tid >> 8) * (SCAP * 8) + wv * 16);
#pragma unroll
        for (int cc = 0; cc < 2; ++cc) {
            const char* ab = c.Ablk + (size_t)M8_CK(cc) * (4 * SCAP * 8) + off;
#pragma unroll
            for (int i = 0; i < C::NPW; ++i) glds16_v((const void*)(ab + i * 2 * (SCAP * 8)), ldsbase + (unsigned)cc * C::STG + (unsigned)wid * 1024u + (unsigned)i * 8192u);
        }
    }
}
template <bool UP, int RH, int NJ, bool GATH>
__device__ __forceinline__ void moe_main(f32x16 (&acc)[8], const MoeCtx& c, ldsp_t lds, const LAS int* rowsS) {
    typedef K8<UP, RH> C;
    constexpr int ROWS = C::ROWS, NPW = C::NPW, WP = C::WP, S = C::S, DW = C::DW, WCOLS = C::WCOLS;
    constexpr float WSC = UP ? 64.f : 32.f;
    const int tid = threadIdx.x, lane = tid & 63, wid = __builtin_amdgcn_readfirstlane(tid >> 6), r = lane & 31, hh = lane >> 5;
    const unsigned ldsbase = (unsigned)(size_t)lds + (unsigned)MOE_L0;
    const unsigned lane16 = (unsigned)lane * 16u, adst = (unsigned)wid * 1024u;
    const unsigned wdst = (unsigned)C::ASZ + (unsigned)(wid * 4) * (unsigned)(WCOLS * 4);
    const unsigned wrd = (unsigned)C::ASZ + (unsigned)((8 * hh) * WCOLS + c.colw + r) * 4u;
    const unsigned ard8 = (unsigned)(hh * (ROWS * 8)) + (unsigned)((32 * c.rh + r) * 8);
    unsigned goff[NPW];
#pragma unroll
    for (int i = 0; i < NPW; ++i) {
        if (GATH) { const int slot = rowsS[tid >> 1]; goff[i] = (unsigned)(UP ? (slot >> 1) : slot) * (unsigned)(UP ? D : DE) + (unsigned)((tid & 1) * 16); }
        else {
            const int w2 = (RH == 1) ? (tid & 127) : (tid & 255), wv = (2 * w2 < c.rows) ? w2 : 0;
            goff[i] = (RH == 1) ? (unsigned)((tid >> 7) * (SCAP * 8) + wv * 16) : (unsigned)((tid >> 8) * (SCAP * 8) + wv * 16 + i * 2 * (SCAP * 8));
        }
    }
    u32x4 ra0[NPW], ra1[NPW];
#define M8_AISSUE(cc, RA) do { const void* ab_ = (const void*)(c.Ablk + (size_t)M8_CK(cc) * (GATH ? 32 : 4 * SCAP * 8)); \
        _Pragma("unroll") for (int i_ = 0; i_ < NPW; ++i_) asm volatile("global_load_dwordx4 %0, %1, %2" : "=v"(RA[i_]) : "v"(goff[i_]), "s"(ab_) : "memory"); } while (0)
#define M8_ALAND(st, RA, N, AOK) do { \
        if (NPW == 1) asm volatile("s_waitcnt vmcnt(%1)" : "+v"(RA[0]) : "n"(N) : "memory"); \
        if (NPW == 2) asm volatile("s_waitcnt vmcnt(%2)" : "+v"(RA[0]), "+v"(RA[NPW > 1 ? 1 : 0]) : "n"(N) : "memory"); \
        if (!(AOK)) { } else \
        if (GATH) { ldsp_t ap_ = lds + MOE_L0 + (st) * C::STG + (unsigned)((tid & 1) * 2 * (ROWS * 8) + (tid >> 1) * 8); \
                    *(LAS u32x2*)(ap_) = (u32x2){RA[0].x, RA[0].y}; *(LAS u32x2*)(ap_ + ROWS * 8) = (u32x2){RA[0].z, RA[0].w}; } \
        else { ldsp_t ap_ = lds + MOE_L0 + (st) * C::STG + adst + lane16; \
               _Pragma("unroll") for (int i_ = 0; i_ < NPW; ++i_) *(LAS u32x4*)(ap_ + i_ * 8192) = RA[i_]; } } while (0)
#define M8_STEP(cq, RAI, RAC, AOK) do { \
        asm volatile("s_waitcnt lgkmcnt(0)" ::: "memory"); \
        __builtin_amdgcn_s_barrier();                       \
        asm volatile("" ::: "memory"); \
        M8_AISSUE((cq) + 2, RAI); \
        { const int sn_ = (st == 0) ? S - 1 : st - 1; M8_WISSUE((cq) + DW, sn_); } \
        { ldsp_t sp = lds + MOE_L0 + st * C::STG; \
          _Pragma("unroll") for (int ks = 0; ks < 2; ++ks) { \
            float w[8]; long af[NJ]; \
            _Pragma("unroll") for (int j = 0; j < 8; ++j) w[j] = *(const LAS float*)(sp + wrd + (ks * 16 + j) * (WCOLS * 4)); \
            _Pragma("unroll") for (int j = 0; j < NJ; ++j) af[j] = *(const LAS long*)(sp + ard8 + ks * (2 * ROWS * 8) + j * (RH * 256)); \
            int lo_ = 0, hi_ = 0; \
            lo_ = __builtin_amdgcn_cvt_pk_fp8_f32(w[0] * WSC, w[1] * WSC, lo_, false); lo_ = __builtin_amdgcn_cvt_pk_fp8_f32(w[2] * WSC, w[3] * WSC, lo_, true); \
            hi_ = __builtin_amdgcn_cvt_pk_fp8_f32(w[4] * WSC, w[5] * WSC, hi_, false); hi_ = __builtin_amdgcn_cvt_pk_fp8_f32(w[6] * WSC, w[7] * WSC, hi_, true); \
            const long wf = (long)(((unsigned long long)(unsigned)hi_ << 32) | (unsigned long long)(unsigned)lo_); \
            _Pragma("unroll") for (int j = 0; j < NJ; ++j) acc[j] = __builtin_amdgcn_mfma_f32_32x32x16_fp8_fp8(wf, af[j], acc[j], 0, 0, 0); } } \
        st = (st == S - 1) ? 0 : st + 1; \
        M8_ALAND(st, RAC, 2 * WP + NPW, AOK);               \
        if (DW == 2) wait_vm<WP + NPW>();                    \
    } while (0)
    int st = 0;
    constexpr bool EARLYA = (RH == 2) && !GATH;
    if constexpr (EARLYA) {
#pragma unroll
        for (int i = 0; i < NPW; ++i) ra1[i] = (u32x4){0u, 0u, 0u, 0u};
        M8_WISSUE(DW - 1, DW - 1);
        wait_vm<WP>();
    } else {
        M8_AISSUE(0, ra0); M8_AISSUE(1, ra1); M8_WISSUE(DW - 1, DW - 1);
        M8_ALAND(0, ra0, NPW + WP, true);
    }
#pragma unroll 1
    for (int cq = 0; cq < C::NCH; cq += 2) {
        M8_STEP(cq, ra0, ra1, !EARLYA || cq > 0);
        M8_STEP(cq + 1, ra1, ra0, true);
    }
    wait_vm<0>();
    asm volatile("s_waitcnt lgkmcnt(0)" ::: "memory");
#undef M8_STEP
#undef M8_ALAND
#undef M8_AISSUE
}
#undef M8_WISSUE
#undef M8_CK

template <bool UP, int RH, bool SRT>
__device__ __forceinline__ void moe_epilogue(const f32x16 (&acc)[8], const MoeCtx& c, const Params& p, const LAS int* rowsS) {
    const int lane = threadIdx.x & 63, hh = lane >> 5;
    int r_e = lane & 31; asm volatile("" : "+v"(r_e));
    const int e = c.e, ns = c.ns, ps = c.ps, rows = c.rows, cgi = c.cgi, rh = c.rh;
    if (UP) {
        const int cis = (RH == 2 ? ps * 64 : 0) + cgi * 16;
        char* actsb = (char*)(p.ws + WS_ACTS) + ((size_t)(e * 16 + ns * 4 + (cis >> 5)) * 4 + ((cis >> 3) & 3)) * (SCAP * 8);
        char* act8 = (char*)(p.ws + WS_ACT);
#pragma unroll
        for (int mt = 0; mt < 8; ++mt) {
            const int row = 32 * (RH * mt + rh) + r_e;
            const int slot = rowsS[row & 511];
#pragma unroll
            for (int q = 0; q < 2; ++q) {
                constexpr float ISC = 1.0f / 64.0f;
                const float a0 = silu_f(acc[mt][q * 4 + 0] * ISC) * (acc[mt][(q + 2) * 4 + 0] * ISC), a1 = silu_f(acc[mt][q * 4 + 1] * ISC) * (acc[mt][(q + 2) * 4 + 1] * ISC);
                const float a2 = silu_f(acc[mt][q * 4 + 2] * ISC) * (acc[mt][(q + 2) * 4 + 2] * ISC), a3 = silu_f(acc[mt][q * 4 + 3] * ISC) * (acc[mt][(q + 2) * 4 + 3] * ISC);
                int t8 = 0; t8 = __builtin_amdgcn_cvt_pk_fp8_f32(a0, a1, t8, false); t8 = __builtin_amdgcn_cvt_pk_fp8_f32(a2, a3, t8, true);
                if (row < rows) {
                    if (SRT) *(int*)(actsb + ((unsigned)(q * (SCAP * 8)) + (unsigned)row * 8u + 4u * (unsigned)hh)) = t8;
                    else *(int*)(act8 + (size_t)slot * DE + ns * 128 + cis + 8 * q + 4 * hh) = t8;
                }
            }
        }
    } else {
        char* O8 = (char*)(p.ws + WS_O);
#pragma unroll
        for (int mt = 0; mt < 8; ++mt) {
            const int row = 32 * (RH * mt + rh) + r_e;
            const int slot = rowsS[row & 511];
            const float gwv = ((const LAS float*)(rowsS + 1024))[row & 511] * (1.0f / 32.0f);
            int t8[4];
#pragma unroll
            for (int q = 0; q < 4; ++q) { int t = 0; t = __builtin_amdgcn_cvt_pk_fp8_f32(acc[mt][q * 4 + 0] * gwv, acc[mt][q * 4 + 1] * gwv, t, false); t = __builtin_amdgcn_cvt_pk_fp8_f32(acc[mt][q * 4 + 2] * gwv, acc[mt][q * 4 + 3] * gwv, t, true); t8[q] = t; }
            const int s0 = hh ? t8[0] : t8[2], s1 = hh ? t8[1] : t8[3];
            const int r0 = __shfl_xor(s0, 32), r1 = __shfl_xor(s1, 32);
            u32x4 o4;
            if (hh) { o4.x = (unsigned)r0; o4.y = (unsigned)t8[2]; o4.z = (unsigned)r1; o4.w = (unsigned)t8[3]; }
            else    { o4.x = (unsigned)t8[0]; o4.y = (unsigned)r0; o4.z = (unsigned)t8[1]; o4.w = (unsigned)r1; }
            if (row < rows) *(u32x4*)(O8 + (size_t)slot * D + ns * 256 + cgi * 32 + 16 * hh) = o4;
        }
    }
}
template <bool UP, int RH, bool GATH>
__device__ __forceinline__ void moe_run(f32x16 (&acc)[8], const MoeCtx& c, ldsp_t lds, const LAS int* rowsS) {
#pragma unroll
    for (int mt = 0; mt < 8; ++mt)
#pragma unroll
        for (int i = 0; i < 16; ++i) acc[mt][i] = 0.f;
    const int nmt = (c.rows + 31) >> 5, njmax = (RH == 2) ? ((nmt + 1) >> 1) : nmt;
    if (njmax <= 4)      moe_main<UP, RH, 4, GATH>(acc, c, lds, rowsS);
    else if (njmax <= 5) moe_main<UP, RH, 5, GATH>(acc, c, lds, rowsS);
    else if (njmax <= 6) moe_main<UP, RH, 6, GATH>(acc, c, lds, rowsS);
    else                 moe_main<UP, RH, 8, GATH>(acc, c, lds, rowsS);
}

template <bool UP>
__device__ __forceinline__ void phase_moe(const Params& p, ldsp_t lds, int l) {
    constexpr int NSL2 = UP ? 8 : 16, NUN = NE * NSL2;
    const int tid = threadIdx.x, G = gridDim.x;
    const int* CNT = (const int*)(p.ws + WS_CTL + CTL_CNT) + l * NE; const int* LIST = (const int*)(p.ws + WS_LIST);
    const char* Agat = UP ? (const char*)(p.ws + WS_H) : (const char*)(p.ws + WS_ACT);
    LAS int* rowsS = (LAS int*)lds;
    const int vid = *(const LAS int*)(lds + LDS_BYTES - 32);
    LAS int* perm = (LAS int*)(lds + LDS_BYTES - 64 - 256);
    __syncthreads();
    if (tid < 64) {
        const int cj = CNT[tid];
        int rank = 0;
#pragma unroll
        for (int i = 0; i < 64; ++i) { const int ci = __builtin_amdgcn_readlane(cj, i); rank += (ci > cj || (ci == cj && i < tid)) ? 1 : 0; }
        const int t = rank >> 3, pos = rank & 7;
        perm[((t & 1) ? 7 - pos : pos) * 8 + t] = tid;
    }
    __syncthreads();
#define MOE_SLOT(s_) (UP ? ((s_) < 4 ? (s_) : 11 - (s_)) : ((s_) ^ (((s_) >> 1) & 1)))
#define MOE_UNIT(u, e_, ns_, ps_, cnt_) do { const int xq_ = (u) & 7, jq_ = (u) >> 3, sub_ = jq_ % NSL2, sl_ = jq_ / NSL2; e_ = perm[xq_ * 8 + MOE_SLOT(sl_)]; ns_ = sub_ >> 1; ps_ = sub_ & 1; cnt_ = CNT[e_]; } while (0)
#define MOE_ROWS(buf, e_, m0_, rows_) do { const int sl_ = LIST[(e_) * T + (m0_) + (tid < (rows_) ? tid : 0)]; rowsS[(buf) * 512 + tid] = sl_; \
        if (!UP) ((LAS float*)(rowsS + 1024))[(buf) * 512 + tid] = ((const float*)(p.ws + WS_GW))[sl_]; } while (0)
#define MOE_ASRT(e_) ((const char*)(p.ws + (UP ? WS_HG : WS_ACTS) + (size_t)(e_) * (UP ? 64 : 16) * (4 * SCAP * 8)))
    int u = vid, e = 0, ns = 0, ps = 0, cnt = 0;
    while (u < NUN) { MOE_UNIT(u, e, ns, ps, cnt); if (cnt > 0) break; u += G; }
    if (u >= NUN) return;
    int buf = 0;
    MoeCtx ctx;
    { const int rows = cnt < SCAP ? cnt : SCAP; __syncthreads(); MOE_ROWS(buf, e, 0, rows); moe_setup<UP, 2>(ctx, p, l, e, ns, ps, rows, MOE_ASRT(e)); wait_vm<0>(); moe_early<UP, 2>(ctx, lds); }
    for (;;) {
        int un = u + G, en = 0, nsn = 0, psn = 0, cntn = 0;
        while (un < NUN) { MOE_UNIT(un, en, nsn, psn, cntn); if (cntn > 0) break; un += G; }
        const bool haven = un < NUN;
        f32x16 acc[8];
        moe_run<UP, 2, false>(acc, ctx, lds, rowsS + buf * 512);
        __syncthreads();
        MoeCtx nctx = ctx;
        const bool chain = haven && cnt <= SCAP;
        if (chain) { const int rows = cntn < SCAP ? cntn : SCAP; MOE_ROWS(buf ^ 1, en, 0, rows); moe_setup<UP, 2>(nctx, p, l, en, nsn, psn, rows, MOE_ASRT(en)); moe_early<UP, 2>(nctx, lds); }
        moe_epilogue<UP, 2, true>(acc, ctx, p, rowsS + buf * 512);
        if (cnt > SCAP) {
#pragma unroll 1
            for (int m0 = SCAP; m0 < cnt; m0 += 256) {
                const int rows = (cnt - m0 < 256) ? (cnt - m0) : 256;
                __syncthreads();
                MOE_ROWS(buf, e, m0, rows);
                __syncthreads();
                if (ps == 0) {
                    MoeCtx fc; moe_setup<UP, 1>(fc, p, l, e, ns, 0, rows, Agat);
                    wait_vm<0>(); moe_early<UP, 1>(fc, lds);
                    moe_run<UP, 1, true>(acc, fc, lds, rowsS + buf * 512);
                    __syncthreads();
                    moe_epilogue<UP, 1, false>(acc, fc, p, rowsS + buf * 512);
                }
            }
        }
        if (!haven) break;
        if (!chain) { const int rows = cntn < SCAP ? cntn : SCAP; __syncthreads(); MOE_ROWS(buf ^ 1, en, 0, rows); moe_setup<UP, 2>(nctx, p, l, en, nsn, psn, rows, MOE_ASRT(en)); wait_vm<0>(); moe_early<UP, 2>(nctx, lds); }
        ctx = nctx; u = un; e = en; ns = nsn; ps = psn; cnt = cntn; buf ^= 1;
    }
#undef MOE_ASRT
#undef MOE_ROWS
#undef MOE_UNIT
#undef MOE_SLOT
}
}

#ifndef MK_KIND_MASK
#define MK_KIND_MASK 0x3ff
#endif
#define KIND(k) (((MK_KIND_MASK) >> (k)) & 1)
#ifndef MK_REP_MASK
#define MK_REP_MASK 0
#endif
#define NREP(k) (1 + (((MK_REP_MASK) >> (k)) & 1))
namespace mk {
constexpr int N_PHASES = 20;
constexpr int LDS_MISC = LDS_BYTES - 64;

#ifdef MK_STREAMTEST
__device__ __forceinline__ void phase_streamtest(const Params& p) {
    const int tid = threadIdx.x, w = blockIdx.x;
    const float* base = p.in[20];
    float4 acc = make_float4(0.f, 0.f, 0.f, 0.f);
    if (MK_STREAMTEST == 1) {
        const float4* src = (const float4*)(base + (size_t)w * 262144) + tid;
#pragma unroll 8
        for (int i = 0; i < 128; ++i) { const float4 v = src[(size_t)i * 512]; acc.x += v.x; acc.y += v.y; acc.z += v.z; acc.w += v.w; }
    } else {
        const int e = w >> 2, ns = w & 3;
        const float4* src = (const float4*)(base + (size_t)e * D * DE + ns * 128 + (size_t)(tid >> 5) * DE) + (tid & 31);
#pragma unroll 8
        for (int i = 0; i < 128; ++i) { const float4 v = src[(size_t)i * 16 * DE / 4]; acc.x += v.x; acc.y += v.y; acc.z += v.z; acc.w += v.w; }
    }
    const float s = acc.x + acc.y + acc.z + acc.w;
    if (s != s) ((float*)(p.ws + WS_END))[tid] = s;
}
#endif
struct SkipZOrder : pg8::StaticOrder {
    __device__ bool next(int i, pg8::Unit& u) const {
        const long L = (long)i * G + c;
        if (L < 480) { if (!pg8::StaticOrder::next(i, u)) return false; if (u.pn >= 8) u.pn += 4; return true; }
        if (L < 512) { const int z = (int)L - 480; u.pm = z >> 2; u.pn = 8 + (z & 3); return true; }
        return false;
    }
};
struct OneUnitOrder {
    int pm, pn;
    __device__ bool next(int i, pg8::Unit& u) const { if (i) return false; u.pm = pm; u.pn = pn; return true; }
    __device__ __forceinline__ void a_ready(const pg8::Unit&) const {}
    __device__ __forceinline__ void done(const pg8::Unit&) const {}
};
template <int L>
__device__ __forceinline__ void run_layer(const Params& p, ldsp_t lds, const XcdBarrier& bar, int lo, int hi) {
    constexpr int PB = 1 + 9 * L;
#define IN(k) (lo <= (k) && (k) < hi)
#define SEAM(k) do { if (IN(k) && IN((k) + 1)) xcd_barrier(bar); } while (0)
    if (KIND(1) && IN(PB + 0)) { if (L == 0) { { phase_norm<0>(p, 0); if constexpr ((NREP(1)) > 1) { __syncthreads(); phase_norm<0>(p, 0); __syncthreads(); } } } else phase_norm<1>(p, L); }
    SEAM(PB + 0);
    if (KIND(2) && IN(PB + 1)) {
        pg8::Gemm g{(const pg8::bf16_t*)(p.ws + WS_H), (const pg8::bf16_t*)(p.ws + WS_WTIN) + (size_t)L * NPAD * D, T, NPAD, D};
        SkipZOrder So; So.init(T, NPAD - 1024, (int)gridDim.x, (int)blockIdx.x);
        EpiProj E{(bf16_t*)(p.ws + WS_PROJ), (float*)(p.ws + WS_DT), p.in[12] + L * SH};
        { pg8::gemm_phase<EpiProj, SkipZOrder, true, true>((PG8_LAS unsigned char*)lds, g, So, E); if constexpr ((NREP(2)) > 1) { __syncthreads(); pg8::gemm_phase<EpiProj, SkipZOrder, true, true>((PG8_LAS unsigned char*)lds, g, So, E); __syncthreads(); } }
    }
    SEAM(PB + 1);
    if (KIND(3) && IN(PB + 2)) {
        auto zgemm = [&](int zu) {
            pg8::Gemm g{(const pg8::bf16_t*)(p.ws + WS_H), (const pg8::bf16_t*)(p.ws + WS_WTIN) + (size_t)L * NPAD * D, T, NPAD, D};
            OneUnitOrder So{zu >> 2, 8 + (zu & 3)};
            EpiProj E{(bf16_t*)(p.ws + WS_PROJ), (float*)(p.ws + WS_DT), p.in[12] + L * SH};
            pg8::gemm_phase<EpiProj, OneUnitOrder, true, true>((PG8_LAS unsigned char*)lds, g, So, E);
        };
        phase_mix(p, lds, L, zgemm); if constexpr ((NREP(3)) > 1) { __syncthreads(); phase_mix(p, lds, L, zgemm); __syncthreads(); }
    }
    SEAM(PB + 2);
    if (KIND(4) && IN(PB + 3)) { phase_scan(p); if constexpr ((NREP(4)) > 1) { __syncthreads(); phase_scan(p); __syncthreads(); } }
    SEAM(PB + 3);
    if (KIND(5) && IN(PB + 4)) { phase_yoff(p, lds, L); if constexpr ((NREP(5)) > 1) { __syncthreads(); phase_yoff(p, lds, L); __syncthreads(); } }
    SEAM(PB + 4);
    if (KIND(6) && IN(PB + 5)) {
        pg8::Gemm g{(const pg8::bf16_t*)(p.ws + WS_YMIX), (const pg8::bf16_t*)(p.ws + WS_WTOUT) + (size_t)L * D * D, T, D, D};
        pg8::StaticOrder So; So.init(T, D, (int)gridDim.x, (int)blockIdx.x);
        EpiRes<(L == 0)> E{(L == 0) ? p.in[0] : (const float*)nullptr, (bf16_t*)(p.ws + WS_X), (const float*)(p.ws + WS_ADA) + (size_t)L * NB * 6 * D + 2 * D};
        { pg8::gemm_phase<EpiRes<(L == 0)>, pg8::StaticOrder, true, true>((PG8_LAS unsigned char*)lds, g, So, E); if constexpr (((L == 0 ? NREP(6) : 1)) > 1) { __syncthreads(); pg8::gemm_phase<EpiRes<(L == 0)>, pg8::StaticOrder, true, true>((PG8_LAS unsigned char*)lds, g, So, E); __syncthreads(); } }
    }
    SEAM(PB + 5);
    if (KIND(7) && IN(PB + 6)) { phase_router(p, lds, L); if constexpr ((NREP(7)) > 1) { __syncthreads(); phase_router(p, lds, L, true); __syncthreads(); } }
    SEAM(PB + 6);
    if (KIND(8) && IN(PB + 7)) { phase_moe<true>(p, lds, L); if constexpr ((NREP(8)) > 1) { __syncthreads(); phase_moe<true>(p, lds, L); __syncthreads(); } }
    SEAM(PB + 7);
    if (KIND(9) && IN(PB + 8)) { phase_moe<false>(p, lds, L); if constexpr ((NREP(9)) > 1) { __syncthreads(); phase_moe<false>(p, lds, L); __syncthreads(); } }
    SEAM(PB + 8);
#undef IN
#undef SEAM
}

__global__ void __launch_bounds__(NT, 2) mk_fwd(Params p) {
    extern __shared__ __attribute__((aligned(16))) unsigned char lds_raw[];
    ldsp_t lds = (ldsp_t)lds_raw;
    const int lo = p.ph_lo, hi = p.ph_hi;
    volatile LAS unsigned* misc = (volatile LAS unsigned*)(lds + LDS_MISC);
    if (threadIdx.x < 16) misc[threadIdx.x] = 0u;
    __syncthreads();
    XcdBarrier bar; bar.bar = (unsigned*)(p.ws + WS_CTL); bar.x = 0; bar.st = misc;
    if (hi - lo > 1) bar = xcd_barrier_post((unsigned*)(p.ws + WS_CTL), misc);
    if (threadIdx.x == 0) { const unsigned myx = xb_xcc_id() & 7u; misc[9] = myx; misc[10] = __hip_atomic_fetch_add((unsigned*)(p.ws + WS_CTL + CTL_CNT + 4096) + myx * 16 + (lo > 0 ? 8 : 0), 1u, __ATOMIC_RELAXED, __HIP_MEMORY_SCOPE_AGENT); misc[8] = blockIdx.x; }
#ifdef MK_STREAMTEST
    if (lo <= 0) { phase_streamtest(p); __syncthreads(); }
#endif
    if (KIND(0) && lo <= 0 && 0 < hi) { phase_prologue(p, lds, 2, (int)blockIdx.x, (int)gridDim.x); if constexpr ((NREP(0)) > 1) { __syncthreads(); phase_prologue(p, lds, 2, (int)blockIdx.x, (int)gridDim.x); __syncthreads(); } }
    if (lo <= 0 && 1 < hi) xcd_barrier(bar);
    if (hi - lo > 1 && threadIdx.x == 0) {
        bool even = (gridDim.x & 7u) == 0u;
        for (int j = 0; j < 16; ++j) { const unsigned c = xb_ld(&bar.bar[XB_XCNT(j)]); if (c != ((j < 8) ? gridDim.x / 8u : 0u)) even = false; }
        if (even) misc[8] = misc[9] + 8u * misc[10];
    }
    __syncthreads();
    run_layer<0>(p, lds, bar, lo, hi);
#ifdef MK_XBAR
    for (int xb = 0; xb < MK_XBAR; ++xb) xcd_barrier(bar);
#endif
    run_layer<1>(p, lds, bar, lo, hi);
    if (KIND(1) && lo <= 19 && 19 < hi) { phase_norm<2>(p, 1); if constexpr ((NREP(1)) > 1) { __syncthreads(); phase_norm<2>(p, 1); __syncthreads(); } }
}
}

extern "C" void kernel_launch(void* const* d_in, const int* in_sizes, int n_in, void* d_out, int out_size, void* d_ws, size_t ws_size, hipStream_t stream) {
    using namespace mk;
    static int grid = 0;
    if (grid == 0) {
        if (n_in != 24 || ws_size < WS_END) { fprintf(stderr, "kernel_launch: unexpected inputs (n_in %d, ws %zu < %zu)\n", n_in, ws_size, (size_t)WS_END); grid = -1; return; }
        int dev = 0, cus = 0, per_cu = 0;
        if (hipGetDevice(&dev) != hipSuccess || hipDeviceGetAttribute(&cus, hipDeviceAttributeMultiprocessorCount, dev) != hipSuccess) { grid = -1; return; }
        if (hipFuncSetAttribute((const void*)mk_fwd, hipFuncAttributeMaxDynamicSharedMemorySize, LDS_BYTES) != hipSuccess) { fprintf(stderr, "kernel_launch: hipFuncSetAttribute failed\n"); grid = -1; return; }
        if (hipOccupancyMaxActiveBlocksPerMultiprocessor(&per_cu, (const void*)mk_fwd, NT, LDS_BYTES) != hipSuccess || per_cu < 1) fprintf(stderr, "kernel_launch: occupancy query says %d\n", per_cu);
        (void)hipGetLastError();
        grid = cus;
    }
    if (grid < 0) return;
    (void)in_sizes; (void)out_size;
    if (hipMemsetAsync((char*)d_ws + WS_CTL, 0, CTL_BYTES, stream) != hipSuccess) return;
    Params prm{};
    for (int i = 0; i < 24; ++i) prm.in[i] = (const float*)d_in[i];
    prm.out = (float*)d_out; prm.ws = (unsigned char*)d_ws;
#if MK_N_LAUNCHES == 1
    prm.ph_lo = 0; prm.ph_hi = N_PHASES;
    hipLaunchKernelGGL(mk_fwd, dim3(grid), dim3(NT), LDS_BYTES, stream, prm);
#else
    for (int k = 0; k < N_PHASES; ++k) { prm.ph_lo = k; prm.ph_hi = k + 1; hipLaunchKernelGGL(mk_fwd, dim3(grid), dim3(NT), LDS_BYTES, stream, prm); }
#endif
    const hipError_t le = hipPeekAtLastError();
    if (le != hipSuccess) fprintf(stderr, "kernel_launch: launch failed: %s\n", hipGetErrorName(le));
}
```

```cpp
#include <hip/hip_runtime.h>
#include <stdint.h>
#include <stdio.h>

#ifndef MK_N_LAUNCHES
#define MK_N_LAUNCHES 1
#endif

namespace mk {
constexpr int D = 2048, NB = 4, S = 2048, T = NB * S;
constexpr int GH = 8, CH = 128, NC = S / CH;
constexpr int SW = 1024, SHD = 64, SH = 16, SG = 2, SN = 128, CONVD = 1536, NPROJ = 4624;
constexpr int NPJ = 4608;
constexpr int NPAD = 4864;
constexpr int NE = 64, NGRP = 8, EPG = 8, DE = 512;
constexpr float EPS = 1e-6f;
constexpr int NT = 512;
constexpr int LDS_BYTES = 160 * 1024 - 512;

typedef unsigned short bf16_t;
typedef short bf16x8 __attribute__((ext_vector_type(8)));
typedef float f32x4 __attribute__((ext_vector_type(4)));
typedef float f32x16 __attribute__((ext_vector_type(16)));
typedef unsigned u32x4 __attribute__((ext_vector_type(4)));
typedef unsigned u32x2 __attribute__((ext_vector_type(2)));

constexpr size_t al(size_t x) { return (x + 255) & ~(size_t)255; }
constexpr size_t WS_CTL = 0, CTL_BYTES = 64 * 1024;
constexpr size_t CTL_CNT = 32 * 1024;
constexpr size_t WS_ADA = WS_CTL + CTL_BYTES;
constexpr size_t WS_WTIN = WS_ADA + al((size_t)2 * NB * 6 * D * 4);
constexpr size_t WS_WTOUT = WS_WTIN + al((size_t)2 * NPAD * D * 2);
constexpr size_t WS_RWH = WS_WTOUT + al((size_t)2 * D * D * 2);
constexpr size_t WS_RWL = WS_RWH + al((size_t)NE * D * 2);
constexpr size_t WS_WSB = WS_RWL + al((size_t)NE * D * 2);
constexpr size_t WS_X = WS_WSB + al((size_t)2 * GH * 128 * 128 * 2);
constexpr size_t WS_H = WS_X + al((size_t)T * D * 4);
constexpr size_t WS_PROJ = WS_H + al((size_t)T * D * 2);
constexpr size_t WS_DT = WS_PROJ + al((size_t)T * NPJ * 2);
constexpr size_t WS_ACS = WS_DT + al((size_t)T * SH * 4);
constexpr size_t WS_YD = WS_ACS + al((size_t)T * SH * 4);
constexpr size_t WS_STATES = WS_YD + al((size_t)T * SW * 2);
constexpr size_t WS_PREV = WS_STATES + al((size_t)NB * NC * SH * SHD * SN * 4);
constexpr size_t WS_YMIX = WS_PREV + al((size_t)NB * NC * SH * SHD * SN * 2);
constexpr size_t WS_LIST = WS_YMIX + al((size_t)T * D * 2);
constexpr size_t WS_GW = WS_LIST + al((size_t)NE * T * 4);
constexpr size_t WS_ACT = WS_GW + al((size_t)T * 2 * 4);
constexpr size_t WS_O = WS_ACT + al((size_t)T * 2 * DE * 2);
#ifndef MK_SCAP
#define MK_SCAP 512
#endif
constexpr int SCAP = MK_SCAP;
constexpr size_t WS_HG = WS_O + al((size_t)T * 2 * D * 2);
constexpr size_t WS_ACTS = WS_HG + al((size_t)NE * 64 * SCAP * 64);
constexpr size_t WS_END = WS_ACTS + al((size_t)NE * 16 * SCAP * 64);

struct Params {
    const float* in[24];
    float* out;
    unsigned char* ws;
    int ph_lo, ph_hi;
};

__device__ __forceinline__ float silu_f(float x) { return x * __builtin_amdgcn_rcpf(1.0f + __expf(-x)); }
__device__ __forceinline__ float softplus_f(float x) { return x > 20.f ? x : log1pf(__expf(x)); }
typedef __bf16 bf16x2_t __attribute__((ext_vector_type(2)));
__device__ __forceinline__ unsigned pk_bf16(float lo, float hi) { bf16x2_t v; v.x = (__bf16)lo; v.y = (__bf16)hi; return __builtin_bit_cast(unsigned, v); }
__device__ __forceinline__ float bf_lo(unsigned u) { return __uint_as_float(u << 16); }
__device__ __forceinline__ float bf_hi(unsigned u) { return __uint_as_float(u & 0xffff0000u); }
__device__ __forceinline__ bf16_t f2bf(float f) { return (bf16_t)(pk_bf16(f, 0.f) & 0xffffu); }
}

namespace pg8 {
#define PG8_LAS __attribute__((address_space(3)))
typedef unsigned short bf16_t;
typedef short bf16x8 __attribute__((ext_vector_type(8)));
typedef float f32x4 __attribute__((ext_vector_type(4)));
typedef unsigned u32x4 __attribute__((ext_vector_type(4)));
constexpr int BM = 256, BK = 64, HALF = 128, HTB = HALF * BK * 2  , STAGE_BYTES = 8 * HTB, NXCD = 8, WGM = 8;

__host__ __device__ __forceinline__ int lds_byte(int r, int c) { const int st = (r >> 4) * 2 + (c >> 5), rr = r & 15, cc = c & 31, ob = rr * 64 + cc * 2; return st * 1024 + (ob ^ (((ob >> 9) & 1) << 5)); }
__host__ __device__ __forceinline__ void stage_rc(int b, int& R, int& C) { const int st = b / 1024, sb = b % 1024, swz = sb ^ (((sb >> 9) & 1) << 5); R = (st >> 1) * 16 + swz / 64; C = (st & 1) * 32 + (swz % 64) / 2; }
__host__ __device__ __forceinline__ int perm32(int rho) { const int n = rho >> 4, i = rho & 15; return 8 * (i >> 2) + 4 * n + (i & 3); }

struct Unit { int pm, pn; };
struct Gemm { const bf16_t* A; const bf16_t* Bt; int M, N, K; };

struct StaticOrder {
    int nM, nN, nwg, G, c;
    __host__ __device__ void init(int M, int N, int G_, int c_) { nM = M / BM; nN = N / BM; nwg = nM * nN; G = G_; c = c_; }
    __host__ __device__ bool next(int i, Unit& u) const {
        const long L = (long)i * G + c; if (L >= nwg) return false;
        int wgid = (int)L; { const int q = nwg / NXCD, r = nwg % NXCD, xcd = wgid % NXCD, off = wgid / NXCD; wgid = (xcd < r ? xcd * (q + 1) : r * (q + 1) + (xcd - r) * q) + off; }
        const int nig = WGM * nN, gid = wgid / nig, fm = gid * WGM, gsz = (nM - fm) < WGM ? (nM - fm) : WGM;
        u.pm = fm + ((wgid % nig) % gsz); u.pn = (wgid % nig) / gsz; return true;
    }
    __device__ __forceinline__ void a_ready(const Unit&) const {}
    __device__ __forceinline__ void done(const Unit&) const {}
};

__device__ __forceinline__ unsigned cvt_pk_bf16(float lo, float hi) { unsigned r; asm volatile("v_cvt_pk_bf16_f32 %0, %1, %2" : "=v"(r) : "v"(lo), "v"(hi)); return r; }
typedef float f32x2 __attribute__((ext_vector_type(2)));
__device__ __forceinline__ f32x2 gelu_pk(f32x2 v) {
    const f32x2 av = __builtin_elementwise_abs(v), d = av * 0.2316418882f + 1.0f;
    f32x2 t; t.x = __builtin_amdgcn_rcpf(d.x); t.y = __builtin_amdgcn_rcpf(d.y);
    f32x2 q = t * 0.5307027145f + (-0.7265760135f); q = q * t + 0.7107068705f; q = q * t + (-0.142248368f); q = q * t + 0.127414796f; q = q * t;
    const f32x2 s = (v * v) * (-0.72134752044f);
    f32x2 e; e.x = __builtin_amdgcn_exp2f(s.x); e.y = __builtin_amdgcn_exp2f(s.y);
    const f32x2 m = v * (q * e), r = v - m;
    f32x2 o; o.x = v.x < 0.f ? m.x : r.x; o.y = v.y < 0.f ? m.y : r.y; return o;
}

template <class Epi, class Sched, bool ALIGN_EPI = false, bool SP2 = false>
__device__ __forceinline__ void gemm_phase(PG8_LAS unsigned char* lds, const Gemm g, const Sched& S, const Epi& E) {
    const int tid = threadIdx.x, wid = __builtin_amdgcn_readfirstlane(tid >> 6), lane = tid & 63, wr = wid >> 2, wc = wid & 3, fr = lane & 15, fq = lane >> 4;
    const int K = g.K, nt = K / BK;
    unsigned voffA[2], voffB[2];
#pragma unroll
    for (int i = 0; i < 2; ++i) { int R, C; stage_rc(tid * 16 + i * 8192, R, C); const int Rb = Epi::PERM ? ((R & ~31) + perm32(R & 31)) : R;
        voffA[i] = (unsigned)(R * K + C) * 2u; voffB[i] = (unsigned)(Rb * K + C) * 2u; }
    const size_t kstep = (size_t)(BK * 2);
    const size_t hstep = (size_t)HALF * K * 2;
    const size_t tstep = 2 * hstep;
    const unsigned ldsw = (unsigned)wid * 1024u;
    const int aoff = lds_byte(wr * 64 + fr, fq * 8), boff = lds_byte(wc * 32 + fr, fq * 8);
#define PG8_SA(b, h) (((b) * 2 + (h)) * HTB)
#define PG8_SB(b, h) ((4 + (b) * 2 + (h)) * HTB)
#define PG8_STAGE(bufoff, gbase, voff) do { _Pragma("unroll") for (int _i = 0; _i < 2; ++_i) \
        __builtin_amdgcn_global_load_lds((const unsigned*)((const char*)(gbase) + (voff)[_i]), (PG8_LAS unsigned*)(lds + (bufoff) + ldsw + _i * 8192), 16, 0, 0); } while (0)
#define PG8_LDA(dst, b, h) do { _Pragma("unroll") for (int m = 0; m < 4; ++m) _Pragma("unroll") for (int k = 0; k < 2; ++k) dst[m][k] = *(const PG8_LAS bf16x8*)(lds + PG8_SA(b, h) + aoff + m * 2048 + k * 1024); } while (0)
#define PG8_LDB(dst, b, h) do { _Pragma("unroll") for (int n = 0; n < 2; ++n) _Pragma("unroll") for (int k = 0; k < 2; ++k) dst[n][k] = *(const PG8_LAS bf16x8*)(lds + PG8_SB(b, h) + boff + n * 2048 + k * 1024); } while (0)
#define PG8_MMA(ai, bj, At, Bt) do { __builtin_amdgcn_s_setprio(1); _Pragma("unroll") for (int m = 0; m < 4; ++m) _Pragma("unroll") for (int n = 0; n < 2; ++n) _Pragma("unroll") for (int k = 0; k < 2; ++k) \
        acc[ai][bj][m][n] = __builtin_amdgcn_mfma_f32_16x16x32_bf16(Bt[n][k], At[m][k], acc[ai][bj][m][n], 0, 0, 0); __builtin_amdgcn_s_setprio(0); } while (0)
#define PG8_WAIT_V(n) asm volatile("s_waitcnt vmcnt(" #n ")" ::: "memory")
#define PG8_WAIT_L(n) asm volatile("s_waitcnt lgkmcnt(" #n ")" ::: "memory")
#define PG8_BAR __builtin_amdgcn_s_barrier()
#define PG8_SCHED __builtin_amdgcn_sched_barrier(0)
    Unit cur, nxt; int ui = 0;
    if (!S.next(0, cur)) return;
    f32x4 acc[2][2][4][2];
#pragma unroll
    for (int a = 0; a < 2; ++a)
#pragma unroll
        for (int b = 0; b < 2; ++b)
#pragma unroll
            for (int m = 0; m < 4; ++m)
#pragma unroll
                for (int n = 0; n < 2; ++n) acc[a][b][m][n] = (f32x4){0.f, 0.f, 0.f, 0.f};
    bf16x8 At[4][2], B0[2][2], B1[2][2];
    const char* cA = (const char*)g.A + (size_t)cur.pm * tstep; const char* cB = (const char*)g.Bt + (size_t)cur.pn * tstep;
    S.a_ready(cur);
    if constexpr (SP2) {
        PG8_STAGE(PG8_SB(0, 0), cB, voffB); PG8_STAGE(PG8_SB(0, 1), cB + hstep, voffB); PG8_STAGE(PG8_SA(0, 0), cA, voffA); PG8_STAGE(PG8_SA(0, 1), cA + hstep, voffA);
        if (wr == 1) PG8_BAR;
        PG8_WAIT_V(2); PG8_BAR;
        PG8_STAGE(PG8_SB(1, 0), cB + kstep, voffB); PG8_STAGE(PG8_SA(1, 0), cA + kstep, voffA); PG8_STAGE(PG8_SB(1, 1), cB + hstep + kstep, voffB);
        PG8_WAIT_V(6); PG8_BAR;
    } else {
        PG8_STAGE(PG8_SB(0, 0), cB, voffB); PG8_STAGE(PG8_SA(0, 0), cA, voffA); PG8_STAGE(PG8_SB(0, 1), cB + hstep, voffB); PG8_STAGE(PG8_SA(0, 1), cA + hstep, voffA);
        if (wr == 1) PG8_BAR;
        PG8_WAIT_V(4); PG8_BAR;
        PG8_STAGE(PG8_SB(1, 0), cB + kstep, voffB); PG8_STAGE(PG8_SA(1, 0), cA + kstep, voffA); PG8_STAGE(PG8_SB(1, 1), cB + hstep + kstep, voffB);
        PG8_WAIT_V(6); PG8_BAR;
    }
    for (;;) {
        const bool has_next = S.next(ui + 1, nxt);
        const char* nA = has_next ? (const char*)g.A + (size_t)nxt.pm * tstep : cA; const char* nB = has_next ? (const char*)g.Bt + (size_t)nxt.pn * tstep : cB;
        for (int t = 0; t < nt; t += 2) {
            const bool last = (t == nt - 2);
            const char* a1 = cA + (size_t)(t + 1) * kstep;
            const char* a2 = last ? nA : cA + (size_t)(t + 2) * kstep; const char* b2 = last ? nB : cB + (size_t)(t + 2) * kstep;
            const char* a3 = a2 + kstep; const char* b3 = b2 + kstep;
            if (last && has_next) S.a_ready(nxt);
            if constexpr (SP2) {
            PG8_LDB(B0, 0, 0); PG8_LDB(B1, 0, 1); PG8_SCHED; PG8_LDA(At, 0, 0); PG8_STAGE(PG8_SA(1, 1), a1 + hstep, voffA);
            PG8_WAIT_V(8); PG8_WAIT_L(0); PG8_BAR; PG8_MMA(0, 0, At, B0); PG8_MMA(0, 1, At, B1); PG8_BAR; PG8_SCHED;
            PG8_LDA(At, 0, 1); PG8_STAGE(PG8_SB(0, 0), b2, voffB); PG8_STAGE(PG8_SB(0, 1), b2 + hstep, voffB); PG8_STAGE(PG8_SA(0, 0), a2, voffA);
            PG8_WAIT_V(8); PG8_WAIT_L(0); PG8_BAR; PG8_MMA(1, 0, At, B0); PG8_MMA(1, 1, At, B1); PG8_BAR; PG8_SCHED;
            PG8_LDB(B0, 1, 0); PG8_LDB(B1, 1, 1); PG8_SCHED; PG8_LDA(At, 1, 0); PG8_STAGE(PG8_SA(0, 1), a2 + hstep, voffA);
            PG8_WAIT_V(8); PG8_WAIT_L(0); PG8_BAR; PG8_MMA(0, 0, At, B0); PG8_MMA(0, 1, At, B1); PG8_BAR; PG8_SCHED;
            PG8_LDA(At, 1, 1); PG8_STAGE(PG8_SB(1, 0), b3, voffB); PG8_STAGE(PG8_SB(1, 1), b3 + hstep, voffB); PG8_STAGE(PG8_SA(1, 0), a3, voffA);
            PG8_WAIT_V(8); PG8_WAIT_L(0); PG8_BAR; PG8_MMA(1, 0, At, B0); PG8_MMA(1, 1, At, B1); PG8_BAR; PG8_SCHED;
            } else {
            PG8_LDB(B0, 0, 0); PG8_SCHED; PG8_LDA(At, 0, 0); PG8_STAGE(PG8_SA(1, 1), a1 + hstep, voffA);
            PG8_WAIT_L(8); PG8_BAR; PG8_WAIT_L(0); PG8_MMA(0, 0, At, B0); PG8_BAR; PG8_SCHED;
            PG8_LDB(B1, 0, 1); PG8_STAGE(PG8_SB(0, 0), b2, voffB);
            PG8_BAR; PG8_WAIT_L(0); PG8_MMA(0, 1, At, B1); PG8_BAR;
            PG8_LDA(At, 0, 1); PG8_STAGE(PG8_SA(0, 0), a2, voffA);
            PG8_BAR; PG8_WAIT_L(0); PG8_MMA(1, 0, At, B0); PG8_BAR; PG8_SCHED;
            PG8_STAGE(PG8_SB(0, 1), b2 + hstep, voffB);
            PG8_WAIT_V(6); PG8_BAR; PG8_MMA(1, 1, At, B1); PG8_BAR;
            PG8_LDB(B0, 1, 0); PG8_SCHED; PG8_LDA(At, 1, 0); PG8_STAGE(PG8_SA(0, 1), a2 + hstep, voffA);
            PG8_WAIT_L(8); PG8_BAR; PG8_WAIT_L(0); PG8_MMA(0, 0, At, B0); PG8_BAR; PG8_SCHED;
            PG8_LDB(B1, 1, 1); PG8_STAGE(PG8_SB(1, 0), b3, voffB);
            PG8_BAR; PG8_WAIT_L(0); PG8_MMA(0, 1, At, B1); PG8_BAR;
            PG8_LDA(At, 1, 1); PG8_STAGE(PG8_SA(1, 0), a3, voffA);
            PG8_BAR; PG8_WAIT_L(0); PG8_MMA(1, 0, At, B0); PG8_BAR; PG8_SCHED;
            PG8_STAGE(PG8_SB(1, 1), b3 + hstep, voffB);
            PG8_WAIT_V(6); PG8_BAR; PG8_MMA(1, 1, At, B1); PG8_BAR;
            }
        }
        if constexpr (ALIGN_EPI) { if (wr == 0) PG8_BAR; }
        if constexpr (!Epi::AFTER_DRAIN) { E(acc, cur, wr, wc, fr, fq); S.done(cur); }
        if (!has_next) break;
#pragma unroll
        for (int a = 0; a < 2; ++a)
#pragma unroll
            for (int b = 0; b < 2; ++b)
#pragma unroll
                for (int m = 0; m < 4; ++m)
#pragma unroll
                    for (int n = 0; n < 2; ++n) acc[a][b][m][n] = (f32x4){0.f, 0.f, 0.f, 0.f};
        cur = nxt; cA = nA; cB = nB; ++ui;
        if constexpr (ALIGN_EPI) { if (wr == 1) PG8_BAR; }
    }
    PG8_WAIT_V(0);
    if constexpr (!ALIGN_EPI) { if (wr == 0) PG8_BAR; }
    PG8_BAR;
    if constexpr (Epi::AFTER_DRAIN) { E.fused(acc, cur, wr, wc, fr, fq, lds, wid, lane); S.done(cur); }
#undef PG8_SA
#undef PG8_SB
#undef PG8_STAGE
#undef PG8_LDA
#undef PG8_LDB
#undef PG8_MMA
#undef PG8_WAIT_V
#undef PG8_WAIT_L
#undef PG8_BAR
#undef PG8_SCHED
}

}

#define XB_TMO      128
#define XB_XCNT(j)  (256  + 64 * (j))
#define XB_XSUB(j)  (1280 + 64 * (j))
#define XB_XGEN(j)  (2304 + 64 * (j))
#define XB_TOP      3328
#define XB_TOPGEN   3392
#define XCD_BAR_WORDS 3456
#define XB_SPIN_CAP (1u << 18)
#define LAS __attribute__((address_space(3)))

__device__ __forceinline__ unsigned xb_ld(unsigned* p)              { return __hip_atomic_load(p, __ATOMIC_RELAXED, __HIP_MEMORY_SCOPE_AGENT); }
__device__ __forceinline__ unsigned xb_add(unsigned* p, unsigned v) { return __hip_atomic_fetch_add(p, v, __ATOMIC_RELAXED, __HIP_MEMORY_SCOPE_AGENT); }
__device__ __forceinline__ unsigned xb_xcc_id() { return (unsigned)__builtin_amdgcn_s_getreg((3 << 11) | 20) & 0xFu; }
#define XB_SPIN(cond, bar) do { unsigned _sp = 0; while (cond) { __builtin_amdgcn_s_sleep(1); \
    if ((++_sp & 255u) == 0u) { if (xb_ld(&(bar)[XB_TMO])) break; if (_sp > XB_SPIN_CAP) { atomicAdd(&(bar)[XB_TMO], 1u); break; } } } } while (0)

struct XcdBarrier {
    unsigned* bar; unsigned x;
    volatile LAS unsigned* st;
};

__device__ __forceinline__ XcdBarrier xcd_barrier_post(unsigned* bar, volatile LAS unsigned* st) {
    XcdBarrier b; b.bar = bar; b.x = xb_xcc_id(); b.st = st;
    if (threadIdx.x == 0) (void)xb_add(&bar[XB_XCNT(b.x)], 1u);
    return b;
}
__device__ __forceinline__ void xcd_barrier_complete(unsigned* bar, unsigned x, unsigned& nloc, unsigned& nx) {
    const unsigned G = gridDim.x * gridDim.y * gridDim.z;
    unsigned sum, cnt, mine, sp = 0u;
    for (;;) {
        sum = 0u; cnt = 0u; mine = 0u;
#pragma unroll
        for (unsigned j = 0; j < 16; ++j) { const unsigned c = xb_ld(&bar[XB_XCNT(j)]); sum += c; cnt += (c > 0u) ? 1u : 0u; mine = (j == x) ? c : mine; }
        if (sum == G) break;
        __builtin_amdgcn_s_sleep(1);
        if ((++sp & 255u) == 0u) { if (xb_ld(&bar[XB_TMO])) break; if (sp > XB_SPIN_CAP) { atomicAdd(&bar[XB_TMO], 1u); break; } }
    }
    nloc = mine > 0u ? mine : 1u; nx = cnt > 0u ? cnt : 1u;
}

__device__ __forceinline__ void xcd_barrier(const XcdBarrier& b) {
    asm volatile("s_waitcnt vmcnt(0)" ::: "memory");
    __syncthreads();
    if (threadIdx.x == 0) {
        unsigned* bar = b.bar;
        __builtin_amdgcn_s_waitcnt(0);
        unsigned nloc = b.st[0], nx = b.st[1];
        if (nloc == 0u) { xcd_barrier_complete(bar, b.x, nloc, nx); b.st[0] = nloc; b.st[1] = nx; }
        const unsigned old = xb_add(&bar[XB_XSUB(b.x)], 1u);
        const unsigned gen = old / nloc;
        if (old + 1u == (gen + 1u) * nloc) {
            __builtin_amdgcn_fence(__ATOMIC_RELEASE, "agent");
            asm volatile("s_waitcnt vmcnt(0)" ::: "memory");
            const unsigned og = xb_add(&bar[XB_TOP], 1u);
            const unsigned tg = og / nx;
            if (og + 1u == (tg + 1u) * nx) xb_add(&bar[XB_TOPGEN], 1u);
            else XB_SPIN(xb_ld(&bar[XB_TOPGEN]) == tg, bar);
            __builtin_amdgcn_fence(__ATOMIC_ACQUIRE, "agent");
            xb_add(&bar[XB_XGEN(b.x)], 1u);
            asm volatile("s_waitcnt vmcnt(0)" ::: "memory");
        } else {
            XB_SPIN(xb_ld(&bar[XB_XGEN(b.x)]) == gen, bar);
            __builtin_amdgcn_fence(__ATOMIC_ACQUIRE, "agent");
            asm volatile("s_waitcnt vmcnt(0)" ::: "memory");
        }
    }
    __syncthreads();
}


namespace mk {
using pg8::cvt_pk_bf16;
typedef LAS unsigned char* ldsp_t;

template <int NT_>
__device__ __forceinline__ void transpose_tiles(const float* __restrict__ src, int ldn, int nvalid, bf16_t* __restrict__ dst_hi, bf16_t* __restrict__ dst_lo, int K, int k0, int n0,
                                                LAS float* tile, int tid) {
    float4 v[NT_][2];
#pragma unroll
    for (int t = 0; t < NT_; ++t)
#pragma unroll
        for (int i = 0; i < 2; ++i) {
            const int r = (tid >> 4) + 32 * i, n = n0 + t * 64 + (tid & 15) * 4;
            v[t][i] = make_float4(0.f, 0.f, 0.f, 0.f);
            if (n < nvalid) v[t][i] = *(const float4*)(src + (size_t)(k0 + r) * ldn + n);
        }
#pragma unroll
    for (int t = 0; t < NT_; ++t) {
        LAS float* tl = tile + (t & 1) * (64 * 65);
#pragma unroll
        for (int i = 0; i < 2; ++i) {
            const int r = (tid >> 4) + 32 * i, c4 = (tid & 15) * 4;
            tl[r * 65 + c4 + 0] = v[t][i].x; tl[r * 65 + c4 + 1] = v[t][i].y; tl[r * 65 + c4 + 2] = v[t][i].z; tl[r * 65 + c4 + 3] = v[t][i].w;
        }
        __syncthreads();
        const int n = tid >> 3, ko = (tid & 7) * 8;
        float f[8];
#pragma unroll
        for (int j = 0; j < 8; ++j) f[j] = tl[(ko + j) * 65 + n];
        u32x4 h; h.x = pk_bf16(f[0], f[1]); h.y = pk_bf16(f[2], f[3]); h.z = pk_bf16(f[4], f[5]); h.w = pk_bf16(f[6], f[7]);
        *(u32x4*)(dst_hi + (size_t)(n0 + t * 64 + n) * K + k0 + ko) = h;
        if (dst_lo) {
            u32x4 lo;
            lo.x = pk_bf16(f[0] - bf_lo(h.x), f[1] - bf_hi(h.x)); lo.y = pk_bf16(f[2] - bf_lo(h.y), f[3] - bf_hi(h.y));
            lo.z = pk_bf16(f[4] - bf_lo(h.z), f[5] - bf_hi(h.z)); lo.w = pk_bf16(f[6] - bf_lo(h.w), f[7] - bf_hi(h.w));
            *(u32x4*)(dst_lo + (size_t)(n0 + t * 64 + n) * K + k0 + ko) = lo;
        }
    }
    __syncthreads();
}

__device__ __forceinline__ void phase_prologue(const Params& p, ldsp_t lds, int which, int rank, int nrank) {
    const int tid = threadIdx.x;
    LAS float* sc = (LAS float*)lds;
    LAS float* red = (LAS float*)(lds + 32768);
    LAS float* tile = (LAS float*)(lds + 65536);
    const float* c = p.in[1]; const float* ada_w = p.in[2]; const float* ada_b = p.in[3];
    float* ADA = (float*)(p.ws + WS_ADA);
    for (int i = tid; i < NB * D; i += NT) sc[i] = silu_f(c[i]);
    __syncthreads();
    constexpr int U_ADA = 768, U_WIN = 32 * 19, U_WOUT = 32 * 8, U_RT = 32, U_WSB = 64;
    constexpr int U_TOT = U_ADA + 2 * U_WIN + 2 * U_WOUT + U_RT + U_WSB;
    for (int u0 = rank; u0 < U_TOT; u0 += nrank) {
        const int u = u0;
        int ul = -1;
        if (u < U_ADA) ul = u / 384; else if (u < U_ADA + 2 * U_WIN) ul = (u - U_ADA) / U_WIN; else if (u < U_ADA + 2 * U_WIN + 2 * U_WOUT) ul = (u - U_ADA - 2 * U_WIN) / U_WOUT;
        if ((which == 0 && ul == 1) || (which == 1 && ul != 1)) continue;
        if (u < U_ADA) {
            const int l = u / 384, cg = u % 384, cl = tid & 7, ks = tid >> 3;
            const float* w = ada_w + ((size_t)l * D + ks * 32) * (6 * D) + cg * 32 + cl * 4;
            float acc[4][4];
#pragma unroll
            for (int b = 0; b < 4; ++b)
#pragma unroll
                for (int i = 0; i < 4; ++i) acc[b][i] = 0.f;
#pragma unroll 16
            for (int kk = 0; kk < 32; ++kk) {
                const float4 wv = *(const float4*)(w + (size_t)kk * (6 * D));
#pragma unroll
                for (int b = 0; b < 4; ++b) { const float s = sc[b * D + ks * 32 + kk]; acc[b][0] += s * wv.x; acc[b][1] += s * wv.y; acc[b][2] += s * wv.z; acc[b][3] += s * wv.w; }
            }
#pragma unroll
            for (int b = 0; b < 4; ++b)
#pragma unroll
                for (int i = 0; i < 4; ++i) red[(ks * 4 + b) * 32 + cl * 4 + i] = acc[b][i];
            __syncthreads();
            if (tid < 128) {
                const int b = tid >> 5, col = tid & 31;
                float s = 0.f;
                for (int k2 = 0; k2 < 64; ++k2) s += red[(k2 * 4 + b) * 32 + col];
                ADA[((size_t)l * NB + b) * (6 * D) + cg * 32 + col] = s + ada_b[l * 6 * D + cg * 32 + col];
            }
            __syncthreads();
        } else if (u < U_ADA + 2 * U_WIN) {
            const int v = u - U_ADA, l = v / U_WIN, tt = v % U_WIN, kt = tt / 19, ng = tt % 19;
            transpose_tiles<4>(p.in[5] + (size_t)l * D * NPROJ, NPROJ, NPROJ, (bf16_t*)(p.ws + WS_WTIN) + (size_t)l * NPAD * D, nullptr, D, kt * 64, ng * 256, tile, tid);
        } else if (u < U_ADA + 2 * U_WIN + 2 * U_WOUT) {
            const int v = u - U_ADA - 2 * U_WIN, l = v / U_WOUT, tt = v % U_WOUT, kt = tt / 8, ng = tt % 8;
            transpose_tiles<4>(p.in[16] + (size_t)l * D * D, D, D, (bf16_t*)(p.ws + WS_WTOUT) + (size_t)l * D * D, nullptr, D, kt * 64, ng * 256, tile, tid);
        } else if (u < U_ADA + 2 * U_WIN + 2 * U_WOUT + U_RT) {
            const int kt = u - (U_ADA + 2 * U_WIN + 2 * U_WOUT);
            transpose_tiles<1>(p.in[18], NE, NE, (bf16_t*)(p.ws + WS_RWH), (bf16_t*)(p.ws + WS_RWL), D, kt * 64, 0, tile, tid);
        } else {
            const int v = u - (U_ADA + 2 * U_WIN + 2 * U_WOUT + U_RT);
            const float* wsrc = p.in[8]; bf16_t* dst = (bf16_t*)(p.ws + WS_WSB);
#pragma unroll
            for (int i = 0; i < 2; ++i) {
                const int e0 = v * 4096 + (tid + i * NT) * 4;
                const int s0 = e0 & 127, t = (e0 >> 7) & 127;
                const float4 wv = *(const float4*)(wsrc + e0);
                u32x2 o; o.x = pk_bf16(s0 + 0 <= t ? wv.x : 0.f, s0 + 1 <= t ? wv.y : 0.f); o.y = pk_bf16(s0 + 2 <= t ? wv.z : 0.f, s0 + 3 <= t ? wv.w : 0.f);
                *(u32x2*)(dst + e0) = o;
            }
        }
    }
}

template <int MODE>
__device__ __forceinline__ void phase_norm(const Params& p, int l) {
    const int tid = threadIdx.x, lane = tid & 63, wid = tid >> 6, G = gridDim.x;
    const float* ADA = (const float*)(p.ws + WS_ADA);
    bf16_t* X = (bf16_t*)(p.ws + WS_X);
    bf16_t* H = (bf16_t*)(p.ws + WS_H);
    const char* O8 = (const char*)(p.ws + WS_O);
    for (int rb = blockIdx.x; rb < T / 32; rb += G) {
        const int b = (rb * 32) / S;
        float4 Av[8], Bv[8], Gv[8];
#pragma unroll
        for (int j = 0; j < 8; ++j) {
            const int d = lane * 4 + 256 * j;
            if (MODE == 2) { Av[j] = *(const float4*)(p.in[23] + d); Bv[j] = make_float4(0.f, 0.f, 0.f, 0.f); }
            else {
                const float4 nw = *(const float4*)(p.in[4] + l * D + d);
                const float4 sh = *(const float4*)(ADA + ((size_t)l * NB + b) * 6 * D + 0 * D + d);
                const float4 s1 = *(const float4*)(ADA + ((size_t)l * NB + b) * 6 * D + 1 * D + d);
                Av[j] = make_float4(nw.x * (1.f + s1.x), nw.y * (1.f + s1.y), nw.z * (1.f + s1.z), nw.w * (1.f + s1.w)); Bv[j] = sh;
            }
            if (MODE >= 1) { const int lp = (MODE == 2) ? 1 : l - 1; Gv[j] = *(const float4*)(ADA + ((size_t)lp * NB + b) * 6 * D + 5 * D + d); }
        }
        constexpr int UNR = (MODE == 1) ? 1 : 2;
#pragma unroll UNR
        for (int rr = 0; rr < 4; ++rr) {
            const int t = rb * 32 + wid * 4 + rr;
            float4 xv[8]; float ss = 0.f;
#pragma unroll
            for (int j = 0; j < 8; ++j) {
                const int d = lane * 4 + 256 * j;
                if (MODE == 0) xv[j] = *(const float4*)(p.in[0] + (size_t)t * D + d);
                else { const u32x2 xb = *(const u32x2*)(X + (size_t)t * D + d); xv[j] = make_float4(bf_lo(xb.x), bf_hi(xb.x), bf_lo(xb.y), bf_hi(xb.y)); }
                if (MODE >= 1) {
                    const int o0 = *(const int*)(O8 + (size_t)(2 * t) * D + d), o1 = *(const int*)(O8 + (size_t)(2 * t + 1) * D + d);
                    typedef float f32x2_t __attribute__((ext_vector_type(2)));
                    const f32x2_t a0 = __builtin_amdgcn_cvt_pk_f32_fp8(o0, false), a1 = __builtin_amdgcn_cvt_pk_f32_fp8(o0, true), b0 = __builtin_amdgcn_cvt_pk_f32_fp8(o1, false), b1 = __builtin_amdgcn_cvt_pk_f32_fp8(o1, true);
                    xv[j].x += Gv[j].x * (a0.x + b0.x); xv[j].y += Gv[j].y * (a0.y + b0.y);
                    xv[j].z += Gv[j].z * (a1.x + b1.x); xv[j].w += Gv[j].w * (a1.y + b1.y);
                }
                ss += xv[j].x * xv[j].x + xv[j].y * xv[j].y + xv[j].z * xv[j].z + xv[j].w * xv[j].w;
            }
#pragma unroll
            for (int o = 32; o > 0; o >>= 1) ss += __shfl_xor(ss, o);
            const float rstd = rsqrtf(ss * (1.0f / D) + EPS);
#pragma unroll
            for (int j = 0; j < 8; ++j) {
                const int d = lane * 4 + 256 * j;
                const float y0 = xv[j].x * rstd * Av[j].x + Bv[j].x, y1 = xv[j].y * rstd * Av[j].y + Bv[j].y, y2 = xv[j].z * rstd * Av[j].z + Bv[j].z, y3 = xv[j].w * rstd * Av[j].w + Bv[j].w;
                if (MODE == 2) *(float4*)(p.out + (size_t)t * D + d) = make_float4(y0, y1, y2, y3);
                else { u32x2 hv; hv.x = pk_bf16(y0, y1); hv.y = pk_bf16(y2, y3); *(u32x2*)(H + (size_t)t * D + d) = hv; }
                if (MODE == 1) { u32x2 xo; xo.x = pk_bf16(xv[j].x, xv[j].y); xo.y = pk_bf16(xv[j].z, xv[j].w); *(u32x2*)(X + (size_t)t * D + d) = xo; }
            }
        }
    }
}

struct EpiProj {
    static constexpr bool PERM = true, AFTER_DRAIN = false;
    bf16_t* PROJ; float* DT; const float* dt_bias;
    __device__ __forceinline__ void operator()(const pg8::f32x4 (&acc)[2][2][4][2], const pg8::Unit& u, int wr, int wc, int fr, int fq) const {
        const int row0 = u.pm * 256 + wr * 64 + fr;
        if (u.pn < 18) {
            const int col0 = u.pn * 256 + wc * 32 + 8 * fq;
            const bool act = u.pn < 8;
#pragma unroll
            for (int ai = 0; ai < 2; ++ai)
#pragma unroll
                for (int m = 0; m < 4; ++m) {
                    bf16_t* rowp = PROJ + (size_t)(row0 + ai * 128 + m * 16) * NPJ + col0;
#pragma unroll
                    for (int bj = 0; bj < 2; ++bj) {
                        pg8::f32x4 v0 = acc[ai][bj][m][0], v1 = acc[ai][bj][m][1];
                        if (act) {
                            const pg8::f32x2 a = pg8::gelu_pk((pg8::f32x2){v0[0], v0[1]}), b2 = pg8::gelu_pk((pg8::f32x2){v0[2], v0[3]}), c2 = pg8::gelu_pk((pg8::f32x2){v1[0], v1[1]}), d2 = pg8::gelu_pk((pg8::f32x2){v1[2], v1[3]});
                            v0 = (pg8::f32x4){a.x, a.y, b2.x, b2.y}; v1 = (pg8::f32x4){c2.x, c2.y, d2.x, d2.y};
                        }
                        pg8::u32x4 w; w.x = cvt_pk_bf16(v0[0], v0[1]); w.y = cvt_pk_bf16(v0[2], v0[3]); w.z = cvt_pk_bf16(v1[0], v1[1]); w.w = cvt_pk_bf16(v1[2], v1[3]);
                        *(pg8::u32x4*)(rowp + bj * 128) = w;
                    }
                }
        } else if (wc == 0 && fq < 2) {
            float db[2][4];
#pragma unroll
            for (int n = 0; n < 2; ++n)
#pragma unroll
                for (int k = 0; k < 4; ++k) db[n][k] = dt_bias[8 * fq + 4 * n + k];
#pragma unroll
            for (int ai = 0; ai < 2; ++ai)
#pragma unroll
                for (int m = 0; m < 4; ++m) {
                    const int row = row0 + ai * 128 + m * 16;
#pragma unroll
                    for (int n = 0; n < 2; ++n) {
                        const int c0 = 8 * fq + 4 * n;
                        const pg8::f32x4 v = acc[ai][0][m][n];
                        float4 o; o.x = softplus_f(v[0] + db[n][0]); o.y = softplus_f(v[1] + db[n][1]); o.z = softplus_f(v[2] + db[n][2]); o.w = softplus_f(v[3] + db[n][3]);
                        *(float4*)(DT + (size_t)row * SH + c0) = o;
                    }
                }
        }
    }
};
template <bool F32R>
struct EpiRes {
    static constexpr bool PERM = true, AFTER_DRAIN = false;
    const float* R32; bf16_t* Xout; const float* gate;
    __device__ __forceinline__ void operator()(const pg8::f32x4 (&acc)[2][2][4][2], const pg8::Unit& u, int wr, int wc, int fr, int fq) const {
        const int row0 = u.pm * 256 + wr * 64 + fr, col0 = u.pn * 256 + wc * 32 + 8 * fq;
        const int b = (u.pm * 256) / S;
        pg8::f32x4 gv[2][2];
#pragma unroll
        for (int bj = 0; bj < 2; ++bj)
#pragma unroll
            for (int n = 0; n < 2; ++n) gv[bj][n] = *(const pg8::f32x4*)(gate + (size_t)b * 6 * D + col0 + bj * 128 + 4 * n);
#pragma unroll
        for (int ai = 0; ai < 2; ++ai) {
            pg8::f32x4 rf[F32R ? 16 : 1]; pg8::u32x4 rb[F32R ? 1 : 8];
#pragma unroll
            for (int m = 0; m < 4; ++m)
#pragma unroll
                for (int bj = 0; bj < 2; ++bj) {
                    const size_t ro = (size_t)(row0 + ai * 128 + m * 16) * D + col0 + bj * 128;
                    if constexpr (F32R) { rf[(m * 2 + bj) * 2] = *(const pg8::f32x4*)(R32 + ro); rf[(m * 2 + bj) * 2 + 1] = *(const pg8::f32x4*)(R32 + ro + 4); }
                    else rb[m * 2 + bj] = *(const pg8::u32x4*)(Xout + ro);
                }
#pragma unroll
            for (int m = 0; m < 4; ++m)
#pragma unroll
                for (int bj = 0; bj < 2; ++bj) {
                    const size_t ro = (size_t)(row0 + ai * 128 + m * 16) * D + col0 + bj * 128;
                    pg8::f32x4 r0, r1;
                    if constexpr (F32R) { r0 = rf[(m * 2 + bj) * 2]; r1 = rf[(m * 2 + bj) * 2 + 1]; }
                    else { const pg8::u32x4 q = rb[m * 2 + bj];
                           r0 = (pg8::f32x4){bf_lo(q.x), bf_hi(q.x), bf_lo(q.y), bf_hi(q.y)}; r1 = (pg8::f32x4){bf_lo(q.z), bf_hi(q.z), bf_lo(q.w), bf_hi(q.w)}; }
                    const pg8::f32x4 v0 = r0 + gv[bj][0] * acc[ai][bj][m][0], v1 = r1 + gv[bj][1] * acc[ai][bj][m][1];
                    pg8::u32x4 w; w.x = cvt_pk_bf16(v0[0], v0[1]); w.y = cvt_pk_bf16(v0[2], v0[3]); w.z = cvt_pk_bf16(v1[0], v1[1]); w.w = cvt_pk_bf16(v1[2], v1[3]);
                    *(pg8::u32x4*)(Xout + ro) = w;
                }
        }
    }
};
}

namespace mk {
#define MFMA16(a, b, c) __builtin_amdgcn_mfma_f32_16x16x32_bf16((a), (b), (c), 0, 0, 0)
constexpr int SP = 272;

struct ConvW { float w[4][8]; float b[8]; };
__device__ __forceinline__ void load_convw(ConvW& cw, const float* __restrict__ conv_w, const float* __restrict__ conv_b, int chx) {
#pragma unroll
    for (int k = 0; k < 4; ++k) {
        const float4 a = *(const float4*)(conv_w + k * CONVD + chx), b2 = *(const float4*)(conv_w + k * CONVD + chx + 4);
        cw.w[k][0] = a.x; cw.w[k][1] = a.y; cw.w[k][2] = a.z; cw.w[k][3] = a.w; cw.w[k][4] = b2.x; cw.w[k][5] = b2.y; cw.w[k][6] = b2.z; cw.w[k][7] = b2.w;
    }
    const float4 a = *(const float4*)(conv_b + chx), b2 = *(const float4*)(conv_b + chx + 4);
    cw.b[0] = a.x; cw.b[1] = a.y; cw.b[2] = a.z; cw.b[3] = a.w; cw.b[4] = b2.x; cw.b[5] = b2.y; cw.b[6] = b2.z; cw.b[7] = b2.w;
}
__device__ __forceinline__ u32x4 ld_raw(const bf16_t* __restrict__ PROJ, int tg, int tl, int pcol) {
    u32x4 z; z.x = z.y = z.z = z.w = 0u;
    if (tl >= 0) z = *(const u32x4*)(PROJ + (size_t)tg * NPJ + pcol);
    return z;
}
__device__ __forceinline__ void conv8(const ConvW& cw, const u32x4& r0, const u32x4& r1, const u32x4& r2, const u32x4& r3, float (&o)[8]) {
#pragma unroll
    for (int j = 0; j < 8; ++j) o[j] = cw.b[j];
    const u32x4 rr[4] = {r0, r1, r2, r3};
#pragma unroll
    for (int k = 0; k < 4; ++k) {
        const float x[8] = {bf_lo(rr[k].x), bf_hi(rr[k].x), bf_lo(rr[k].y), bf_hi(rr[k].y), bf_lo(rr[k].z), bf_hi(rr[k].z), bf_lo(rr[k].w), bf_hi(rr[k].w)};
#pragma unroll
        for (int j = 0; j < 8; ++j) o[j] += cw.w[k][j] * x[j];
    }
#pragma unroll
    for (int j = 0; j < 8; ++j) o[j] = silu_f(o[j]);
}
__device__ __forceinline__ u32x4 pack8(const float (&o)[8]) { u32x4 v; v.x = pk_bf16(o[0], o[1]); v.y = pk_bf16(o[2], o[3]); v.z = pk_bf16(o[4], o[5]); v.w = pk_bf16(o[6], o[7]); return v; }

__device__ __forceinline__ void ssd_unit(const Params& p, ldsp_t lds, int l, int u) {
    const int tid = threadIdx.x, lane = tid & 63, wid = __builtin_amdgcn_readfirstlane(tid >> 6), fr = lane & 15, fq = lane >> 4;
    const int hs = u & 1, g = (u >> 1) & 1, bc = u >> 2, b = bc / NC, c = bc % NC;
    const int tg0 = bc * CH, tl0 = c * CH;
    const bf16_t* PROJ = (const bf16_t*)(p.ws + WS_PROJ);
    const float* DT = (const float*)(p.ws + WS_DT);
    float* ACS = (float*)(p.ws + WS_ACS);
    bf16_t* YD = (bf16_t*)(p.ws + WS_YD);
    bf16_t* STATES = (bf16_t*)(p.ws + WS_STATES);
    const float* conv_w = p.in[10] + (size_t)l * 4 * CONVD; const float* conv_b = p.in[11] + l * CONVD;
    ldsp_t R1 = lds, R2 = lds + 34816, R3 = lds + 69632, R4 = lds + 104448;
    LAS float* acsS = (LAS float*)(lds + 122880); LAS float* dtS = (LAS float*)(lds + 122880 + 2048);
    LAS float* cwS = (LAS float*)(lds + 122880 + 4096);
    for (int i = tid; i < 1284; i += NT) {
        float v;
        if (i < 1280) { const int hq = i / 320, rem = i - hq * 320, k = rem >> 6, ch = (g * 8 + hs * 4 + hq) * SHD + (rem & 63); v = (k < 4) ? conv_w[k * CONVD + ch] : conv_b[ch]; }
        else v = p.in[14][l * SH + g * 8 + hs * 4 + (i - 1280)];
        cwS[i] = v;
    }
    (void)b;
    {
        const int o = tid & 31, lg = tid >> 5, l0 = lg * 8, is_c = o >> 4, nn = (o & 15) * 8;
        const int chx = 1024 + is_c * 256 + g * SN + nn, pcol = 3072 + chx;
        ConvW cw; load_convw(cw, conv_w, conv_b, chx);
        u32x4 raw[11];
#pragma unroll
        for (int r = 0; r < 11; ++r) raw[r] = ld_raw(PROJ, tg0 + l0 + r - 3, tl0 + l0 + r - 3, pcol);
#pragma unroll
        for (int hq = 0; hq < 2; ++hq) {
            unsigned tq[8][2];
#pragma unroll
            for (int mm = 0; mm < 2; ++mm) {
                const int m = 2 * hq + mm;
                float ova[8], ovb[8];
                conv8(cw, raw[2 * m], raw[2 * m + 1], raw[2 * m + 2], raw[2 * m + 3], ova);
                conv8(cw, raw[2 * m + 1], raw[2 * m + 2], raw[2 * m + 3], raw[2 * m + 4], ovb);
                *(LAS u32x4*)((is_c ? R1 : R2) + (l0 + 2 * m) * SP + nn * 2) = pack8(ova);
                *(LAS u32x4*)((is_c ? R1 : R2) + (l0 + 2 * m + 1) * SP + nn * 2) = pack8(ovb);
#pragma unroll
                for (int j = 0; j < 8; ++j) tq[j][mm] = pk_bf16(ova[j], ovb[j]);
            }
            if (!is_c) {
#pragma unroll
                for (int j = 0; j < 8; ++j) { u32x2 t2; t2.x = tq[j][0]; t2.y = tq[j][1]; *(LAS u32x2*)(R3 + (nn + j) * SP + ((lg ^ (o & 7)) * 16) + hq * 8) = t2; }
            }
        }
    }
    if (wid < 4) {
        const int h = g * 8 + hs * 4 + wid, l2 = lane * 2;
        const float a = -__expf(p.in[13][l * SH + h]);
        const float dt0 = DT[(size_t)(tg0 + l2) * SH + h], dt1 = DT[(size_t)(tg0 + l2 + 1) * SH + h];
        const float ad0 = dt0 * a, ad1 = dt1 * a, s = ad0 + ad1;
        float incl = s;
#pragma unroll
        for (int o = 1; o < 64; o <<= 1) { const float n = __shfl_up(incl, o); if (lane >= o) incl += n; }
        const float excl = incl - s;
        acsS[wid * 128 + l2] = excl + ad0; acsS[wid * 128 + l2 + 1] = incl;
        dtS[wid * 128 + l2] = dt0; dtS[wid * 128 + l2 + 1] = dt1;
        ACS[(size_t)(tg0 + l2) * SH + h] = excl + ad0; ACS[(size_t)(tg0 + l2 + 1) * SH + h] = incl;
    }
    __syncthreads();
    f32x4 CB[8];
#pragma unroll
    for (int nt = 0; nt < 8; ++nt) CB[nt] = (f32x4){0.f, 0.f, 0.f, 0.f};
#pragma unroll
    for (int ks = 0; ks < 4; ++ks) {
        const bf16x8 af = *(const LAS bf16x8*)(R1 + (16 * wid + fr) * SP + (32 * ks + 8 * fq) * 2);
#pragma unroll
        for (int nt = 0; nt < 8; ++nt) if (nt <= wid) {
            const bf16x8 bfr = *(const LAS bf16x8*)(R2 + (16 * nt + fr) * SP + (32 * ks + 8 * fq) * 2);
            CB[nt] = MFMA16(bfr, af, CB[nt]);
        }
    }
    __syncthreads();
    const float dsk_base = 0.f; (void)dsk_base;
    u32x4 raw[5];
    {
        const int o = tid & 7, l0 = (tid >> 3) * 2, pcol = 3072 + (g * 8 + hs * 4) * SHD + o * 8;
#pragma unroll
        for (int r = 0; r < 5; ++r) raw[r] = ld_raw(PROJ, tg0 + l0 + r - 3, tl0 + l0 + r - 3, pcol);
    }
#pragma unroll 1
    for (int hl = 0; hl < 4; ++hl) {
        const int h = g * 8 + hs * 4 + hl;
        {
            const int o = tid & 7, lg = tid >> 3, l0 = lg * 2;
            ConvW cw;
#pragma unroll
            for (int k = 0; k < 4; ++k) {
                const f32x4 a = *(const LAS f32x4*)(cwS + hl * 320 + k * 64 + o * 8), b2 = *(const LAS f32x4*)(cwS + hl * 320 + k * 64 + o * 8 + 4);
                cw.w[k][0] = a[0]; cw.w[k][1] = a[1]; cw.w[k][2] = a[2]; cw.w[k][3] = a[3]; cw.w[k][4] = b2[0]; cw.w[k][5] = b2[1]; cw.w[k][6] = b2[2]; cw.w[k][7] = b2[3];
            }
            { const f32x4 a = *(const LAS f32x4*)(cwS + hl * 320 + 256 + o * 8), b2 = *(const LAS f32x4*)(cwS + hl * 320 + 256 + o * 8 + 4);
              cw.b[0] = a[0]; cw.b[1] = a[1]; cw.b[2] = a[2]; cw.b[3] = a[3]; cw.b[4] = b2[0]; cw.b[5] = b2[1]; cw.b[6] = b2[2]; cw.b[7] = b2[3]; }
            const float alast = acsS[hl * 128 + 127];
            float ov0[8], ov1[8];
            conv8(cw, raw[0], raw[1], raw[2], raw[3], ov0); conv8(cw, raw[1], raw[2], raw[3], raw[4], ov1);
            *(LAS u32x4*)(R4 + l0 * 144 + o * 16) = pack8(ov0);
            *(LAS u32x4*)(R4 + (l0 + 1) * 144 + o * 16) = pack8(ov1);
            const float dt0 = dtS[hl * 128 + l0], dt1 = dtS[hl * 128 + l0 + 1];
            const float e0 = __expf(alast - acsS[hl * 128 + l0]), e1 = __expf(alast - acsS[hl * 128 + l0 + 1]);
            const unsigned cw4 = (unsigned)((lg ^ (o << 3)) * 4);
#pragma unroll
            for (int j = 0; j < 8; ++j) {
                const float xa = ov0[j] * dt0, xb = ov1[j] * dt1;
                *(LAS unsigned*)(R2 + (o * 8 + j) * SP + cw4) = pk_bf16(xa, xb);
                *(LAS unsigned*)(R2 + 17408 + (o * 8 + j) * SP + cw4) = pk_bf16(xa * e0, xb * e1);
            }
        }
        if (hl < 3) {
            const int o = tid & 7, l0 = (tid >> 3) * 2, pcol = 3072 + (h + 1) * SHD + o * 8;
#pragma unroll
            for (int r = 0; r < 5; ++r) raw[r] = ld_raw(PROJ, tg0 + l0 + r - 3, tl0 + l0 + r - 3, pcol);
        }
        {
            const int lrow = 16 * wid + fr;
            const float al = acsS[hl * 128 + lrow];
#pragma unroll
            for (int nt = 0; nt < 8; ++nt) {
                if (nt <= wid) {
                    const f32x4 as = *(const LAS f32x4*)(acsS + hl * 128 + 16 * nt + 4 * fq);
                    float v[4];
#pragma unroll
                    for (int r = 0; r < 4; ++r) { const float e = __expf(al - as[r]); const bool keep = (nt < wid) || (4 * fq + r <= fr); v[r] = keep ? CB[nt][r] * e : 0.f; }
                    u32x2 w2; w2.x = pk_bf16(v[0], v[1]); w2.y = pk_bf16(v[2], v[3]);
                    *(LAS u32x2*)(R1 + lrow * SP + (16 * nt + 4 * fq) * 2) = w2;
                } else if (nt == wid + 1 && !(wid & 1)) {
                    u32x2 w2; w2.x = 0u; w2.y = 0u;
                    *(LAS u32x2*)(R1 + lrow * SP + (16 * nt + 4 * fq) * 2) = w2;
                }
            }
        }
        __syncthreads();
        {
            f32x4 acc[4];
#pragma unroll
            for (int nt = 0; nt < 4; ++nt) acc[nt] = (f32x4){0.f, 0.f, 0.f, 0.f};
#pragma unroll
            for (int ks = 0; ks < 4; ++ks) if (ks <= (wid >> 1)) {
                const bf16x8 af = *(const LAS bf16x8*)(R1 + (16 * wid + fr) * SP + (32 * ks + 8 * fq) * 2);
#pragma unroll
                for (int nt = 0; nt < 4; ++nt) {
                    const bf16x8 bfr = *(const LAS bf16x8*)(R2 + (16 * nt + fr) * SP + (((4 * ks + fq) ^ (2 * (2 * nt + (fr >> 3)))) * 16));
                    acc[nt] = MFMA16(bfr, af, acc[nt]);
                }
            }
            const int lrow = 16 * wid + fr;
            const float dsk = cwS[1280 + hl];
#pragma unroll
            for (int nt = 0; nt < 4; ++nt) {
                const int p0 = 16 * nt + 4 * fq;
                const u32x2 xs2 = *(const LAS u32x2*)(R4 + lrow * 144 + p0 * 2);
                u32x2 o2; o2.x = pk_bf16(acc[nt][0] + dsk * bf_lo(xs2.x), acc[nt][1] + dsk * bf_hi(xs2.x)); o2.y = pk_bf16(acc[nt][2] + dsk * bf_lo(xs2.y), acc[nt][3] + dsk * bf_hi(xs2.y));
                *(u32x2*)(YD + (size_t)(tg0 + lrow) * SW + h * SHD + p0) = o2;
            }
        }
        {
            f32x4 acc[4];
#pragma unroll
            for (int j = 0; j < 4; ++j) acc[j] = (f32x4){0.f, 0.f, 0.f, 0.f};
            const int mp = wid & 3, nb = 4 * (wid >> 2);
#pragma unroll
            for (int ks = 0; ks < 4; ++ks) {
                const bf16x8 af = *(const LAS bf16x8*)(R2 + 17408 + (16 * mp + fr) * SP + (((4 * ks + fq) ^ (2 * (2 * mp + (fr >> 3)))) * 16));
#pragma unroll
                for (int j = 0; j < 4; ++j) {
                    const bf16x8 bfr = *(const LAS bf16x8*)(R3 + (16 * (nb + j) + fr) * SP + (((4 * ks + fq) ^ ((2 * (nb + j) + (fr >> 3)) & 7)) * 16));
                    acc[j] = MFMA16(bfr, af, acc[j]);
                }
            }
            bf16_t* sp = STATES + (((size_t)bc * SH + h) * SHD + 16 * mp + fr) * SN;
#pragma unroll
            for (int j = 0; j < 4; ++j) { u32x2 o2; o2.x = pk_bf16(acc[j][0], acc[j][1]); o2.y = pk_bf16(acc[j][2], acc[j][3]); *(u32x2*)(sp + 16 * (nb + j) + 4 * fq) = o2; }
        }
        __syncthreads();
    }
}

__device__ __forceinline__ void gmlp_unit(const Params& p, ldsp_t lds, int l, int u) {
    const int tid = threadIdx.x, lane = tid & 63, wid = __builtin_amdgcn_readfirstlane(tid >> 6), fr = lane & 15, fq = lane >> 4;
    const int hh = u & 7, bc = u >> 3, tg0 = bc * CH;
    const bf16_t* PROJ = (const bf16_t*)(p.ws + WS_PROJ);
    bf16_t* YMIX = (bf16_t*)(p.ws + WS_YMIX);
    ldsp_t A = lds, VT = lds + 34816;
    {
        const bf16_t* wsb = (const bf16_t*)(p.ws + WS_WSB) + ((size_t)(l * GH + hh) * 128) * 128;
#pragma unroll
        for (int i = 0; i < 4; ++i) { const int q = tid + NT * i, row = q >> 4, pc = q & 15; *(LAS u32x4*)(A + row * SP + pc * 16) = *(const u32x4*)(wsb + row * 128 + pc * 8); }
    }
    {
        const int s = tid >> 2, q4 = tid & 3;
        const bf16_t* src = PROJ + (size_t)(tg0 + s) * NPJ + 1024 + hh * 128 + q4 * 32;
        float gv[32];
#pragma unroll
        for (int i = 0; i < 4; ++i) { const u32x4 v = *(const u32x4*)(src + i * 8);
            gv[i * 8 + 0] = bf_lo(v.x); gv[i * 8 + 1] = bf_hi(v.x); gv[i * 8 + 2] = bf_lo(v.y); gv[i * 8 + 3] = bf_hi(v.y); gv[i * 8 + 4] = bf_lo(v.z); gv[i * 8 + 5] = bf_hi(v.z); gv[i * 8 + 6] = bf_lo(v.w); gv[i * 8 + 7] = bf_hi(v.w); }
        float sm = 0.f;
#pragma unroll
        for (int i = 0; i < 32; ++i) sm += gv[i];
        sm += __shfl_xor(sm, 1); sm += __shfl_xor(sm, 2);
        const float mu = sm * (1.0f / 128.0f);
        float q = 0.f;
#pragma unroll
        for (int i = 0; i < 32; ++i) { const float d = gv[i] - mu; q += d * d; }
        q += __shfl_xor(q, 1); q += __shfl_xor(q, 2);
        const float rstd = rsqrtf(q * (1.0f / 128.0f) + EPS);
        const float* lw = p.in[6] + l * 1024 + hh * 128 + q4 * 32; const float* lb = p.in[7] + l * 1024 + hh * 128 + q4 * 32;
#pragma unroll
        for (int i = 0; i < 32; ++i) *(LAS bf16_t*)(VT + (q4 * 32 + i) * SP + s * 2) = f2bf((gv[i] - mu) * rstd * lw[i] + lb[i]);
    }
    __syncthreads();
    f32x4 acc[8];
#pragma unroll
    for (int nt = 0; nt < 8; ++nt) acc[nt] = (f32x4){0.f, 0.f, 0.f, 0.f};
#pragma unroll
    for (int ks = 0; ks < 4; ++ks) if (ks <= (wid >> 1)) {
        const bf16x8 af = *(const LAS bf16x8*)(A + (16 * wid + fr) * SP + (32 * ks + 8 * fq) * 2);
#pragma unroll
        for (int nt = 0; nt < 8; ++nt) {
            const bf16x8 bfr = *(const LAS bf16x8*)(VT + (16 * nt + fr) * SP + (32 * ks + 8 * fq) * 2);
            acc[nt] = MFMA16(bfr, af, acc[nt]);
        }
    }
    {
        const int trow = 16 * wid + fr;
        const float bsv = p.in[9][l * 1024 + hh * 128 + trow];
        u32x2 uu[8];
#pragma unroll
        for (int nt = 0; nt < 8; ++nt) uu[nt] = *(const u32x2*)(PROJ + (size_t)(tg0 + trow) * NPJ + hh * 128 + 16 * nt + 4 * fq);
#pragma unroll
        for (int nt = 0; nt < 8; ++nt) {
            const int p0 = 16 * nt + 4 * fq;
            const u32x2 u2 = uu[nt];
            u32x2 o2; o2.x = pk_bf16(bf_lo(u2.x) * (acc[nt][0] + bsv), bf_hi(u2.x) * (acc[nt][1] + bsv)); o2.y = pk_bf16(bf_lo(u2.y) * (acc[nt][2] + bsv), bf_hi(u2.y) * (acc[nt][3] + bsv));
            *(u32x2*)(YMIX + (size_t)(tg0 + trow) * D + hh * 128 + p0) = o2;
        }
    }
    __syncthreads();
}

template <class ZF>
__device__ __forceinline__ void phase_mix(const Params& p, ldsp_t lds, int l, const ZF& zgemm) {
    const int b = (int)blockIdx.x, G = (int)gridDim.x;
    if (G == 256) {
        if (b < 96) {
            zgemm(32 + b);
            __syncthreads();
            const int n = (b < 64) ? 3 : 2, g0 = (b < 64) ? 3 * b : 192 + 2 * (b - 64);
            for (int i = 0; i < n; ++i) gmlp_unit(p, lds, l, g0 + i);
        } else if (b < 192) {
            const int c = b - 96;
            ssd_unit(p, lds, l, 2 * c); ssd_unit(p, lds, l, 2 * c + 1);
        } else {
            const int c = b - 192;
            ssd_unit(p, lds, l, 192 + c);
            for (int i = 0; i < 4; ++i) gmlp_unit(p, lds, l, 256 + 4 * c + i);
        }
    } else {
        for (int u = 32 + b; u < 128; u += G) { zgemm(u); __syncthreads(); }
        for (int u = b; u < 768; u += G) { if (u < 256) ssd_unit(p, lds, l, u); else gmlp_unit(p, lds, l, u - 256); }
    }
}

__device__ __forceinline__ void phase_scan(const Params& p) {
    const bf16_t* STATES = (const bf16_t*)(p.ws + WS_STATES); const float* ACS = (const float*)(p.ws + WS_ACS);
    bf16_t* PREV = (bf16_t*)(p.ws + WS_PREV);
    for (int idx = blockIdx.x * NT + threadIdx.x; idx < NB * SH * SHD * SN / 4; idx += gridDim.x * NT) {
        const int n4 = idx & 31, pp = (idx >> 5) & 63, h = (idx >> 11) & 15, b = idx >> 15;
        float4 st[NC]; float dec[NC];
#pragma unroll
        for (int c = 0; c < NC; ++c) {
            { const u32x2 sb = *(const u32x2*)(STATES + ((((size_t)(b * NC + c)) * SH + h) * SHD + pp) * SN + n4 * 4); st[c] = make_float4(bf_lo(sb.x), bf_hi(sb.x), bf_lo(sb.y), bf_hi(sb.y)); }
            dec[c] = ACS[((size_t)(b * NC + c) * CH + CH - 1) * SH + h];
        }
        float4 carry = make_float4(0.f, 0.f, 0.f, 0.f);
#pragma unroll
        for (int c = 0; c < NC; ++c) {
            u32x2 o; o.x = pk_bf16(carry.x, carry.y); o.y = pk_bf16(carry.z, carry.w);
            *(u32x2*)(PREV + ((((size_t)(b * NC + c)) * SH + h) * SHD + pp) * SN + n4 * 4) = o;
            const float d = __expf(dec[c]);
            carry.x = carry.x * d + st[c].x; carry.y = carry.y * d + st[c].y; carry.z = carry.z * d + st[c].z; carry.w = carry.w * d + st[c].w;
        }
    }
}

__device__ __forceinline__ void phase_yoff(const Params& p, ldsp_t lds, int l) {
    const int tid = threadIdx.x, lane = tid & 63, wid = __builtin_amdgcn_readfirstlane(tid >> 6), fr = lane & 15, fq = lane >> 4;
    const bf16_t* PROJ = (const bf16_t*)(p.ws + WS_PROJ); const float* ACS = (const float*)(p.ws + WS_ACS);
    const bf16_t* YD = (const bf16_t*)(p.ws + WS_YD); const bf16_t* PREV = (const bf16_t*)(p.ws + WS_PREV);
    bf16_t* YMIX = (bf16_t*)(p.ws + WS_YMIX);
    const float* conv_w = p.in[10] + (size_t)l * 4 * CONVD; const float* conv_b = p.in[11] + l * CONVD;
    ldsp_t CmS = lds; LAS float* red = (LAS float*)(lds + 52224);
    for (int u = blockIdx.x; u < 256; u += gridDim.x) {
        const int g = u & 1, tb = (u >> 1) & 31, b = u >> 6;
        const int tl0 = tb * 64, tg0 = b * S + tl0, bc = b * NC + (tb >> 1);
        {
            const int o = tid & 15, lg = tid >> 4, l0 = lg * 2, chx = 1280 + g * SN + o * 8, pcol = 3072 + chx;
            ConvW cw; load_convw(cw, conv_w, conv_b, chx);
            u32x4 raw[5];
#pragma unroll
            for (int r = 0; r < 5; ++r) raw[r] = ld_raw(PROJ, tg0 + l0 + r - 3, tl0 + l0 + r - 3, pcol);
#pragma unroll
            for (int i = 0; i < 2; ++i) { float ov[8]; conv8(cw, raw[i], raw[i + 1], raw[i + 2], raw[i + 3], ov); *(LAS u32x4*)(CmS + (l0 + i) * SP + o * 16) = pack8(ov); }
        }
        const int mt = wid & 3, ntb = 2 * (wid >> 2);
        const int trow = tg0 + 16 * mt + fr;
        f32x4 gval[8][2]; float ssq = 0.f;
        u32x4 pvr[2];
        {
            const bf16_t* src = PREV + (((size_t)bc * SH + g * 8) * SHD) * SN;
#pragma unroll
            for (int i = 0; i < 2; ++i) { const int q = tid + NT * i; pvr[i] = *(const u32x4*)(src + (q >> 4) * 128 + (q & 15) * 8); }
        }
#pragma unroll
        for (int hl = 0; hl < 8; ++hl) {
            const int h = g * 8 + hl;
            ldsp_t Pv = lds + 17408 + (hl & 1) * 17408;
#pragma unroll
            for (int i = 0; i < 2; ++i) { const int q = tid + NT * i; *(LAS u32x4*)(Pv + (q >> 4) * SP + (q & 15) * 16) = pvr[i]; }
            if (hl < 7) {
                const bf16_t* src = PREV + (((size_t)bc * SH + h + 1) * SHD) * SN;
#pragma unroll
                for (int i = 0; i < 2; ++i) { const int q = tid + NT * i; pvr[i] = *(const u32x4*)(src + (q >> 4) * 128 + (q & 15) * 8); }
            }
            __syncthreads();
            f32x4 acc[2] = {(f32x4){0.f, 0.f, 0.f, 0.f}, (f32x4){0.f, 0.f, 0.f, 0.f}};
#pragma unroll
            for (int ks = 0; ks < 4; ++ks) {
                const bf16x8 af = *(const LAS bf16x8*)(CmS + (16 * mt + fr) * SP + (32 * ks + 8 * fq) * 2);
#pragma unroll
                for (int j = 0; j < 2; ++j) {
                    const bf16x8 bfr = *(const LAS bf16x8*)(Pv + (16 * (ntb + j) + fr) * SP + (32 * ks + 8 * fq) * 2);
                    acc[j] = MFMA16(bfr, af, acc[j]);
                }
            }
            const float ea = __expf(ACS[(size_t)trow * SH + h]);
#pragma unroll
            for (int j = 0; j < 2; ++j) {
                const int p0 = 16 * (ntb + j) + 4 * fq;
                const u32x2 yd = *(const u32x2*)(YD + (size_t)trow * SW + h * SHD + p0);
                const u32x2 zz = *(const u32x2*)(PROJ + (size_t)trow * NPJ + 2048 + h * SHD + p0);
                f32x4 gv;
                gv[0] = (bf_lo(yd.x) + ea * acc[j][0]) * silu_f(bf_lo(zz.x)); gv[1] = (bf_hi(yd.x) + ea * acc[j][1]) * silu_f(bf_hi(zz.x));
                gv[2] = (bf_lo(yd.y) + ea * acc[j][2]) * silu_f(bf_lo(zz.y)); gv[3] = (bf_hi(yd.y) + ea * acc[j][3]) * silu_f(bf_hi(zz.y));
                gval[hl][j] = gv;
                ssq += gv[0] * gv[0] + gv[1] * gv[1] + gv[2] * gv[2] + gv[3] * gv[3];
            }
        }
        ssq += __shfl_xor(ssq, 16); ssq += __shfl_xor(ssq, 32);
        if (fq == 0) red[(wid >> 2) * 64 + 16 * mt + fr] = ssq;
        __syncthreads();
        const float tot = red[16 * mt + fr] + red[64 + 16 * mt + fr];
        const float rstd = rsqrtf(tot * (1.0f / 512.0f) + EPS);
        const float* nw = p.in[15] + l * SW;
#pragma unroll
        for (int hl = 0; hl < 8; ++hl) {
            const int h = g * 8 + hl;
#pragma unroll
            for (int j = 0; j < 2; ++j) {
                const int p0 = 16 * (ntb + j) + 4 * fq;
                const float4 w4 = *(const float4*)(nw + h * SHD + p0);
                u32x2 o2; o2.x = pk_bf16(gval[hl][j][0] * rstd * w4.x, gval[hl][j][1] * rstd * w4.y); o2.y = pk_bf16(gval[hl][j][2] * rstd * w4.z, gval[hl][j][3] * rstd * w4.w);
                *(u32x2*)(YMIX + (size_t)trow * D + 1024 + h * SHD + p0) = o2;
            }
        }
        __syncthreads();
    }
}
}

namespace mk {
#define MFMA32(a, b, c) __builtin_amdgcn_mfma_f32_32x32x16_bf16((a), (b), (c), 0, 0, 0)
constexpr int HLP = 4112;
__device__ __forceinline__ void phase_router(const Params& p, ldsp_t lds, int l, bool dummy = false) {
    const int tid = threadIdx.x, lane = tid & 63, wid = __builtin_amdgcn_readfirstlane(tid >> 6), fr = lane & 15, fq = lane >> 4, G = gridDim.x;
    const float* ADA = (const float*)(p.ws + WS_ADA); const bf16_t* X = (const bf16_t*)(p.ws + WS_X);
    bf16_t* H = (bf16_t*)(p.ws + WS_H);
    const bf16_t* RWH = (const bf16_t*)(p.ws + WS_RWH); const bf16_t* RWL = (const bf16_t*)(p.ws + WS_RWL);
    int* CNT = (int*)(p.ws + WS_CTL + CTL_CNT) + l * NE; int* LIST = (int*)(p.ws + WS_LIST); float* GW = (float*)(p.ws + WS_GW);
    if (dummy) { CNT += 4 * NE; LIST = (int*)(p.ws + WS_END); GW = (float*)(p.ws + WS_END + (size_t)NE * T * 4); }
    LAS float* LG = (LAS float*)(lds + 32 * HLP);
    LAS int* lcnt = (LAS int*)(lds + 32 * HLP + 8192);
    LAS int* lbase = lcnt + 64;
    LAS int* sinfo = lcnt + 128;
    const float* rbias = p.in[19];
    if (tid < 64) lcnt[tid] = 0;
    for (int rb = blockIdx.x; rb < T / 32; rb += G) {
        const int b = (rb * 32) / S;
        float4 Av[8], Bv[8];
#pragma unroll
        for (int j = 0; j < 8; ++j) {
            const int d = lane * 4 + 256 * j;
            const float4 nw = *(const float4*)(p.in[17] + l * D + d);
            const float4 sh = *(const float4*)(ADA + ((size_t)l * NB + b) * 6 * D + 3 * D + d);
            const float4 s2 = *(const float4*)(ADA + ((size_t)l * NB + b) * 6 * D + 4 * D + d);
            Av[j] = make_float4(nw.x * (1.f + s2.x), nw.y * (1.f + s2.y), nw.z * (1.f + s2.z), nw.w * (1.f + s2.w)); Bv[j] = sh;
        }
#pragma unroll 1
        for (int half = 0; half < 2; ++half) {
#pragma unroll
            for (int rr = 0; rr < 2; ++rr) {
                const int row = wid * 2 + rr, t = rb * 32 + half * 16 + row;
                float4 xv[8]; float ss = 0.f;
#pragma unroll
                for (int j = 0; j < 8; ++j) { const u32x2 xb = *(const u32x2*)(X + (size_t)t * D + lane * 4 + 256 * j); xv[j] = make_float4(bf_lo(xb.x), bf_hi(xb.x), bf_lo(xb.y), bf_hi(xb.y)); ss += xv[j].x * xv[j].x + xv[j].y * xv[j].y + xv[j].z * xv[j].z + xv[j].w * xv[j].w; }
#pragma unroll
                for (int o = 32; o > 0; o >>= 1) ss += __shfl_xor(ss, o);
                const float rstd = rsqrtf(ss * (1.0f / D) + EPS);
#pragma unroll
                for (int j = 0; j < 8; ++j) {
                    const int d = lane * 4 + 256 * j;
                    const float y0 = xv[j].x * rstd * Av[j].x + Bv[j].x, y1 = xv[j].y * rstd * Av[j].y + Bv[j].y, y2 = xv[j].z * rstd * Av[j].z + Bv[j].z, y3 = xv[j].w * rstd * Av[j].w + Bv[j].w;
                    u32x2 hv; hv.x = pk_bf16(y0, y1); hv.y = pk_bf16(y2, y3);
                    u32x2 lv; lv.x = pk_bf16(y0 - bf_lo(hv.x), y1 - bf_hi(hv.x)); lv.y = pk_bf16(y2 - bf_lo(hv.y), y3 - bf_hi(hv.y));
                    *(LAS u32x2*)(lds + row * HLP + d * 2) = hv;
                    *(LAS u32x2*)(lds + (16 + row) * HLP + d * 2) = lv;
                }
            }
            __syncthreads();
            {
                const int nt = wid & 3, kh = wid >> 2;
                f32x4 acc = (f32x4){0.f, 0.f, 0.f, 0.f};
                const bf16_t* bh = RWH + (size_t)(16 * nt + fr) * D + 8 * fq; const bf16_t* bl = RWL + (size_t)(16 * nt + fr) * D + 8 * fq;
#pragma unroll 8
                for (int ks = 0; ks < 32; ++ks) {
                    const int k0 = (kh * 32 + ks) * 32;
                    const bf16x8 ah = *(const LAS bf16x8*)(lds + fr * HLP + (k0 + 8 * fq) * 2);
                    const bf16x8 alo = *(const LAS bf16x8*)(lds + (16 + fr) * HLP + (k0 + 8 * fq) * 2);
                    const bf16x8 bhv = *(const bf16x8*)(bh + k0); const bf16x8 blv = *(const bf16x8*)(bl + k0);
                    acc = MFMA16(ah, bhv, acc); acc = MFMA16(ah, blv, acc); acc = MFMA16(alo, bhv, acc);
                }
#pragma unroll
                for (int r = 0; r < 4; ++r) LG[(kh * 16 + 4 * fq + r) * 64 + 16 * nt + fr] = acc[r];
            }
            __syncthreads();
#pragma unroll 1
            for (int rr = 0; rr < 2; ++rr) {
                const int row = wid * 2 + rr, t = rb * 32 + half * 16 + row;
                const float lg = LG[row * 64 + lane] + LG[(16 + row) * 64 + lane];
                const float sc = 1.0f / (1.0f + __expf(-lg)), v = sc + rbias[lane];
                float m1 = v; int i1 = lane;
#pragma unroll
                for (int o = 1; o < 8; o <<= 1) { const float ov = __shfl_xor(m1, o); const int oi = __shfl_xor(i1, o); if (ov > m1 || (ov == m1 && oi < i1)) { m1 = ov; i1 = oi; } }
                float m2 = (lane == i1) ? -1e30f : v; int i2 = lane;
#pragma unroll
                for (int o = 1; o < 8; o <<= 1) { const float ov = __shfl_xor(m2, o); const int oi = __shfl_xor(i2, o); if (ov > m2 || (ov == m2 && oi < i2)) { m2 = ov; i2 = oi; } }
                float gs = m1 + m2; int bg = lane >> 3;
#pragma unroll
                for (int o = 8; o < 64; o <<= 1) { const float ov = __shfl_xor(gs, o); const int og = __shfl_xor(bg, o); if (ov > gs || (ov == gs && og < bg)) { gs = ov; bg = og; } }
                const int e1 = __shfl(i1, bg * 8), e2 = __shfl(i2, bg * 8);
                const float u1 = __shfl(sc, e1), u2 = __shfl(sc, e2);
                if (lane == 0) {
                    const float inv = 1.0f / (u1 + u2);
                    GW[t * 2 + 0] = u1 * inv; GW[t * 2 + 1] = u2 * inv;
                    LAS int* si = sinfo + (half * 16 + row) * 4;
                    si[0] = e1; si[1] = __hip_atomic_fetch_add(lcnt + e1, 1, __ATOMIC_RELAXED, __HIP_MEMORY_SCOPE_WORKGROUP); si[2] = e2; si[3] = __hip_atomic_fetch_add(lcnt + e2, 1, __ATOMIC_RELAXED, __HIP_MEMORY_SCOPE_WORKGROUP);
                }
            }
            __syncthreads();
            if (tid < 64) { const int c = lcnt[tid]; lbase[tid] = c ? atomicAdd(&CNT[tid], c) : 0; lcnt[tid] = 0; }
            __syncthreads();
            {
                const int sl = tid >> 4, row = sl >> 1, k = sl & 1, cg = tid & 15;
                const int e = sinfo[(half * 16 + row) * 4 + 2 * k], pos = lbase[e] + sinfo[(half * 16 + row) * 4 + 2 * k + 1];
                if (cg == 0) LIST[e * T + pos] = (rb * 32 + half * 16 + row) * 2 + k;
                if (pos >= SCAP) {
                    const int tk = rb * 32 + half * 16 + row;
                    char* h8 = (char*)(p.ws + WS_H) + (size_t)tk * D;
#pragma unroll
                    for (int cc = 0; cc < 4; ++cc)
#pragma unroll
                        for (int j = 0; j < 4; ++j) {
                            const u32x4 v = *(const LAS u32x4*)(lds + row * HLP + (cg * 4 + cc) * 64 + j * 16);
                            u32x2 o; int t0 = 0, t1 = 0;
                            t0 = __builtin_amdgcn_cvt_pk_fp8_f32(bf_lo(v.x), bf_hi(v.x), t0, false); t0 = __builtin_amdgcn_cvt_pk_fp8_f32(bf_lo(v.y), bf_hi(v.y), t0, true);
                            t1 = __builtin_amdgcn_cvt_pk_fp8_f32(bf_lo(v.z), bf_hi(v.z), t1, false); t1 = __builtin_amdgcn_cvt_pk_fp8_f32(bf_lo(v.w), bf_hi(v.w), t1, true);
                            o.x = (unsigned)t0; o.y = (unsigned)t1;
                            *(u32x2*)(h8 + (cg * 4 + cc) * 32 + j * 8) = o;
                        }
                }
                if (pos < SCAP) {
                    char* hg = (char*)(p.ws + WS_HG);
#pragma unroll
                    for (int cc = 0; cc < 4; ++cc) {
                        const int ck = cg * 4 + cc;
#pragma unroll
                        for (int j = 0; j < 4; ++j) {
                            const u32x4 v = *(const LAS u32x4*)(lds + row * HLP + ck * 64 + j * 16);
                            u32x2 o; int t0 = 0, t1 = 0;
                            t0 = __builtin_amdgcn_cvt_pk_fp8_f32(bf_lo(v.x), bf_hi(v.x), t0, false); t0 = __builtin_amdgcn_cvt_pk_fp8_f32(bf_lo(v.y), bf_hi(v.y), t0, true);
                            t1 = __builtin_amdgcn_cvt_pk_fp8_f32(bf_lo(v.z), bf_hi(v.z), t1, false); t1 = __builtin_amdgcn_cvt_pk_fp8_f32(bf_lo(v.w), bf_hi(v.w), t1, true);
                            o.x = (unsigned)t0; o.y = (unsigned)t1;
                            *(u32x2*)(hg + ((size_t)((e * 64 + ck) * 4 + j) * SCAP + pos) * 8) = o;
                        }
                    }
                }
            }
            __syncthreads();
        }
    }
}

__device__ __forceinline__ void glds16_v(const void* gsrc, unsigned lds_dst) {
    unsigned keep;
    asm volatile("s_mov_b32 %0, m0\n\ts_mov_b32 m0, %2\n\ts_nop 0\n\tglobal_load_lds_dwordx4 %1, off nt\n\ts_mov_b32 m0, %0" : "=&s"(keep) : "v"(gsrc), "s"(lds_dst) : "memory");
}
template <int N> __device__ __forceinline__ void wait_vm() { asm volatile("s_waitcnt vmcnt(%0)" :: "n"(N) : "memory"); }

constexpr int MOE_L0 = 8192;
template <bool UP, int RH> struct K8 {
    static constexpr int KTOT = UP ? D : DE, KC = 32, NCH = KTOT / KC, WLD = UP ? DE : D, WCOLS = 256 / RH;
    static constexpr int S = (RH == 1) ? 3 : 4, DW = S - 1, ROWS = RH * 256, ASZ = ROWS * 32, STG = ASZ + 32 * WCOLS * 4, WP = 4 / RH, NPW = RH;
    static_assert(MOE_L0 + S * STG <= LDS_BYTES - 64, "MoE LDS map");
};
struct MoeCtx { int e, ns, ps, rows, cgi, rh, colw, rot; const char* wsrc; const char* Ablk; };

template <bool UP, int RH>
__device__ __forceinline__ void moe_setup(MoeCtx& c, const Params& p, int l, int e, int ns, int ps, int rows, const char* Ablk) {
    typedef K8<UP, RH> C;
    const int lane = threadIdx.x & 63, wid = __builtin_amdgcn_readfirstlane(threadIdx.x >> 6), r = lane & 31;
    c.e = e; c.ns = ns; c.ps = ps; c.rows = rows; c.Ablk = Ablk;
    if (UP) { if (RH == 1) { c.cgi = wid; c.rh = 0; } else { c.cgi = wid >> 1; c.rh = wid & 1; } c.colw = c.cgi * 16 + ((r >> 4) ? (C::WCOLS / 2 - 16) : 0); }
    else    { if (RH == 1) { c.cgi = wid; c.rh = 0; c.colw = c.cgi * 32; } else { c.cgi = 4 * ps + (wid >> 1); c.rh = wid & 1; c.colw = (wid >> 1) * 32; } }
    if (UP) { const int hl = (RH == 1) ? (lane >> 5) : ((lane >> 4) & 1), cl = (RH == 1) ? (lane & 31) : (lane & 15);
              c.wsrc = (const char*)((hl ? p.in[21] : p.in[20]) + ((size_t)l * NE + e) * D * DE + ns * 128 + (RH == 2 ? ps * 64 : 0) + cl * 4); }
    else c.wsrc = (const char*)(p.in[22] + ((size_t)l * NE + e) * DE * D + ns * 256 + (RH == 2 ? ps * 128 + (lane & 31) * 4 : lane * 4));
    c.wsrc += (size_t)(wid * 4 + (RH == 2 ? (lane >> 5) : 0)) * C::WLD * 4;
    c.rot = (e * 5) & (C::NCH - 1);
}
#define M8_CK(cc) ((((cc) < C::NCH ? (cc) : C::NCH - 1) + c.rot) & (C::NCH - 1))
#define M8_WISSUE(cc, st) do { const unsigned sb_ = ldsbase + (unsigned)(st) * C::STG; const int ck_ = M8_CK(cc); const int live_ = ((cc) < C::NCH) ? RH : 0; \
        _Pragma("unroll") for (int i_ = 0; i_ < C::WP; ++i_) glds16_v((const void*)(c.wsrc + ((size_t)ck_ * C::KC + i_ * live_) * C::WLD * 4), sb_ + wdst + i_ * 1024); } while (0)
template <bool UP, int RH>
__device__ __forceinline__ void moe_early(const MoeCtx& c, ldsp_t lds) {
    typedef K8<UP, RH> C;
    const int wid = __builtin_amdgcn_readfirstlane(threadIdx.x >> 6);
    const unsigned ldsbase = (unsigned)(size_t)lds + (unsigned)MOE_L0;
    const unsigned wdst = (unsigned)C::ASZ + (unsigned)(wid * 4) * (unsigned)(C::WCOLS * 4);
#pragma unroll
    for (int i = 0; i < C::DW - 1; ++i) M8_WISSUE(i, i);
    if constexpr (RH == 2) {
        const int tid = threadIdx.x, w2 = tid & 255, wv = (2 * w2 < c.rows) ? w2 : 0;
        const unsigned off = (unsigned)((tid >> 8) * (SCAP * 8) + wv * 16);
#pragma unroll
        for (int cc = 0; cc < 2; ++cc) {
            const char* ab = c.Ablk + (size_t)M8_CK(cc) * (4 * SCAP * 8) + off;
#pragma unroll
            for (int i = 0; i < C::NPW; ++i) glds16_v((const void*)(ab + i * 2 * (SCAP * 8)), ldsbase + (unsigned)cc * C::STG + (unsigned)wid * 1024u + (unsigned)i * 8192u);
        }
    }
}
template <bool UP, int RH, int NJ, bool GATH>
__device__ __forceinline__ void moe_main(f32x16 (&acc)[8], const MoeCtx& c, ldsp_t lds, const LAS int* rowsS) {
    typedef K8<UP, RH> C;
    constexpr int ROWS = C::ROWS, NPW = C::NPW, WP = C::WP, S = C::S, DW = C::DW, WCOLS = C::WCOLS;
    constexpr float WSC = UP ? 64.f : 32.f;
    const int tid = threadIdx.x, lane = tid & 63, wid = __builtin_amdgcn_readfirstlane(tid >> 6), r = lane & 31, hh = lane >> 5;
    const unsigned ldsbase = (unsigned)(size_t)lds + (unsigned)MOE_L0;
    const unsigned lane16 = (unsigned)lane * 16u, adst = (unsigned)wid * 1024u;
    const unsigned wdst = (unsigned)C::ASZ + (unsigned)(wid * 4) * (unsigned)(WCOLS * 4);
    const unsigned wrd = (unsigned)C::ASZ + (unsigned)((8 * hh) * WCOLS + c.colw + r) * 4u;
    const unsigned ard8 = (unsigned)(hh * (ROWS * 8)) + (unsigned)((32 * c.rh + r) * 8);
    unsigned goff[NPW];
#pragma unroll
    for (int i = 0; i < NPW; ++i) {
        if (GATH) { const int slot = rowsS[tid >> 1]; goff[i] = (unsigned)(UP ? (slot >> 1) : slot) * (unsigned)(UP ? D : DE) + (unsigned)((tid & 1) * 16); }
        else {
            const int w2 = (RH == 1) ? (tid & 127) : (tid & 255), wv = (2 * w2 < c.rows) ? w2 : 0;
            goff[i] = (RH == 1) ? (unsigned)((tid >> 7) * (SCAP * 8) + wv * 16) : (unsigned)((tid >> 8) * (SCAP * 8) + wv * 16 + i * 2 * (SCAP * 8));
        }
    }
    u32x4 ra0[NPW], ra1[NPW];
#define M8_AISSUE(cc, RA) do { const void* ab_ = (const void*)(c.Ablk + (size_t)M8_CK(cc) * (GATH ? 32 : 4 * SCAP * 8)); \
        _Pragma("unroll") for (int i_ = 0; i_ < NPW; ++i_) asm volatile("global_load_dwordx4 %0, %1, %2" : "=v"(RA[i_]) : "v"(goff[i_]), "s"(ab_) : "memory"); } while (0)
#define M8_ALAND(st, RA, N, AOK) do { \
        if (NPW == 1) asm volatile("s_waitcnt vmcnt(%1)" : "+v"(RA[0]) : "n"(N) : "memory"); \
        if (NPW == 2) asm volatile("s_waitcnt vmcnt(%2)" : "+v"(RA[0]), "+v"(RA[NPW > 1 ? 1 : 0]) : "n"(N) : "memory"); \
        if (!(AOK)) { } else \
        if (GATH) { ldsp_t ap_ = lds + MOE_L0 + (st) * C::STG + (unsigned)((tid & 1) * 2 * (ROWS * 8) + (tid >> 1) * 8); \
                    *(LAS u32x2*)(ap_) = (u32x2){RA[0].x, RA[0].y}; *(LAS u32x2*)(ap_ + ROWS * 8) = (u32x2){RA[0].z, RA[0].w}; } \
        else { ldsp_t ap_ = lds + MOE_L0 + (st) * C::STG + adst + lane16; \
               _Pragma("unroll") for (int i_ = 0; i_ < NPW; ++i_) *(LAS u32x4*)(ap_ + i_ * 8192) = RA[i_]; } } while (0)
#define M8_STEP(cq, RAI, RAC, AOK) do { \
        asm volatile("s_waitcnt lgkmcnt(0)" ::: "memory"); \
        __builtin_amdgcn_s_barrier();                       \
        asm volatile("" ::: "memory"); \
        M8_AISSUE((cq) + 2, RAI); \
        { const int sn_ = (st == 0) ? S - 1 : st - 1; M8_WISSUE((cq) + DW, sn_); } \
        { ldsp_t sp = lds + MOE_L0 + st * C::STG; \
          _Pragma("unroll") for (int ks = 0; ks < 2; ++ks) { \
            float w[8]; long af[NJ]; \
            _Pragma("unroll") for (int j = 0; j < 8; ++j) w[j] = *(const LAS float*)(sp + wrd + (ks * 16 + j) * (WCOLS * 4)); \
            _Pragma("unroll") for (int j = 0; j < NJ; ++j) af[j] = *(const LAS long*)(sp + ard8 + ks * (2 * ROWS * 8) + j * (RH * 256)); \
            int lo_ = 0, hi_ = 0; \
            lo_ = __builtin_amdgcn_cvt_pk_fp8_f32(w[0] * WSC, w[1] * WSC, lo_, false); lo_ = __builtin_amdgcn_cvt_pk_fp8_f32(w[2] * WSC, w[3] * WSC, lo_, true); \
            hi_ = __builtin_amdgcn_cvt_pk_fp8_f32(w[4] * WSC, w[5] * WSC, hi_, false); hi_ = __builtin_amdgcn_cvt_pk_fp8_f32(w[6] * WSC, w[7] * WSC, hi_, true); \
            const long wf = (long)(((unsigned long long)(unsigned)hi_ << 32) | (unsigned long long)(unsigned)lo_); \
            _Pragma("unroll") for (int j = 0; j < NJ; ++j) acc[j] = __builtin_amdgcn_mfma_f32_32x32x16_fp8_fp8(wf, af[j], acc[j], 0, 0, 0); } } \
        st = (st == S - 1) ? 0 : st + 1; \
        M8_ALAND(st, RAC, 2 * WP + NPW, AOK);               \
        if (DW == 2) wait_vm<WP + NPW>();                    \
    } while (0)
    int st = 0;
    constexpr bool EARLYA = (RH == 2) && !GATH;
    if constexpr (EARLYA) {
#pragma unroll
        for (int i = 0; i < NPW; ++i) ra1[i] = (u32x4){0u, 0u, 0u, 0u};
        M8_WISSUE(DW - 1, DW - 1);
        wait_vm<WP>();
    } else {
        M8_AISSUE(0, ra0); M8_AISSUE(1, ra1); M8_WISSUE(DW - 1, DW - 1);
        M8_ALAND(0, ra0, NPW + WP, true);
    }
#pragma unroll 1
    for (int cq = 0; cq < C::NCH; cq += 2) {
        M8_STEP(cq, ra0, ra1, !EARLYA || cq > 0);
        M8_STEP(cq + 1, ra1, ra0, true);
    }
    wait_vm<0>();
    asm volatile("s_waitcnt lgkmcnt(0)" ::: "memory");
#undef M8_STEP
#undef M8_ALAND
#undef M8_AISSUE
}
#undef M8_WISSUE
#undef M8_CK

template <bool UP, int RH, bool SRT>
__device__ __forceinline__ void moe_epilogue(const f32x16 (&acc)[8], const MoeCtx& c, const Params& p, const LAS int* rowsS) {
    const int lane = threadIdx.x & 63, hh = lane >> 5;
    int r_e = lane & 31; asm volatile("" : "+v"(r_e));
    const int e = c.e, ns = c.ns, ps = c.ps, rows = c.rows, cgi = c.cgi, rh = c.rh;
    if (UP) {
        const int cis = (RH == 2 ? ps * 64 : 0) + cgi * 16;
        char* actsb = (char*)(p.ws + WS_ACTS) + ((size_t)(e * 16 + ns * 4 + (cis >> 5)) * 4 + ((cis >> 3) & 3)) * (SCAP * 8);
        char* act8 = (char*)(p.ws + WS_ACT);
#pragma unroll
        for (int mt = 0; mt < 8; ++mt) {
            const int row = 32 * (RH * mt + rh) + r_e;
            const int slot = rowsS[row & 511];
#pragma unroll
            for (int q = 0; q < 2; ++q) {
                constexpr float ISC = 1.0f / 64.0f;
                const float a0 = silu_f(acc[mt][q * 4 + 0] * ISC) * (acc[mt][(q + 2) * 4 + 0] * ISC), a1 = silu_f(acc[mt][q * 4 + 1] * ISC) * (acc[mt][(q + 2) * 4 + 1] * ISC);
                const float a2 = silu_f(acc[mt][q * 4 + 2] * ISC) * (acc[mt][(q + 2) * 4 + 2] * ISC), a3 = silu_f(acc[mt][q * 4 + 3] * ISC) * (acc[mt][(q + 2) * 4 + 3] * ISC);
                int t8 = 0; t8 = __builtin_amdgcn_cvt_pk_fp8_f32(a0, a1, t8, false); t8 = __builtin_amdgcn_cvt_pk_fp8_f32(a2, a3, t8, true);
                if (row < rows) {
                    if (SRT) *(int*)(actsb + ((unsigned)(q * (SCAP * 8)) + (unsigned)row * 8u + 4u * (unsigned)hh)) = t8;
                    else *(int*)(act8 + (size_t)slot * DE + ns * 128 + cis + 8 * q + 4 * hh) = t8;
                }
            }
        }
    } else {
        char* O8 = (char*)(p.ws + WS_O);
#pragma unroll
        for (int mt = 0; mt < 8; ++mt) {
            const int row = 32 * (RH * mt + rh) + r_e;
            const int slot = rowsS[row & 511];
            const float gwv = ((const LAS float*)(rowsS + 1024))[row & 511] * (1.0f / 32.0f);
            int t8[4];
#pragma unroll
            for (int q = 0; q < 4; ++q) { int t = 0; t = __builtin_amdgcn_cvt_pk_fp8_f32(acc[mt][q * 4 + 0] * gwv, acc[mt][q * 4 + 1] * gwv, t, false); t = __builtin_amdgcn_cvt_pk_fp8_f32(acc[mt][q * 4 + 2] * gwv, acc[mt][q * 4 + 3] * gwv, t, true); t8[q] = t; }
            const int s0 = hh ? t8[0] : t8[2], s1 = hh ? t8[1] : t8[3];
            const int r0 = __shfl_xor(s0, 32), r1 = __shfl_xor(s1, 32);
            u32x4 o4;
            if (hh) { o4.x = (unsigned)r0; o4.y = (unsigned)t8[2]; o4.z = (unsigned)r1; o4.w = (unsigned)t8[3]; }
            else    { o4.x = (unsigned)t8[0]; o4.y = (unsigned)r0; o4.z = (unsigned)t8[1]; o4.w = (unsigned)r1; }
            if (row < rows) *(u32x4*)(O8 + (size_t)slot * D + ns * 256 + cgi * 32 + 16 * hh) = o4;
        }
    }
}
template <bool UP, int RH, bool GATH>
__device__ __forceinline__ void moe_run(f32x16 (&acc)[8], const MoeCtx& c, ldsp_t lds, const LAS int* rowsS) {
#pragma unroll
    for (int mt = 0; mt < 8; ++mt)
#pragma unroll
        for (int i = 0; i < 16; ++i) acc[mt][i] = 0.f;
    const int nmt = (c.rows + 31) >> 5, njmax = (RH == 2) ? ((nmt + 1) >> 1) : nmt;
    if (njmax <= 4)      moe_main<UP, RH, 4, GATH>(acc, c, lds, rowsS);
    else if (njmax <= 5) moe_main<UP, RH, 5, GATH>(acc, c, lds, rowsS);
    else if (njmax <= 6) moe_main<UP, RH, 6, GATH>(acc, c, lds, rowsS);
    else                 moe_main<UP, RH, 8, GATH>(acc, c, lds, rowsS);
}

template <bool UP>
__device__ __forceinline__ void phase_moe(const Params& p, ldsp_t lds, int l) {
    constexpr int NSL2 = UP ? 8 : 16, NUN = NE * NSL2;
    const int tid = threadIdx.x, G = gridDim.x;
    const int* CNT = (const int*)(p.ws + WS_CTL + CTL_CNT) + l * NE; const int* LIST = (const int*)(p.ws + WS_LIST);
    const char* Agat = UP ? (const char*)(p.ws + WS_H) : (const char*)(p.ws + WS_ACT);
    LAS int* rowsS = (LAS int*)lds;
    const int vid = *(const LAS int*)(lds + LDS_BYTES - 32);
    LAS int* perm = (LAS int*)(lds + LDS_BYTES - 64 - 256);
    __syncthreads();
    if (tid < 64) {
        const int cj = CNT[tid];
        int rank = 0;
#pragma unroll
        for (int i = 0; i < 64; ++i) { const int ci = __builtin_amdgcn_readlane(cj, i); rank += (ci > cj || (ci == cj && i < tid)) ? 1 : 0; }
        const int t = rank >> 3, pos = rank & 7;
        perm[((t & 1) ? 7 - pos : pos) * 8 + t] = tid;
    }
    __syncthreads();
#define MOE_SLOT(s_) (UP ? ((s_) < 4 ? (s_) : 11 - (s_)) : ((s_) ^ (((s_) >> 1) & 1)))
#define MOE_UNIT(u, e_, ns_, ps_, cnt_) do { const int xq_ = (u) & 7, jq_ = (u) >> 3, sub_ = jq_ % NSL2, sl_ = jq_ / NSL2; e_ = perm[xq_ * 8 + MOE_SLOT(sl_)]; ns_ = sub_ >> 1; ps_ = sub_ & 1; cnt_ = CNT[e_]; } while (0)
#define MOE_ROWS(buf, e_, m0_, rows_) do { const int sl_ = LIST[(e_) * T + (m0_) + (tid < (rows_) ? tid : 0)]; rowsS[(buf) * 512 + tid] = sl_; \
        if (!UP) ((LAS float*)(rowsS + 1024))[(buf) * 512 + tid] = ((const float*)(p.ws + WS_GW))[sl_]; } while (0)
#define MOE_ASRT(e_) ((const char*)(p.ws + (UP ? WS_HG : WS_ACTS) + (size_t)(e_) * (UP ? 64 : 16) * (4 * SCAP * 8)))
    int u = vid, e = 0, ns = 0, ps = 0, cnt = 0;
    while (u < NUN) { MOE_UNIT(u, e, ns, ps, cnt); if (cnt > 0) break; u += G; }
    if (u >= NUN) return;
    int buf = 0;
    MoeCtx ctx;
    { const int rows = cnt < SCAP ? cnt : SCAP; __syncthreads(); MOE_ROWS(buf, e, 0, rows); moe_setup<UP, 2>(ctx, p, l, e, ns, ps, rows, MOE_ASRT(e)); wait_vm<0>(); moe_early<UP, 2>(ctx, lds); }
    for (;;) {
        int un = u + G, en = 0, nsn = 0, psn = 0, cntn = 0;
        while (un < NUN) { MOE_UNIT(un, en, nsn, psn, cntn); if (cntn > 0) break; un += G; }
        const bool haven = un < NUN;
        f32x16 acc[8];
        moe_run<UP, 2, false>(acc, ctx, lds, rowsS + buf * 512);
        __syncthreads();
        MoeCtx nctx = ctx;
        const bool chain = haven && cnt <= SCAP;
        if (chain) { const int rows = cntn < SCAP ? cntn : SCAP; MOE_ROWS(buf ^ 1, en, 0, rows); moe_setup<UP, 2>(nctx, p, l, en, nsn, psn, rows, MOE_ASRT(en)); moe_early<UP, 2>(nctx, lds); }
        moe_epilogue<UP, 2, true>(acc, ctx, p, rowsS + buf * 512);
        if (cnt > SCAP) {
#pragma unroll 1
            for (int m0 = SCAP; m0 < cnt; m0 += 256) {
                const int rows = (cnt - m0 < 256) ? (cnt - m0) : 256;
                __syncthreads();
                MOE_ROWS(buf, e, m0, rows);
                __syncthreads();
                if (ps == 0) {
                    MoeCtx fc; moe_setup<UP, 1>(fc, p, l, e, ns, 0, rows, Agat);
                    wait_vm<0>(); moe_early<UP, 1>(fc, lds);
                    moe_run<UP, 1, true>(acc, fc, lds, rowsS + buf * 512);
                    __syncthreads();
                    moe_epilogue<UP, 1, false>(acc, fc, p, rowsS + buf * 512);
                }
            }
        }
        if (!haven) break;
        if (!chain) { const int rows = cntn < SCAP ? cntn : SCAP; __syncthreads(); MOE_ROWS(buf ^ 1, en, 0, rows); moe_setup<UP, 2>(nctx, p, l, en, nsn, psn, rows, MOE_ASRT(en)); wait_vm<0>(); moe_early<UP, 2>(nctx, lds); }
        ctx = nctx; u = un; e = en; ns = nsn; ps = psn; cnt = cntn; buf ^= 1;
    }
#undef MOE_ASRT
#undef MOE_ROWS
#undef MOE_UNIT
#undef MOE_SLOT
}
}

#ifndef MK_KIND_MASK
#define MK_KIND_MASK 0x3ff
#endif
#define KIND(k) (((MK_KIND_MASK) >> (k)) & 1)
#ifndef MK_REP_MASK
#define MK_REP_MASK 0
#endif
#define NREP(k) (1 + (((MK_REP_MASK) >> (k)) & 1))
namespace mk {
constexpr int N_PHASES = 20;
constexpr int LDS_MISC = LDS_BYTES - 64;

#ifdef MK_STREAMTEST
__device__ __forceinline__ void phase_streamtest(const Params& p) {
    const int tid = threadIdx.x, w = blockIdx.x;
    const float* base = p.in[20];
    float4 acc = make_float4(0.f, 0.f, 0.f, 0.f);
    if (MK_STREAMTEST == 1) {
        const float4* src = (const float4*)(base + (size_t)w * 262144) + tid;
#pragma unroll 8
        for (int i = 0; i < 128; ++i) { const float4 v = src[(size_t)i * 512]; acc.x += v.x; acc.y += v.y; acc.z += v.z; acc.w += v.w; }
    } else {
        const int e = w >> 2, ns = w & 3;
        const float4* src = (const float4*)(base + (size_t)e * D * DE + ns * 128 + (size_t)(tid >> 5) * DE) + (tid & 31);
#pragma unroll 8
        for (int i = 0; i < 128; ++i) { const float4 v = src[(size_t)i * 16 * DE / 4]; acc.x += v.x; acc.y += v.y; acc.z += v.z; acc.w += v.w; }
    }
    const float s = acc.x + acc.y + acc.z + acc.w;
    if (s != s) ((float*)(p.ws + WS_END))[tid] = s;
}
#endif
struct SkipZOrder : pg8::StaticOrder {
    __device__ bool next(int i, pg8::Unit& u) const {
        const long L = (long)i * G + c;
        if (L < 480) { if (!pg8::StaticOrder::next(i, u)) return false; if (u.pn >= 8) u.pn += 4; return true; }
        if (L < 512) { const int z = (int)L - 480; u.pm = z >> 2; u.pn = 8 + (z & 3); return true; }
        return false;
    }
};
struct OneUnitOrder {
    int pm, pn;
    __device__ bool next(int i, pg8::Unit& u) const { if (i) return false; u.pm = pm; u.pn = pn; return true; }
    __device__ __forceinline__ void a_ready(const pg8::Unit&) const {}
    __device__ __forceinline__ void done(const pg8::Unit&) const {}
};
template <int L>
__device__ __forceinline__ void run_layer(const Params& p, ldsp_t lds, const XcdBarrier& bar, int lo, int hi) {
    constexpr int PB = 1 + 9 * L;
#define IN(k) (lo <= (k) && (k) < hi)
#define SEAM(k) do { if (IN(k) && IN((k) + 1)) xcd_barrier(bar); } while (0)
    if (KIND(1) && IN(PB + 0)) { if (L == 0) { { phase_norm<0>(p, 0); if constexpr ((NREP(1)) > 1) { __syncthreads(); phase_norm<0>(p, 0); __syncthreads(); } } } else phase_norm<1>(p, L); }
    SEAM(PB + 0);
    if (KIND(2) && IN(PB + 1)) {
        pg8::Gemm g{(const pg8::bf16_t*)(p.ws + WS_H), (const pg8::bf16_t*)(p.ws + WS_WTIN) + (size_t)L * NPAD * D, T, NPAD, D};
        SkipZOrder So; So.init(T, NPAD - 1024, (int)gridDim.x, (int)blockIdx.x);
        EpiProj E{(bf16_t*)(p.ws + WS_PROJ), (float*)(p.ws + WS_DT), p.in[12] + L * SH};
        { pg8::gemm_phase<EpiProj, SkipZOrder, true, true>((PG8_LAS unsigned char*)lds, g, So, E); if constexpr ((NREP(2)) > 1) { __syncthreads(); pg8::gemm_phase<EpiProj, SkipZOrder, true, true>((PG8_LAS unsigned char*)lds, g, So, E); __syncthreads(); } }
    }
    SEAM(PB + 1);
    if (KIND(3) && IN(PB + 2)) {
        auto zgemm = [&](int zu) {
            pg8::Gemm g{(const pg8::bf16_t*)(p.ws + WS_H), (const pg8::bf16_t*)(p.ws + WS_WTIN) + (size_t)L * NPAD * D, T, NPAD, D};
            OneUnitOrder So{zu >> 2, 8 + (zu & 3)};
            EpiProj E{(bf16_t*)(p.ws + WS_PROJ), (float*)(p.ws + WS_DT), p.in[12] + L * SH};
            pg8::gemm_phase<EpiProj, OneUnitOrder, true, true>((PG8_LAS unsigned char*)lds, g, So, E);
        };
        phase_mix(p, lds, L, zgemm); if constexpr ((NREP(3)) > 1) { __syncthreads(); phase_mix(p, lds, L, zgemm); __syncthreads(); }
    }
    SEAM(PB + 2);
    if (KIND(4) && IN(PB + 3)) { phase_scan(p); if constexpr ((NREP(4)) > 1) { __syncthreads(); phase_scan(p); __syncthreads(); } }
    SEAM(PB + 3);
    if (KIND(5) && IN(PB + 4)) { phase_yoff(p, lds, L); if constexpr ((NREP(5)) > 1) { __syncthreads(); phase_yoff(p, lds, L); __syncthreads(); } }
    SEAM(PB + 4);
    if (KIND(6) && IN(PB + 5)) {
        pg8::Gemm g{(const pg8::bf16_t*)(p.ws + WS_YMIX), (const pg8::bf16_t*)(p.ws + WS_WTOUT) + (size_t)L * D * D, T, D, D};
        pg8::StaticOrder So; So.init(T, D, (int)gridDim.x, (int)blockIdx.x);
        EpiRes<(L == 0)> E{(L == 0) ? p.in[0] : (const float*)nullptr, (bf16_t*)(p.ws + WS_X), (const float*)(p.ws + WS_ADA) + (size_t)L * NB * 6 * D + 2 * D};
        { pg8::gemm_phase<EpiRes<(L == 0)>, pg8::StaticOrder, true, true>((PG8_LAS unsigned char*)lds, g, So, E); if constexpr (((L == 0 ? NREP(6) : 1)) > 1) { __syncthreads(); pg8::gemm_phase<EpiRes<(L == 0)>, pg8::StaticOrder, true, true>((PG8_LAS unsigned char*)lds, g, So, E); __syncthreads(); } }
    }
    SEAM(PB + 5);
    if (KIND(7) && IN(PB + 6)) { phase_router(p, lds, L); if constexpr ((NREP(7)) > 1) { __syncthreads(); phase_router(p, lds, L, true); __syncthreads(); } }
    SEAM(PB + 6);
    if (KIND(8) && IN(PB + 7)) { phase_moe<true>(p, lds, L); if constexpr ((NREP(8)) > 1) { __syncthreads(); phase_moe<true>(p, lds, L); __syncthreads(); } }
    SEAM(PB + 7);
    if (KIND(9) && IN(PB + 8)) { phase_moe<false>(p, lds, L); if constexpr ((NREP(9)) > 1) { __syncthreads(); phase_moe<false>(p, lds, L); __syncthreads(); } }
    SEAM(PB + 8);
#undef IN
#undef SEAM
}

__global__ void __launch_bounds__(NT, 2) mk_fwd(Params p) {
    extern __shared__ __attribute__((aligned(16))) unsigned char lds_raw[];
    ldsp_t lds = (ldsp_t)lds_raw;
    const int lo = p.ph_lo, hi = p.ph_hi;
    volatile LAS unsigned* misc = (volatile LAS unsigned*)(lds + LDS_MISC);
    if (threadIdx.x < 16) misc[threadIdx.x] = 0u;
    __syncthreads();
    XcdBarrier bar; bar.bar = (unsigned*)(p.ws + WS_CTL); bar.x = 0; bar.st = misc;
    if (hi - lo > 1) bar = xcd_barrier_post((unsigned*)(p.ws + WS_CTL), misc);
    if (threadIdx.x == 0) { const unsigned myx = xb_xcc_id() & 7u; misc[9] = myx; misc[10] = __hip_atomic_fetch_add((unsigned*)(p.ws + WS_CTL + CTL_CNT + 4096) + myx * 16 + (lo > 0 ? 8 : 0), 1u, __ATOMIC_RELAXED, __HIP_MEMORY_SCOPE_AGENT); misc[8] = blockIdx.x; }
#ifdef MK_STREAMTEST
    if (lo <= 0) { phase_streamtest(p); __syncthreads(); }
#endif
    if (KIND(0) && lo <= 0 && 0 < hi) { phase_prologue(p, lds, 2, (int)blockIdx.x, (int)gridDim.x); if constexpr ((NREP(0)) > 1) { __syncthreads(); phase_prologue(p, lds, 2, (int)blockIdx.x, (int)gridDim.x); __syncthreads(); } }
    if (lo <= 0 && 1 < hi) xcd_barrier(bar);
    if (hi - lo > 1 && threadIdx.x == 0) {
        bool even = (gridDim.x & 7u) == 0u;
        for (int j = 0; j < 16; ++j) { const unsigned c = xb_ld(&bar.bar[XB_XCNT(j)]); if (c != ((j < 8) ? gridDim.x / 8u : 0u)) even = false; }
        if (even) misc[8] = misc[9] + 8u * misc[10];
    }
    __syncthreads();
    run_layer<0>(p, lds, bar, lo, hi);
#ifdef MK_XBAR
    for (int xb = 0; xb < MK_XBAR; ++xb) xcd_barrier(bar);
#endif
    run_layer<1>(p, lds, bar, lo, hi);
    if (KIND(1) && lo <= 19 && 19 < hi) { phase_norm<2>(p, 1); if constexpr ((NREP(1)) > 1) { __syncthreads(); phase_norm<2>(p, 1); __syncthreads(); } }
}
}

extern "C" void kernel_launch(void* const* d_in, const int* in_sizes, int n_in, void* d_out, int out_size, void* d_ws, size_t ws_size, hipStream_t stream) {
    using namespace mk;
    static int grid = 0;
    if (grid == 0) {
        if (n_in != 24 || ws_size < WS_END) { fprintf(stderr, "kernel_launch: unexpected inputs (n_in %d, ws %zu < %zu)\n", n_in, ws_size, (size_t)WS_END); grid = -1; return; }
        int dev = 0, cus = 0, per_cu = 0;
        if (hipGetDevice(&dev) != hipSuccess || hipDeviceGetAttribute(&cus, hipDeviceAttributeMultiprocessorCount, dev) != hipSuccess) { grid = -1; return; }
        if (hipFuncSetAttribute((const void*)mk_fwd, hipFuncAttributeMaxDynamicSharedMemorySize, LDS_BYTES) != hipSuccess) { fprintf(stderr, "kernel_launch: hipFuncSetAttribute failed\n"); grid = -1; return; }
        if (hipOccupancyMaxActiveBlocksPerMultiprocessor(&per_cu, (const void*)mk_fwd, NT, LDS_BYTES) != hipSuccess || per_cu < 1) fprintf(stderr, "kernel_launch: occupancy query says %d\n", per_cu);
        (void)hipGetLastError();
        grid = cus;
    }
    if (grid < 0) return;
    (void)in_sizes; (void)out_size;
    if (hipMemsetAsync((char*)d_ws + WS_CTL, 0, CTL_BYTES, stream) != hipSuccess) return;
    Params prm{};
    for (int i = 0; i < 24; ++i) prm.in[i] = (const float*)d_in[i];
    prm.out = (float*)d_out; prm.ws = (unsigned char*)d_ws;
#if MK_N_LAUNCHES == 1
    prm.ph_lo = 0; prm.ph_hi = N_PHASES;
    hipLaunchKernelGGL(mk_fwd, dim3(grid), dim3(NT), LDS_BYTES, stream, prm);
#else
    for (int k = 0; k < N_PHASES; ++k) { prm.ph_lo = k; prm.ph_hi = k + 1; hipLaunchKernelGGL(mk_fwd, dim3(grid), dim3(NT), LDS_BYTES, stream, prm); }
#endif
    const hipError_t le = hipPeekAtLastError();
    if (le != hipSuccess) fprintf(stderr, "kernel_launch: launch failed: %s\n", hipGetErrorName(le));
}
```

```cpp
#include <hip/hip_runtime.h>
#include <stdint.h>
#include <stdio.h>

#ifndef MK_N_LAUNCHES
#define MK_N_LAUNCHES 1
#endif

namespace mk {
constexpr int D = 2048, NB = 4, S = 2048, T = NB * S;
constexpr int GH = 8, CH = 128, NC = S / CH;
constexpr int SW = 1024, SHD = 64, SH = 16, SG = 2, SN = 128, CONVD = 1536, NPROJ = 4624;
constexpr int NPJ = 4608;
constexpr int NPAD = 4864;
constexpr int NE = 64, NGRP = 8, EPG = 8, DE = 512;
constexpr float EPS = 1e-6f;
constexpr int NT = 512;
constexpr int LDS_BYTES = 160 * 1024 - 512;

typedef unsigned short bf16_t;
typedef short bf16x8 __attribute__((ext_vector_type(8)));
typedef float f32x4 __attribute__((ext_vector_type(4)));
typedef float f32x16 __attribute__((ext_vector_type(16)));
typedef unsigned u32x4 __attribute__((ext_vector_type(4)));
typedef unsigned u32x2 __attribute__((ext_vector_type(2)));

constexpr size_t al(size_t x) { return (x + 255) & ~(size_t)255; }
constexpr size_t WS_CTL = 0, CTL_BYTES = 64 * 1024;
constexpr size_t CTL_CNT = 32 * 1024;
constexpr size_t WS_ADA = WS_CTL + CTL_BYTES;
constexpr size_t WS_WTIN = WS_ADA + al((size_t)2 * NB * 6 * D * 4);
constexpr size_t WS_WTOUT = WS_WTIN + al((size_t)2 * NPAD * D * 2);
constexpr size_t WS_RWH = WS_WTOUT + al((size_t)2 * D * D * 2);
constexpr size_t WS_RWL = WS_RWH + al((size_t)NE * D * 2);
constexpr size_t WS_WSB = WS_RWL + al((size_t)NE * D * 2);
constexpr size_t WS_X = WS_WSB + al((size_t)2 * GH * 128 * 128 * 2);
constexpr size_t WS_H = WS_X + al((size_t)T * D * 4);
constexpr size_t WS_PROJ = WS_H + al((size_t)T * D * 2);
constexpr size_t WS_DT = WS_PROJ + al((size_t)T * NPJ * 2);
constexpr size_t WS_ACS = WS_DT + al((size_t)T * SH * 4);
constexpr size_t WS_YD = WS_ACS + al((size_t)T * SH * 4);
constexpr size_t WS_STATES = WS_YD + al((size_t)T * SW * 2);
constexpr size_t WS_PREV = WS_STATES + al((size_t)NB * NC * SH * SHD * SN * 4);
constexpr size_t WS_YMIX = WS_PREV + al((size_t)NB * NC * SH * SHD * SN * 2);
constexpr size_t WS_LIST = WS_YMIX + al((size_t)T * D * 2);
constexpr size_t WS_GW = WS_LIST + al((size_t)NE * T * 4);
constexpr size_t WS_ACT = WS_GW + al((size_t)T * 2 * 4);
constexpr size_t WS_O = WS_ACT + al((size_t)T * 2 * DE * 2);
#ifndef MK_SCAP
#define MK_SCAP 512
#endif
constexpr int SCAP = MK_SCAP;
constexpr size_t WS_HG = WS_O + al((size_t)T * 2 * D * 2);
constexpr size_t WS_ACTS = WS_HG + al((size_t)NE * 64 * SCAP * 64);
constexpr size_t WS_END = WS_ACTS + al((size_t)NE * 16 * SCAP * 64);

struct Params {
    const float* in[24];
    float* out;
    unsigned char* ws;
    int ph_lo, ph_hi;
};

__device__ __forceinline__ float silu_f(float x) { return x * __builtin_amdgcn_rcpf(1.0f + __expf(-x)); }
__device__ __forceinline__ float softplus_f(float x) { return x > 20.f ? x : log1pf(__expf(x)); }
typedef __bf16 bf16x2_t __attribute__((ext_vector_type(2)));
__device__ __forceinline__ unsigned pk_bf16(float lo, float hi) { bf16x2_t v; v.x = (__bf16)lo; v.y = (__bf16)hi; return __builtin_bit_cast(unsigned, v); }
__device__ __forceinline__ float bf_lo(unsigned u) { return __uint_as_float(u << 16); }
__device__ __forceinline__ float bf_hi(unsigned u) { return __uint_as_float(u & 0xffff0000u); }
__device__ __forceinline__ bf16_t f2bf(float f) { return (bf16_t)(pk_bf16(f, 0.f) & 0xffffu); }
}

namespace pg8 {
#define PG8_LAS __attribute__((address_space(3)))
typedef unsigned short bf16_t;
typedef short bf16x8 __attribute__((ext_vector_type(8)));
typedef float f32x4 __attribute__((ext_vector_type(4)));
typedef unsigned u32x4 __attribute__((ext_vector_type(4)));
constexpr int BM = 256, BK = 64, HALF = 128, HTB = HALF * BK * 2  , STAGE_BYTES = 8 * HTB, NXCD = 8, WGM = 8;

__host__ __device__ __forceinline__ int lds_byte(int r, int c) { const int st = (r >> 4) * 2 + (c >> 5), rr = r & 15, cc = c & 31, ob = rr * 64 + cc * 2; return st * 1024 + (ob ^ (((ob >> 9) & 1) << 5)); }
__host__ __device__ __forceinline__ void stage_rc(int b, int& R, int& C) { const int st = b / 1024, sb = b % 1024, swz = sb ^ (((sb >> 9) & 1) << 5); R = (st >> 1) * 16 + swz / 64; C = (st & 1) * 32 + (swz % 64) / 2; }
__host__ __device__ __forceinline__ int perm32(int rho) { const int n = rho >> 4, i = rho & 15; return 8 * (i >> 2) + 4 * n + (i & 3); }

struct Unit { int pm, pn; };
struct Gemm { const bf16_t* A; const bf16_t* Bt; int M, N, K; };

struct StaticOrder {
    int nM, nN, nwg, G, c;
    __host__ __device__ void init(int M, int N, int G_, int c_) { nM = M / BM; nN = N / BM; nwg = nM * nN; G = G_; c = c_; }
    __host__ __device__ bool next(int i, Unit& u) const {
        const long L = (long)i * G + c; if (L >= nwg) return false;
        int wgid = (int)L; { const int q = nwg / NXCD, r = nwg % NXCD, xcd = wgid % NXCD, off = wgid / NXCD; wgid = (xcd < r ? xcd * (q + 1) : r * (q + 1) + (xcd - r) * q) + off; }
        const int nig = WGM * nN, gid = wgid / nig, fm = gid * WGM, gsz = (nM - fm) < WGM ? (nM - fm) : WGM;
        u.pm = fm + ((wgid % nig) % gsz); u.pn = (wgid % nig) / gsz; return true;
    }
    __device__ __forceinline__ void a_ready(const Unit&) const {}
    __device__ __forceinline__ void done(const Unit&) const {}
};

__device__ __forceinline__ unsigned cvt_pk_bf16(float lo, float hi) { unsigned r; asm volatile("v_cvt_pk_bf16_f32 %0, %1, %2" : "=v"(r) : "v"(lo), "v"(hi)); return r; }
typedef float f32x2 __attribute__((ext_vector_type(2)));
__device__ __forceinline__ f32x2 gelu_pk(f32x2 v) {
    const f32x2 av = __builtin_elementwise_abs(v), d = av * 0.2316418882f + 1.0f;
    f32x2 t; t.x = __builtin_amdgcn_rcpf(d.x); t.y = __builtin_amdgcn_rcpf(d.y);
    f32x2 q = t * 0.5307027145f + (-0.7265760135f); q = q * t + 0.7107068705f; q = q * t + (-0.142248368f); q = q * t + 0.127414796f; q = q * t;
    const f32x2 s = (v * v) * (-0.72134752044f);
    f32x2 e; e.x = __builtin_amdgcn_exp2f(s.x); e.y = __builtin_amdgcn_exp2f(s.y);
    const f32x2 m = v * (q * e), r = v - m;
    f32x2 o; o.x = v.x < 0.f ? m.x : r.x; o.y = v.y < 0.f ? m.y : r.y; return o;
}

template <class Epi, class Sched, bool ALIGN_EPI = false, bool SP2 = false>
__device__ __forceinline__ void gemm_phase(PG8_LAS unsigned char* lds, const Gemm g, const Sched& S, const Epi& E) {
    const int tid = threadIdx.x, wid = __builtin_amdgcn_readfirstlane(tid >> 6), lane = tid & 63, wr = wid >> 2, wc = wid & 3, fr = lane & 15, fq = lane >> 4;
    const int K = g.K, nt = K / BK;
    unsigned voffA[2], voffB[2];
#pragma unroll
    for (int i = 0; i < 2; ++i) { int R, C; stage_rc(tid * 16 + i * 8192, R, C); const int Rb = Epi::PERM ? ((R & ~31) + perm32(R & 31)) : R;
        voffA[i] = (unsigned)(R * K + C) * 2u; voffB[i] = (unsigned)(Rb * K + C) * 2u; }
    const size_t kstep = (size_t)(BK * 2);
    const size_t hstep = (size_t)HALF * K * 2;
    const size_t tstep = 2 * hstep;
    const unsigned ldsw = (unsigned)wid * 1024u;
    const int aoff = lds_byte(wr * 64 + fr, fq * 8), boff = lds_byte(wc * 32 + fr, fq * 8);
#define PG8_SA(b, h) (((b) * 2 + (h)) * HTB)
#define PG8_SB(b, h) ((4 + (b) * 2 + (h)) * HTB)
#define PG8_STAGE(bufoff, gbase, voff) do { _Pragma("unroll") for (int _i = 0; _i < 2; ++_i) \
        __builtin_amdgcn_global_load_lds((const unsigned*)((const char*)(gbase) + (voff)[_i]), (PG8_LAS unsigned*)(lds + (bufoff) + ldsw + _i * 8192), 16, 0, 0); } while (0)
#define PG8_LDA(dst, b, h) do { _Pragma("unroll") for (int m = 0; m < 4; ++m) _Pragma("unroll") for (int k = 0; k < 2; ++k) dst[m][k] = *(const PG8_LAS bf16x8*)(lds + PG8_SA(b, h) + aoff + m * 2048 + k * 1024); } while (0)
#define PG8_LDB(dst, b, h) do { _Pragma("unroll") for (int n = 0; n < 2; ++n) _Pragma("unroll") for (int k = 0; k < 2; ++k) dst[n][k] = *(const PG8_LAS bf16x8*)(lds + PG8_SB(b, h) + boff + n * 2048 + k * 1024); } while (0)
#define PG8_MMA(ai, bj, At, Bt) do { __builtin_amdgcn_s_setprio(1); _Pragma("unroll") for (int m = 0; m < 4; ++m) _Pragma("unroll") for (int n = 0; n < 2; ++n) _Pragma("unroll") for (int k = 0; k < 2; ++k) \
        acc[ai][bj][m][n] = __builtin_amdgcn_mfma_f32_16x16x32_bf16(Bt[n][k], At[m][k], acc[ai][bj][m][n], 0, 0, 0); __builtin_amdgcn_s_setprio(0); } while (0)
#define PG8_WAIT_V(n) asm volatile("s_waitcnt vmcnt(" #n ")" ::: "memory")
#define PG8_WAIT_L(n) asm volatile("s_waitcnt lgkmcnt(" #n ")" ::: "memory")
#define PG8_BAR __builtin_amdgcn_s_barrier()
#define PG8_SCHED __builtin_amdgcn_sched_barrier(0)
    Unit cur, nxt; int ui = 0;
    if (!S.next(0, cur)) return;
    f32x4 acc[2][2][4][2];
#pragma unroll
    for (int a = 0; a < 2; ++a)
#pragma unroll
        for (int b = 0; b < 2; ++b)
#pragma unroll
            for (int m = 0; m < 4; ++m)
#pragma unroll
                for (int n = 0; n < 2; ++n) acc[a][b][m][n] = (f32x4){0.f, 0.f, 0.f, 0.f};
    bf16x8 At[4][2], B0[2][2], B1[2][2];
    const char* cA = (const char*)g.A + (size_t)cur.pm * tstep; const char* cB = (const char*)g.Bt + (size_t)cur.pn * tstep;
    S.a_ready(cur);
    if constexpr (SP2) {
        PG8_STAGE(PG8_SB(0, 0), cB, voffB); PG8_STAGE(PG8_SB(0, 1), cB + hstep, voffB); PG8_STAGE(PG8_SA(0, 0), cA, voffA); PG8_STAGE(PG8_SA(0, 1), cA + hstep, voffA);
        if (wr == 1) PG8_BAR;
        PG8_WAIT_V(2); PG8_BAR;
        PG8_STAGE(PG8_SB(1, 0), cB + kstep, voffB); PG8_STAGE(PG8_SA(1, 0), cA + kstep, voffA); PG8_STAGE(PG8_SB(1, 1), cB + hstep + kstep, voffB);
        PG8_WAIT_V(6); PG8_BAR;
    } else {
        PG8_STAGE(PG8_SB(0, 0), cB, voffB); PG8_STAGE(PG8_SA(0, 0), cA, voffA); PG8_STAGE(PG8_SB(0, 1), cB + hstep, voffB); PG8_STAGE(PG8_SA(0, 1), cA + hstep, voffA);
        if (wr == 1) PG8_BAR;
        PG8_WAIT_V(4); PG8_BAR;
        PG8_STAGE(PG8_SB(1, 0), cB + kstep, voffB); PG8_STAGE(PG8_SA(1, 0), cA + kstep, voffA); PG8_STAGE(PG8_SB(1, 1), cB + hstep + kstep, voffB);
        PG8_WAIT_V(6); PG8_BAR;
    }
    for (;;) {
        const bool has_next = S.next(ui + 1, nxt);
        const char* nA = has_next ? (const char*)g.A + (size_t)nxt.pm * tstep : cA; const char* nB = has_next ? (const char*)g.Bt + (size_t)nxt.pn * tstep : cB;
        for (int t = 0; t < nt; t += 2) {
            const bool last = (t == nt - 2);
            const char* a1 = cA + (size_t)(t + 1) * kstep;
            const char* a2 = last ? nA : cA + (size_t)(t + 2) * kstep; const char* b2 = last ? nB : cB + (size_t)(t + 2) * kstep;
            const char* a3 = a2 + kstep; const char* b3 = b2 + kstep;
            if (last && has_next) S.a_ready(nxt);
            if constexpr (SP2) {
            PG8_LDB(B0, 0, 0); PG8_LDB(B1, 0, 1); PG8_SCHED; PG8_LDA(At, 0, 0); PG8_STAGE(PG8_SA(1, 1), a1 + hstep, voffA);
            PG8_WAIT_V(8); PG8_WAIT_L(0); PG8_BAR; PG8_MMA(0, 0, At, B0); PG8_MMA(0, 1, At, B1); PG8_BAR; PG8_SCHED;
            PG8_LDA(At, 0, 1); PG8_STAGE(PG8_SB(0, 0), b2, voffB); PG8_STAGE(PG8_SB(0, 1), b2 + hstep, voffB); PG8_STAGE(PG8_SA(0, 0), a2, voffA);
            PG8_WAIT_V(8); PG8_WAIT_L(0); PG8_BAR; PG8_MMA(1, 0, At, B0); PG8_MMA(1, 1, At, B1); PG8_BAR; PG8_SCHED;
            PG8_LDB(B0, 1, 0); PG8_LDB(B1, 1, 1); PG8_SCHED; PG8_LDA(At, 1, 0); PG8_STAGE(PG8_SA(0, 1), a2 + hstep, voffA);
            PG8_WAIT_V(8); PG8_WAIT_L(0); PG8_BAR; PG8_MMA(0, 0, At, B0); PG8_MMA(0, 1, At, B1); PG8_BAR; PG8_SCHED;
            PG8_LDA(At, 1, 1); PG8_STAGE(PG8_SB(1, 0), b3, voffB); PG8_STAGE(PG8_SB(1, 1), b3 + hstep, voffB); PG8_STAGE(PG8_SA(1, 0), a3, voffA);
            PG8_WAIT_V(8); PG8_WAIT_L(0); PG8_BAR; PG8_MMA(1, 0, At, B0); PG8_MMA(1, 1, At, B1); PG8_BAR; PG8_SCHED;
            } else {
            PG8_LDB(B0, 0, 0); PG8_SCHED; PG8_LDA(At, 0, 0); PG8_STAGE(PG8_SA(1, 1), a1 + hstep, voffA);
            PG8_WAIT_L(8); PG8_BAR; PG8_WAIT_L(0); PG8_MMA(0, 0, At, B0); PG8_BAR; PG8_SCHED;
            PG8_LDB(B1, 0, 1); PG8_STAGE(PG8_SB(0, 0), b2, voffB);
            PG8_BAR; PG8_WAIT_L(0); PG8_MMA(0, 1, At, B1); PG8_BAR;
            PG8_LDA(At, 0, 1); PG8_STAGE(PG8_SA(0, 0), a2, voffA);
            PG8_BAR; PG8_WAIT_L(0); PG8_MMA(1, 0, At, B0); PG8_BAR; PG8_SCHED;
            PG8_STAGE(PG8_SB(0, 1), b2 + hstep, voffB);
            PG8_WAIT_V(6); PG8_BAR; PG8_MMA(1, 1, At, B1); PG8_BAR;
            PG8_LDB(B0, 1, 0); PG8_SCHED; PG8_LDA(At, 1, 0); PG8_STAGE(PG8_SA(0, 1), a2 + hstep, voffA);
            PG8_WAIT_L(8); PG8_BAR; PG8_WAIT_L(0); PG8_MMA(0, 0, At, B0); PG8_BAR; PG8_SCHED;
            PG8_LDB(B1, 1, 1); PG8_STAGE(PG8_SB(1, 0), b3, voffB);
            PG8_BAR; PG8_WAIT_L(0); PG8_MMA(0, 1, At, B1); PG8_BAR;
            PG8_LDA(At, 1, 1); PG8_STAGE(PG8_SA(1, 0), a3, voffA);
            PG8_BAR; PG8_WAIT_L(0); PG8_MMA(1, 0, At, B0); PG8_BAR; PG8_SCHED;
            PG8_STAGE(PG8_SB(1, 1), b3 + hstep, voffB);
            PG8_WAIT_V(6); PG8_BAR; PG8_MMA(1, 1, At, B1); PG8_BAR;
            }
        }
        if constexpr (ALIGN_EPI) { if (wr == 0) PG8_BAR; }
        if constexpr (!Epi::AFTER_DRAIN) { E(acc, cur, wr, wc, fr, fq); S.done(cur); }
        if (!has_next) break;
#pragma unroll
        for (int a = 0; a < 2; ++a)
#pragma unroll
            for (int b = 0; b < 2; ++b)
#pragma unroll
                for (int m = 0; m < 4; ++m)
#pragma unroll
                    for (int n = 0; n < 2; ++n) acc[a][b][m][n] = (f32x4){0.f, 0.f, 0.f, 0.f};
        cur = nxt; cA = nA; cB = nB; ++ui;
        if constexpr (ALIGN_EPI) { if (wr == 1) PG8_BAR; }
    }
    PG8_WAIT_V(0);
    if constexpr (!ALIGN_EPI) { if (wr == 0) PG8_BAR; }
    PG8_BAR;
    if constexpr (Epi::AFTER_DRAIN) { E.fused(acc, cur, wr, wc, fr, fq, lds, wid, lane); S.done(cur); }
#undef PG8_SA
#undef PG8_SB
#undef PG8_STAGE
#undef PG8_LDA
#undef PG8_LDB
#undef PG8_MMA
#undef PG8_WAIT_V
#undef PG8_WAIT_L
#undef PG8_BAR
#undef PG8_SCHED
}

}

#define XB_TMO      128
#define XB_XCNT(j)  (256  + 64 * (j))
#define XB_XSUB(j)  (1280 + 64 * (j))
#define XB_XGEN(j)  (2304 + 64 * (j))
#define XB_TOP      3328
#define XB_TOPGEN   3392
#define XCD_BAR_WORDS 3456
#define XB_SPIN_CAP (1u << 18)
#define LAS __attribute__((address_space(3)))

__device__ __forceinline__ unsigned xb_ld(unsigned* p)              { return __hip_atomic_load(p, __ATOMIC_RELAXED, __HIP_MEMORY_SCOPE_AGENT); }
__device__ __forceinline__ unsigned xb_add(unsigned* p, unsigned v) { return __hip_atomic_fetch_add(p, v, __ATOMIC_RELAXED, __HIP_MEMORY_SCOPE_AGENT); }
__device__ __forceinline__ unsigned xb_xcc_id() { return (unsigned)__builtin_amdgcn_s_getreg((3 << 11) | 20) & 0xFu; }
#define XB_SPIN(cond, bar) do { unsigned _sp = 0; while (cond) { __builtin_amdgcn_s_sleep(1); \
    if ((++_sp & 255u) == 0u) { if (xb_ld(&(bar)[XB_TMO])) break; if (_sp > XB_SPIN_CAP) { atomicAdd(&(bar)[XB_TMO], 1u); break; } } } } while (0)

struct XcdBarrier {
    unsigned* bar; unsigned x;
    volatile LAS unsigned* st;
};

__device__ __forceinline__ XcdBarrier xcd_barrier_post(unsigned* bar, volatile LAS unsigned* st) {
    XcdBarrier b; b.bar = bar; b.x = xb_xcc_id(); b.st = st;
    if (threadIdx.x == 0) (void)xb_add(&bar[XB_XCNT(b.x)], 1u);
    return b;
}
__device__ __forceinline__ void xcd_barrier_complete(unsigned* bar, unsigned x, unsigned& nloc, unsigned& nx) {
    const unsigned G = gridDim.x * gridDim.y * gridDim.z;
    unsigned sum, cnt, mine, sp = 0u;
    for (;;) {
        sum = 0u; cnt = 0u; mine = 0u;
#pragma unroll
        for (unsigned j = 0; j < 16; ++j) { const unsigned c = xb_ld(&bar[XB_XCNT(j)]); sum += c; cnt += (c > 0u) ? 1u : 0u; mine = (j == x) ? c : mine; }
        if (sum == G) break;
        __builtin_amdgcn_s_sleep(1);
        if ((++sp & 255u) == 0u) { if (xb_ld(&bar[XB_TMO])) break; if (sp > XB_SPIN_CAP) { atomicAdd(&bar[XB_TMO], 1u); break; } }
    }
    nloc = mine > 0u ? mine : 1u; nx = cnt > 0u ? cnt : 1u;
}

__device__ __forceinline__ void xcd_barrier(const XcdBarrier& b) {
    asm volatile("s_waitcnt vmcnt(0)" ::: "memory");
    __syncthreads();
    if (threadIdx.x == 0) {
        unsigned* bar = b.bar;
        __builtin_amdgcn_s_waitcnt(0);
        unsigned nloc = b.st[0], nx = b.st[1];
        if (nloc == 0u) { xcd_barrier_complete(bar, b.x, nloc, nx); b.st[0] = nloc; b.st[1] = nx; }
        const unsigned old = xb_add(&bar[XB_XSUB(b.x)], 1u);
        const unsigned gen = old / nloc;
        if (old + 1u == (gen + 1u) * nloc) {
            __builtin_amdgcn_fence(__ATOMIC_RELEASE, "agent");
            asm volatile("s_waitcnt vmcnt(0)" ::: "memory");
            const unsigned og = xb_add(&bar[XB_TOP], 1u);
            const unsigned tg = og / nx;
            if (og + 1u == (tg + 1u) * nx) xb_add(&bar[XB_TOPGEN], 1u);
            else XB_SPIN(xb_ld(&bar[XB_TOPGEN]) == tg, bar);
            __builtin_amdgcn_fence(__ATOMIC_ACQUIRE, "agent");
            xb_add(&bar[XB_XGEN(b.x)], 1u);
            asm volatile("s_waitcnt vmcnt(0)" ::: "memory");
        } else {
            XB_SPIN(xb_ld(&bar[XB_XGEN(b.x)]) == gen, bar);
            __builtin_amdgcn_fence(__ATOMIC_ACQUIRE, "agent");
            asm volatile("s_waitcnt vmcnt(0)" ::: "memory");
        }
    }
    __syncthreads();
}


namespace mk {
using pg8::cvt_pk_bf16;
typedef LAS unsigned char* ldsp_t;

template <int NT_>
__device__ __forceinline__ void transpose_tiles(const float* __restrict__ src, int ldn, int nvalid, bf16_t* __restrict__ dst_hi, bf16_t* __restrict__ dst_lo, int K, int k0, int n0,
                                                LAS float* tile, int tid) {
    float4 v[NT_][2];
#pragma unroll
    for (int t = 0; t < NT_; ++t)
#pragma unroll
        for (int i = 0; i < 2; ++i) {
            const int r = (tid >> 4) + 32 * i, n = n0 + t * 64 + (tid & 15) * 4;
            v[t][i] = make_float4(0.f, 0.f, 0.f, 0.f);
            if (n < nvalid) v[t][i] = *(const float4*)(src + (size_t)(k0 + r) * ldn + n);
        }
#pragma unroll
    for (int t = 0; t < NT_; ++t) {
        LAS float* tl = tile + (t & 1) * (64 * 65);
#pragma unroll
        for (int i = 0; i < 2; ++i) {
            const int r = (tid >> 4) + 32 * i, c4 = (tid & 15) * 4;
            tl[r * 65 + c4 + 0] = v[t][i].x; tl[r * 65 + c4 + 1] = v[t][i].y; tl[r * 65 + c4 + 2] = v[t][i].z; tl[r * 65 + c4 + 3] = v[t][i].w;
        }
        __syncthreads();
        const int n = tid >> 3, ko = (tid & 7) * 8;
        float f[8];
#pragma unroll
        for (int j = 0; j < 8; ++j) f[j] = tl[(ko + j) * 65 + n];
        u32x4 h; h.x = pk_bf16(f[0], f[1]); h.y = pk_bf16(f[2], f[3]); h.z = pk_bf16(f[4], f[5]); h.w = pk_bf16(f[6], f[7]);
        *(u32x4*)(dst_hi + (size_t)(n0 + t * 64 + n) * K + k0 + ko) = h;
        if (dst_lo) {
            u32x4 lo;
            lo.x = pk_bf16(f[0] - bf_lo(h.x), f[1] - bf_hi(h.x)); lo.y = pk_bf16(f[2] - bf_lo(h.y), f[3] - bf_hi(h.y));
            lo.z = pk_bf16(f[4] - bf_lo(h.z), f[5] - bf_hi(h.z)); lo.w = pk_bf16(f[6] - bf_lo(h.w), f[7] - bf_hi(h.w));
            *(u32x4*)(dst_lo + (size_t)(n0 + t * 64 + n) * K + k0 + ko) = lo;
        }
    }
    __syncthreads();
}

__device__ __forceinline__ void phase_prologue(const Params& p, ldsp_t lds, int which, int rank, int nrank) {
    const int tid = threadIdx.x;
    LAS float* sc = (LAS float*)lds;
    LAS float* red = (LAS float*)(lds + 32768);
    LAS float* tile = (LAS float*)(lds + 65536);
    const float* c = p.in[1]; const float* ada_w = p.in[2]; const float* ada_b = p.in[3];
    float* ADA = (float*)(p.ws + WS_ADA);
    for (int i = tid; i < NB * D; i += NT) sc[i] = silu_f(c[i]);
    __syncthreads();
    constexpr int U_ADA = 768, U_WIN = 32 * 19, U_WOUT = 32 * 8, U_RT = 32, U_WSB = 64;
    constexpr int U_TOT = U_ADA + 2 * U_WIN + 2 * U_WOUT + U_RT + U_WSB;
    for (int u0 = rank; u0 < U_TOT; u0 += nrank) {
        const int u = u0;
        int ul = -1;
        if (u < U_ADA) ul = u / 384; else if (u < U_ADA + 2 * U_WIN) ul = (u - U_ADA) / U_WIN; else if (u < U_ADA + 2 * U_WIN + 2 * U_WOUT) ul = (u - U_ADA - 2 * U_WIN) / U_WOUT;
        if ((which == 0 && ul == 1) || (which == 1 && ul != 1)) continue;
        if (u < U_ADA) {
            const int l = u / 384, cg = u % 384, cl = tid & 7, ks = tid >> 3;
            const float* w = ada_w + ((size_t)l * D + ks * 32) * (6 * D) + cg * 32 + cl * 4;
            float acc[4][4];
#pragma unroll
            for (int b = 0; b < 4; ++b)
#pragma unroll
                for (int i = 0; i < 4; ++i) acc[b][i] = 0.f;
#pragma unroll 16
            for (int kk = 0; kk < 32; ++kk) {
                const float4 wv = *(const float4*)(w + (size_t)kk * (6 * D));
#pragma unroll
                for (int b = 0; b < 4; ++b) { const float s = sc[b * D + ks * 32 + kk]; acc[b][0] += s * wv.x; acc[b][1] += s * wv.y; acc[b][2] += s * wv.z; acc[b][3] += s * wv.w; }
            }
#pragma unroll
            for (int b = 0; b < 4; ++b)
#pragma unroll
                for (int i = 0; i < 4; ++i) red[(ks * 4 + b) * 32 + cl * 4 + i] = acc[b][i];
            __syncthreads();
            if (tid < 128) {
                const int b = tid >> 5, col = tid & 31;
                float s = 0.f;
                for (int k2 = 0; k2 < 64; ++k2) s += red[(k2 * 4 + b) * 32 + col];
                ADA[((size_t)l * NB + b) * (6 * D) + cg * 32 + col] = s + ada_b[l * 6 * D + cg * 32 + col];
            }
            __syncthreads();
        } else if (u < U_ADA + 2 * U_WIN) {
            const int v = u - U_ADA, l = v / U_WIN, tt = v % U_WIN, kt = tt / 19, ng = tt % 19;
            transpose_tiles<4>(p.in[5] + (size_t)l * D * NPROJ, NPROJ, NPROJ, (bf16_t*)(p.ws + WS_WTIN) + (size_t)l * NPAD * D, nullptr, D, kt * 64, ng * 256, tile, tid);
        } else if (u < U_ADA + 2 * U_WIN + 2 * U_WOUT) {
            const int v = u - U_ADA - 2 * U_WIN, l = v / U_WOUT, tt = v % U_WOUT, kt = tt / 8, ng = tt % 8;
            transpose_tiles<4>(p.in[16] + (size_t)l * D * D, D, D, (bf16_t*)(p.ws + WS_WTOUT) + (size_t)l * D * D, nullptr, D, kt * 64, ng * 256, tile, tid);
        } else if (u < U_ADA + 2 * U_WIN + 2 * U_WOUT + U_RT) {
            const int kt = u - (U_ADA + 2 * U_WIN + 2 * U_WOUT);
            transpose_tiles<1>(p.in[18], NE, NE, (bf16_t*)(p.ws + WS_RWH), (bf16_t*)(p.ws + WS_RWL), D, kt * 64, 0, tile, tid);
        } else {
            const int v = u - (U_ADA + 2 * U_WIN + 2 * U_WOUT + U_RT);
            const float* wsrc = p.in[8]; bf16_t* dst = (bf16_t*)(p.ws + WS_WSB);
#pragma unroll
            for (int i = 0; i < 2; ++i) {
                const int e0 = v * 4096 + (tid + i * NT) * 4;
                const int s0 = e0 & 127, t = (e0 >> 7) & 127;
                const float4 wv = *(const float4*)(wsrc + e0);
                u32x2 o; o.x = pk_bf16(s0 + 0 <= t ? wv.x : 0.f, s0 + 1 <= t ? wv.y : 0.f); o.y = pk_bf16(s0 + 2 <= t ? wv.z : 0.f, s0 + 3 <= t ? wv.w : 0.f);
                *(u32x2*)(dst + e0) = o;
            }
        }
    }
}

template <int MODE>
__device__ __forceinline__ void phase_norm(const Params& p, int l) {
    const int tid = threadIdx.x, lane = tid & 63, wid = tid >> 6, G = gridDim.x;
    const float* ADA = (const float*)(p.ws + WS_ADA);
    bf16_t* X = (bf16_t*)(p.ws + WS_X);
    bf16_t* H = (bf16_t*)(p.ws + WS_H);
    const char* O8 = (const char*)(p.ws + WS_O);
    for (int rb = blockIdx.x; rb < T / 32; rb += G) {
        const int b = (rb * 32) / S;
        float4 Av[8], Bv[8], Gv[8];
#pragma unroll
        for (int j = 0; j < 8; ++j) {
            const int d = lane * 4 + 256 * j;
            if (MODE == 2) { Av[j] = *(const float4*)(p.in[23] + d); Bv[j] = make_float4(0.f, 0.f, 0.f, 0.f); }
            else {
                const float4 nw = *(const float4*)(p.in[4] + l * D + d);
                const float4 sh = *(const float4*)(ADA + ((size_t)l * NB + b) * 6 * D + 0 * D + d);
                const float4 s1 = *(const float4*)(ADA + ((size_t)l * NB + b) * 6 * D + 1 * D + d);
                Av[j] = make_float4(nw.x * (1.f + s1.x), nw.y * (1.f + s1.y), nw.z * (1.f + s1.z), nw.w * (1.f + s1.w)); Bv[j] = sh;
            }
            if (MODE >= 1) { const int lp = (MODE == 2) ? 1 : l - 1; Gv[j] = *(const float4*)(ADA + ((size_t)lp * NB + b) * 6 * D + 5 * D + d); }
        }
        constexpr int UNR = (MODE == 1) ? 1 : 2;
#pragma unroll UNR
        for (int rr = 0; rr < 4; ++rr) {
            const int t = rb * 32 + wid * 4 + rr;
            float4 xv[8]; float ss = 0.f;
#pragma unroll
            for (int j = 0; j < 8; ++j) {
                const int d = lane * 4 + 256 * j;
                if (MODE == 0) xv[j] = *(const float4*)(p.in[0] + (size_t)t * D + d);
                else { const u32x2 xb = *(const u32x2*)(X + (size_t)t * D + d); xv[j] = make_float4(bf_lo(xb.x), bf_hi(xb.x), bf_lo(xb.y), bf_hi(xb.y)); }
                if (MODE >= 1) {
                    const int o0 = *(const int*)(O8 + (size_t)(2 * t) * D + d), o1 = *(const int*)(O8 + (size_t)(2 * t + 1) * D + d);
                    typedef float f32x2_t __attribute__((ext_vector_type(2)));
                    const f32x2_t a0 = __builtin_amdgcn_cvt_pk_f32_fp8(o0, false), a1 = __builtin_amdgcn_cvt_pk_f32_fp8(o0, true), b0 = __builtin_amdgcn_cvt_pk_f32_fp8(o1, false), b1 = __builtin_amdgcn_cvt_pk_f32_fp8(o1, true);
                    xv[j].x += Gv[j].x * (a0.x + b0.x); xv[j].y += Gv[j].y * (a0.y + b0.y);
                    xv[j].z += Gv[j].z * (a1.x + b1.x); xv[j].w += Gv[j].w * (a1.y + b1.y);
                }
                ss += xv[j].x * xv[j].x + xv[j].y * xv[j].y + xv[j].z * xv[j].z + xv[j].w * xv[j].w;
            }
#pragma unroll
            for (int o = 32; o > 0; o >>= 1) ss += __shfl_xor(ss, o);
            const float rstd = rsqrtf(ss * (1.0f / D) + EPS);
#pragma unroll
            for (int j = 0; j < 8; ++j) {
                const int d = lane * 4 + 256 * j;
                const float y0 = xv[j].x * rstd * Av[j].x + Bv[j].x, y1 = xv[j].y * rstd * Av[j].y + Bv[j].y, y2 = xv[j].z * rstd * Av[j].z + Bv[j].z, y3 = xv[j].w * rstd * Av[j].w + Bv[j].w;
                if (MODE == 2) *(float4*)(p.out + (size_t)t * D + d) = make_float4(y0, y1, y2, y3);
                else { u32x2 hv; hv.x = pk_bf16(y0, y1); hv.y = pk_bf16(y2, y3); *(u32x2*)(H + (size_t)t * D + d) = hv; }
                if (MODE == 1) { u32x2 xo; xo.x = pk_bf16(xv[j].x, xv[j].y); xo.y = pk_bf16(xv[j].z, xv[j].w); *(u32x2*)(X + (size_t)t * D + d) = xo; }
            }
        }
    }
}

struct EpiProj {
    static constexpr bool PERM = true, AFTER_DRAIN = false;
    bf16_t* PROJ; float* DT; const float* dt_bias;
    __device__ __forceinline__ void operator()(const pg8::f32x4 (&acc)[2][2][4][2], const pg8::Unit& u, int wr, int wc, int fr, int fq) const {
        const int row0 = u.pm * 256 + wr * 64 + fr;
        if (u.pn < 18) {
            const int col0 = u.pn * 256 + wc * 32 + 8 * fq;
            const bool act = u.pn < 8;
#pragma unroll
            for (int ai = 0; ai < 2; ++ai)
#pragma unroll
                for (int m = 0; m < 4; ++m) {
                    bf16_t* rowp = PROJ + (size_t)(row0 + ai * 128 + m * 16) * NPJ + col0;
#pragma unroll
                    for (int bj = 0; bj < 2; ++bj) {
                        pg8::f32x4 v0 = acc[ai][bj][m][0], v1 = acc[ai][bj][m][1];
                        if (act) {
                            const pg8::f32x2 a = pg8::gelu_pk((pg8::f32x2){v0[0], v0[1]}), b2 = pg8::gelu_pk((pg8::f32x2){v0[2], v0[3]}), c2 = pg8::gelu_pk((pg8::f32x2){v1[0], v1[1]}), d2 = pg8::gelu_pk((pg8::f32x2){v1[2], v1[3]});
                            v0 = (pg8::f32x4){a.x, a.y, b2.x, b2.y}; v1 = (pg8::f32x4){c2.x, c2.y, d2.x, d2.y};
                        }
                        pg8::u32x4 w; w.x = cvt_pk_bf16(v0[0], v0[1]); w.y = cvt_pk_bf16(v0[2], v0[3]); w.z = cvt_pk_bf16(v1[0], v1[1]); w.w = cvt_pk_bf16(v1[2], v1[3]);
                        *(pg8::u32x4*)(rowp + bj * 128) = w;
                    }
                }
        } else if (wc == 0 && fq < 2) {
            float db[2][4];
#pragma unroll
            for (int n = 0; n < 2; ++n)
#pragma unroll
                for (int k = 0; k < 4; ++k) db[n][k] = dt_bias[8 * fq + 4 * n + k];
#pragma unroll
            for (int ai = 0; ai < 2; ++ai)
#pragma unroll
                for (int m = 0; m < 4; ++m) {
                    const int row = row0 + ai * 128 + m * 16;
#pragma unroll
                    for (int n = 0; n < 2; ++n) {
                        const int c0 = 8 * fq + 4 * n;
                        const pg8::f32x4 v = acc[ai][0][m][n];
                        float4 o; o.x = softplus_f(v[0] + db[n][0]); o.y = softplus_f(v[1] + db[n][1]); o.z = softplus_f(v[2] + db[n][2]); o.w = softplus_f(v[3] + db[n][3]);
                        *(float4*)(DT + (size_t)row * SH + c0) = o;
                    }
                }
        }
    }
};
template <bool F32R>
struct EpiRes {
    static constexpr bool PERM = true, AFTER_DRAIN = false;
    const float* R32; bf16_t* Xout; const float* gate;
    __device__ __forceinline__ void operator()(const pg8::f32x4 (&acc)[2][2][4][2], const pg8::Unit& u, int wr, int wc, int fr, int fq) const {
        const int row0 = u.pm * 256 + wr * 64 + fr, col0 = u.pn * 256 + wc * 32 + 8 * fq;
        const int b = (u.pm * 256) / S;
        pg8::f32x4 gv[2][2];
#pragma unroll
        for (int bj = 0; bj < 2; ++bj)
#pragma unroll
            for (int n = 0; n < 2; ++n) gv[bj][n] = *(const pg8::f32x4*)(gate + (size_t)b * 6 * D + col0 + bj * 128 + 4 * n);
#pragma unroll
        for (int ai = 0; ai < 2; ++ai) {
            pg8::f32x4 rf[F32R ? 16 : 1]; pg8::u32x4 rb[F32R ? 1 : 8];
#pragma unroll
            for (int m = 0; m < 4; ++m)
#pragma unroll
                for (int bj = 0; bj < 2; ++bj) {
                    const size_t ro = (size_t)(row0 + ai * 128 + m * 16) * D + col0 + bj * 128;
                    if constexpr (F32R) { rf[(m * 2 + bj) * 2] = *(const pg8::f32x4*)(R32 + ro); rf[(m * 2 + bj) * 2 + 1] = *(const pg8::f32x4*)(R32 + ro + 4); }
                    else rb[m * 2 + bj] = *(const pg8::u32x4*)(Xout + ro);
                }
#pragma unroll
            for (int m = 0; m < 4; ++m)
#pragma unroll
                for (int bj = 0; bj < 2; ++bj) {
                    const size_t ro = (size_t)(row0 + ai * 128 + m * 16) * D + col0 + bj * 128;
                    pg8::f32x4 r0, r1;
                    if constexpr (F32R) { r0 = rf[(m * 2 + bj) * 2]; r1 = rf[(m * 2 + bj) * 2 + 1]; }
                    else { const pg8::u32x4 q = rb[m * 2 + bj];
                           r0 = (pg8::f32x4){bf_lo(q.x), bf_hi(q.x), bf_lo(q.y), bf_hi(q.y)}; r1 = (pg8::f32x4){bf_lo(q.z), bf_hi(q.z), bf_lo(q.w), bf_hi(q.w)}; }
                    const pg8::f32x4 v0 = r0 + gv[bj][0] * acc[ai][bj][m][0], v1 = r1 + gv[bj][1] * acc[ai][bj][m][1];
                    pg8::u32x4 w; w.x = cvt_pk_bf16(v0[0], v0[1]); w.y = cvt_pk_bf16(v0[2], v0[3]); w.z = cvt_pk_bf16(v1[0], v1[1]); w.w = cvt_pk_bf16(v1[2], v1[3]);
                    *(pg8::u32x4*)(Xout + ro) = w;
                }
        }
    }
};
}

namespace mk {
#define MFMA16(a, b, c) __builtin_amdgcn_mfma_f32_16x16x32_bf16((a), (b), (c), 0, 0, 0)
constexpr int SP = 272;

struct ConvW { float w[4][8]; float b[8]; };
__device__ __forceinline__ void load_convw(ConvW& cw, const float* __restrict__ conv_w, const float* __restrict__ conv_b, int chx) {
#pragma unroll
    for (int k = 0; k < 4; ++k) {
        const float4 a = *(const float4*)(conv_w + k * CONVD + chx), b2 = *(const float4*)(conv_w + k * CONVD + chx + 4);
        cw.w[k][0] = a.x; cw.w[k][1] = a.y; cw.w[k][2] = a.z; cw.w[k][3] = a.w; cw.w[k][4] = b2.x; cw.w[k][5] = b2.y; cw.w[k][6] = b2.z; cw.w[k][7] = b2.w;
    }
    const float4 a = *(const float4*)(conv_b + chx), b2 = *(const float4*)(conv_b + chx + 4);
    cw.b[0] = a.x; cw.b[1] = a.y; cw.b[2] = a.z; cw.b[3] = a.w; cw.b[4] = b2.x; cw.b[5] = b2.y; cw.b[6] = b2.z; cw.b[7] = b2.w;
}
__device__ __forceinline__ u32x4 ld_raw(const bf16_t* __restrict__ PROJ, int tg, int tl, int pcol) {
    u32x4 z; z.x = z.y = z.z = z.w = 0u;
    if (tl >= 0) z = *(const u32x4*)(PROJ + (size_t)tg * NPJ + pcol);
    return z;
}
__device__ __forceinline__ void conv8(const ConvW& cw, const u32x4& r0, const u32x4& r1, const u32x4& r2, const u32x4& r3, float (&o)[8]) {
#pragma unroll
    for (int j = 0; j < 8; ++j) o[j] = cw.b[j];
    const u32x4 rr[4] = {r0, r1, r2, r3};
#pragma unroll
    for (int k = 0; k < 4; ++k) {
        const float x[8] = {bf_lo(rr[k].x), bf_hi(rr[k].x), bf_lo(rr[k].y), bf_hi(rr[k].y), bf_lo(rr[k].z), bf_hi(rr[k].z), bf_lo(rr[k].w), bf_hi(rr[k].w)};
#pragma unroll
        for (int j = 0; j < 8; ++j) o[j] += cw.w[k][j] * x[j];
    }
#pragma unroll
    for (int j = 0; j < 8; ++j) o[j] = silu_f(o[j]);
}
__device__ __forceinline__ u32x4 pack8(const float (&o)[8]) { u32x4 v; v.x = pk_bf16(o[0], o[1]); v.y = pk_bf16(o[2], o[3]); v.z = pk_bf16(o[4], o[5]); v.w = pk_bf16(o[6], o[7]); return v; }

__device__ __forceinline__ void ssd_unit(const Params& p, ldsp_t lds, int l, int u) {
    const int tid = threadIdx.x, lane = tid & 63, wid = __builtin_amdgcn_readfirstlane(tid >> 6), fr = lane & 15, fq = lane >> 4;
    const int hs = u & 1, g = (u >> 1) & 1, bc = u >> 2, b = bc / NC, c = bc % NC;
    const int tg0 = bc * CH, tl0 = c * CH;
    const bf16_t* PROJ = (const bf16_t*)(p.ws + WS_PROJ);
    const float* DT = (const float*)(p.ws + WS_DT);
    float* ACS = (float*)(p.ws + WS_ACS);
    bf16_t* YD = (bf16_t*)(p.ws + WS_YD);
    bf16_t* STATES = (bf16_t*)(p.ws + WS_STATES);
    const float* conv_w = p.in[10] + (size_t)l * 4 * CONVD; const float* conv_b = p.in[11] + l * CONVD;
    ldsp_t R1 = lds, R2 = lds + 34816, R3 = lds + 69632, R4 = lds + 104448;
    LAS float* acsS = (LAS float*)(lds + 122880); LAS float* dtS = (LAS float*)(lds + 122880 + 2048);
    LAS float* cwS = (LAS float*)(lds + 122880 + 4096);
    for (int i = tid; i < 1284; i += NT) {
        float v;
        if (i < 1280) { const int hq = i / 320, rem = i - hq * 320, k = rem >> 6, ch = (g * 8 + hs * 4 + hq) * SHD + (rem & 63); v = (k < 4) ? conv_w[k * CONVD + ch] : conv_b[ch]; }
        else v = p.in[14][l * SH + g * 8 + hs * 4 + (i - 1280)];
        cwS[i] = v;
    }
    (void)b;
    {
        const int o = tid & 31, lg = tid >> 5, l0 = lg * 8, is_c = o >> 4, nn = (o & 15) * 8;
        const int chx = 1024 + is_c * 256 + g * SN + nn, pcol = 3072 + chx;
        ConvW cw; load_convw(cw, conv_w, conv_b, chx);
        u32x4 raw[11];
#pragma unroll
        for (int r = 0; r < 11; ++r) raw[r] = ld_raw(PROJ, tg0 + l0 + r - 3, tl0 + l0 + r - 3, pcol);
#pragma unroll
        for (int hq = 0; hq < 2; ++hq) {
            unsigned tq[8][2];
#pragma unroll
            for (int mm = 0; mm < 2; ++mm) {
                const int m = 2 * hq + mm;
                float ova[8], ovb[8];
                conv8(cw, raw[2 * m], raw[2 * m + 1], raw[2 * m + 2], raw[2 * m + 3], ova);
                conv8(cw, raw[2 * m + 1], raw[2 * m + 2], raw[2 * m + 3], raw[2 * m + 4], ovb);
                *(LAS u32x4*)((is_c ? R1 : R2) + (l0 + 2 * m) * SP + nn * 2) = pack8(ova);
                *(LAS u32x4*)((is_c ? R1 : R2) + (l0 + 2 * m + 1) * SP + nn * 2) = pack8(ovb);
#pragma unroll
                for (int j = 0; j < 8; ++j) tq[j][mm] = pk_bf16(ova[j], ovb[j]);
            }
            if (!is_c) {
#pragma unroll
                for (int j = 0; j < 8; ++j) { u32x2 t2; t2.x = tq[j][0]; t2.y = tq[j][1]; *(LAS u32x2*)(R3 + (nn + j) * SP + ((lg ^ (o & 7)) * 16) + hq * 8) = t2; }
            }
        }
    }
    if (wid < 4) {
        const int h = g * 8 + hs * 4 + wid, l2 = lane * 2;
        const float a = -__expf(p.in[13][l * SH + h]);
        const float dt0 = DT[(size_t)(tg0 + l2) * SH + h], dt1 = DT[(size_t)(tg0 + l2 + 1) * SH + h];
        const float ad0 = dt0 * a, ad1 = dt1 * a, s = ad0 + ad1;
        float incl = s;
#pragma unroll
        for (int o = 1; o < 64; o <<= 1) { const float n = __shfl_up(incl, o); if (lane >= o) incl += n; }
        const float excl = incl - s;
        acsS[wid * 128 + l2] = excl + ad0; acsS[wid * 128 + l2 + 1] = incl;
        dtS[wid * 128 + l2] = dt0; dtS[wid * 128 + l2 + 1] = dt1;
        ACS[(size_t)(tg0 + l2) * SH + h] = excl + ad0; ACS[(size_t)(tg0 + l2 + 1) * SH + h] = incl;
    }
    __syncthreads();
    f32x4 CB[8];
#pragma unroll
    for (int nt = 0; nt < 8; ++nt) CB[nt] = (f32x4){0.f, 0.f, 0.f, 0.f};
#pragma unroll
    for (int ks = 0; ks < 4; ++ks) {
        const bf16x8 af = *(const LAS bf16x8*)(R1 + (16 * wid + fr) * SP + (32 * ks + 8 * fq) * 2);
#pragma unroll
        for (int nt = 0; nt < 8; ++nt) if (nt <= wid) {
            const bf16x8 bfr = *(const LAS bf16x8*)(R2 + (16 * nt + fr) * SP + (32 * ks + 8 * fq) * 2);
            CB[nt] = MFMA16(bfr, af, CB[nt]);
        }
    }
    __syncthreads();
    const float dsk_base = 0.f; (void)dsk_base;
    u32x4 raw[5];
    {
        const int o = tid & 7, l0 = (tid >> 3) * 2, pcol = 3072 + (g * 8 + hs * 4) * SHD + o * 8;
#pragma unroll
        for (int r = 0; r < 5; ++r) raw[r] = ld_raw(PROJ, tg0 + l0 + r - 3, tl0 + l0 + r - 3, pcol);
    }
#pragma unroll 1
    for (int hl = 0; hl < 4; ++hl) {
        const int h = g * 8 + hs * 4 + hl;
        {
            const int o = tid & 7, lg = tid >> 3, l0 = lg * 2;
            ConvW cw;
#pragma unroll
            for (int k = 0; k < 4; ++k) {
                const f32x4 a = *(const LAS f32x4*)(cwS + hl * 320 + k * 64 + o * 8), b2 = *(const LAS f32x4*)(cwS + hl * 320 + k * 64 + o * 8 + 4);
                cw.w[k][0] = a[0]; cw.w[k][1] = a[1]; cw.w[k][2] = a[2]; cw.w[k][3] = a[3]; cw.w[k][4] = b2[0]; cw.w[k][5] = b2[1]; cw.w[k][6] = b2[2]; cw.w[k][7] = b2[3];
            }
            { const f32x4 a = *(const LAS f32x4*)(cwS + hl * 320 + 256 + o * 8), b2 = *(const LAS f32x4*)(cwS + hl * 320 + 256 + o * 8 + 4);
              cw.b[0] = a[0]; cw.b[1] = a[1]; cw.b[2] = a[2]; cw.b[3] = a[3]; cw.b[4] = b2[0]; cw.b[5] = b2[1]; cw.b[6] = b2[2]; cw.b[7] = b2[3]; }
            const float alast = acsS[hl * 128 + 127];
            float ov0[8], ov1[8];
            conv8(cw, raw[0], raw[1], raw[2], raw[3], ov0); conv8(cw, raw[1], raw[2], raw[3], raw[4], ov1);
            *(LAS u32x4*)(R4 + l0 * 144 + o * 16) = pack8(ov0);
            *(LAS u32x4*)(R4 + (l0 + 1) * 144 + o * 16) = pack8(ov1);
            const float dt0 = dtS[hl * 128 + l0], dt1 = dtS[hl * 128 + l0 + 1];
            const float e0 = __expf(alast - acsS[hl * 128 + l0]), e1 = __expf(alast - acsS[hl * 128 + l0 + 1]);
            const unsigned cw4 = (unsigned)((lg ^ (o << 3)) * 4);
#pragma unroll
            for (int j = 0; j < 8; ++j) {
                const float xa = ov0[j] * dt0, xb = ov1[j] * dt1;
                *(LAS unsigned*)(R2 + (o * 8 + j) * SP + cw4) = pk_bf16(xa, xb);
                *(LAS unsigned*)(R2 + 17408 + (o * 8 + j) * SP + cw4) = pk_bf16(xa * e0, xb * e1);
            }
        }
        if (hl < 3) {
            const int o = tid & 7, l0 = (tid >> 3) * 2, pcol = 3072 + (h + 1) * SHD + o * 8;
#pragma unroll
            for (int r = 0; r < 5; ++r) raw[r] = ld_raw(PROJ, tg0 + l0 + r - 3, tl0 + l0 + r - 3, pcol);
        }
        {
            const int lrow = 16 * wid + fr;
            const float al = acsS[hl * 128 + lrow];
#pragma unroll
            for (int nt = 0; nt < 8; ++nt) {
                if (nt <= wid) {
                    const f32x4 as = *(const LAS f32x4*)(acsS + hl * 128 + 16 * nt + 4 * fq);
                    float v[4];
#pragma unroll
                    for (int r = 0; r < 4; ++r) { const float e = __expf(al - as[r]); const bool keep = (nt < wid) || (4 * fq + r <= fr); v[r] = keep ? CB[nt][r] * e : 0.f; }
                    u32x2 w2; w2.x = pk_bf16(v[0], v[1]); w2.y = pk_bf16(v[2], v[3]);
                    *(LAS u32x2*)(R1 + lrow * SP + (16 * nt + 4 * fq) * 2) = w2;
                } else if (nt == wid + 1 && !(wid & 1)) {
                    u32x2 w2; w2.x = 0u; w2.y = 0u;
                    *(LAS u32x2*)(R1 + lrow * SP + (16 * nt + 4 * fq) * 2) = w2;
                }
            }
        }
        __syncthreads();
        {
            f32x4 acc[4];
#pragma unroll
            for (int nt = 0; nt < 4; ++nt) acc[nt] = (f32x4){0.f, 0.f, 0.f, 0.f};
#pragma unroll
            for (int ks = 0; ks < 4; ++ks) if (ks <= (wid >> 1)) {
                const bf16x8 af = *(const LAS bf16x8*)(R1 + (16 * wid + fr) * SP + (32 * ks + 8 * fq) * 2);
#pragma unroll
                for (int nt = 0; nt < 4; ++nt) {
                    const bf16x8 bfr = *(const LAS bf16x8*)(R2 + (16 * nt + fr) * SP + (((4 * ks + fq) ^ (2 * (2 * nt + (fr >> 3)))) * 16));
                    acc[nt] = MFMA16(bfr, af, acc[nt]);
                }
            }
            const int lrow = 16 * wid + fr;
            const float dsk = cwS[1280 + hl];
#pragma unroll
            for (int nt = 0; nt < 4; ++nt) {
                const int p0 = 16 * nt + 4 * fq;
                const u32x2 xs2 = *(const LAS u32x2*)(R4 + lrow * 144 + p0 * 2);
                u32x2 o2; o2.x = pk_bf16(acc[nt][0] + dsk * bf_lo(xs2.x), acc[nt][1] + dsk * bf_hi(xs2.x)); o2.y = pk_bf16(acc[nt][2] + dsk * bf_lo(xs2.y), acc[nt][3] + dsk * bf_hi(xs2.y));
                *(u32x2*)(YD + (size_t)(tg0 + lrow) * SW + h * SHD + p0) = o2;
            }
        }
        {
            f32x4 acc[4];
#pragma unroll
            for (int j = 0; j < 4; ++j) acc[j] = (f32x4){0.f, 0.f, 0.f, 0.f};
            const int mp = wid & 3, nb = 4 * (wid >> 2);
#pragma unroll
            for (int ks = 0; ks < 4; ++ks) {
                const bf16x8 af = *(const LAS bf16x8*)(R2 + 17408 + (16 * mp + fr) * SP + (((4 * ks + fq) ^ (2 * (2 * mp + (fr >> 3)))) * 16));
#pragma unroll
                for (int j = 0; j < 4; ++j) {
                    const bf16x8 bfr = *(const LAS bf16x8*)(R3 + (16 * (nb + j) + fr) * SP + (((4 * ks + fq) ^ ((2 * (nb + j) + (fr >> 3)) & 7)) * 16));
                    acc[j] = MFMA16(bfr, af, acc[j]);
                }
            }
            bf16_t* sp = STATES + (((size_t)bc * SH + h) * SHD + 16 * mp + fr) * SN;
#pragma unroll
            for (int j = 0; j < 4; ++j) { u32x2 o2; o2.x = pk_bf16(acc[j][0], acc[j][1]); o2.y = pk_bf16(acc[j][2], acc[j][3]); *(u32x2*)(sp + 16 * (nb + j) + 4 * fq) = o2; }
        }
        __syncthreads();
    }
}

__device__ __forceinline__ void gmlp_unit(const Params& p, ldsp_t lds, int l, int u) {
    const int tid = threadIdx.x, lane = tid & 63, wid = __builtin_amdgcn_readfirstlane(tid >> 6), fr = lane & 15, fq = lane >> 4;
    const int hh = u & 7, bc = u >> 3, tg0 = bc * CH;
    const bf16_t* PROJ = (const bf16_t*)(p.ws + WS_PROJ);
    bf16_t* YMIX = (bf16_t*)(p.ws + WS_YMIX);
    ldsp_t A = lds, VT = lds + 34816;
    {
        const bf16_t* wsb = (const bf16_t*)(p.ws + WS_WSB) + ((size_t)(l * GH + hh) * 128) * 128;
#pragma unroll
        for (int i = 0; i < 4; ++i) { const int q = tid + NT * i, row = q >> 4, pc = q & 15; *(LAS u32x4*)(A + row * SP + pc * 16) = *(const u32x4*)(wsb + row * 128 + pc * 8); }
    }
    {
        const int s = tid >> 2, q4 = tid & 3;
        const bf16_t* src = PROJ + (size_t)(tg0 + s) * NPJ + 1024 + hh * 128 + q4 * 32;
        float gv[32];
#pragma unroll
        for (int i = 0; i < 4; ++i) { const u32x4 v = *(const u32x4*)(src + i * 8);
            gv[i * 8 + 0] = bf_lo(v.x); gv[i * 8 + 1] = bf_hi(v.x); gv[i * 8 + 2] = bf_lo(v.y); gv[i * 8 + 3] = bf_hi(v.y); gv[i * 8 + 4] = bf_lo(v.z); gv[i * 8 + 5] = bf_hi(v.z); gv[i * 8 + 6] = bf_lo(v.w); gv[i * 8 + 7] = bf_hi(v.w); }
        float sm = 0.f;
#pragma unroll
        for (int i = 0; i < 32; ++i) sm += gv[i];
        sm += __shfl_xor(sm, 1); sm += __shfl_xor(sm, 2);
        const float mu = sm * (1.0f / 128.0f);
        float q = 0.f;
#pragma unroll
        for (int i = 0; i < 32; ++i) { const float d = gv[i] - mu; q += d * d; }
        q += __shfl_xor(q, 1); q += __shfl_xor(q, 2);
        const float rstd = rsqrtf(q * (1.0f / 128.0f) + EPS);
        const float* lw = p.in[6] + l * 1024 + hh * 128 + q4 * 32; const float* lb = p.in[7] + l * 1024 + hh * 128 + q4 * 32;
#pragma unroll
        for (int i = 0; i < 32; ++i) *(LAS bf16_t*)(VT + (q4 * 32 + i) * SP + s * 2) = f2bf((gv[i] - mu) * rstd * lw[i] + lb[i]);
    }
    __syncthreads();
    f32x4 acc[8];
#pragma unroll
    for (int nt = 0; nt < 8; ++nt) acc[nt] = (f32x4){0.f, 0.f, 0.f, 0.f};
#pragma unroll
    for (int ks = 0; ks < 4; ++ks) if (ks <= (wid >> 1)) {
        const bf16x8 af = *(const LAS bf16x8*)(A + (16 * wid + fr) * SP + (32 * ks + 8 * fq) * 2);
#pragma unroll
        for (int nt = 0; nt < 8; ++nt) {
            const bf16x8 bfr = *(const LAS bf16x8*)(VT + (16 * nt + fr) * SP + (32 * ks + 8 * fq) * 2);
            acc[nt] = MFMA16(bfr, af, acc[nt]);
        }
    }
    {
        const int trow = 16 * wid + fr;
        const float bsv = p.in[9][l * 1024 + hh * 128 + trow];
        u32x2 uu[8];
#pragma unroll
        for (int nt = 0; nt < 8; ++nt) uu[nt] = *(const u32x2*)(PROJ + (size_t)(tg0 + trow) * NPJ + hh * 128 + 16 * nt + 4 * fq);
#pragma unroll
        for (int nt = 0; nt < 8; ++nt) {
            const int p0 = 16 * nt + 4 * fq;
            const u32x2 u2 = uu[nt];
            u32x2 o2; o2.x = pk_bf16(bf_lo(u2.x) * (acc[nt][0] + bsv), bf_hi(u2.x) * (acc[nt][1] + bsv)); o2.y = pk_bf16(bf_lo(u2.y) * (acc[nt][2] + bsv), bf_hi(u2.y) * (acc[nt][3] + bsv));
            *(u32x2*)(YMIX + (size_t)(tg0 + trow) * D + hh * 128 + p0) = o2;
        }
    }
    __syncthreads();
}

template <class ZF>
__device__ __forceinline__ void phase_mix(const Params& p, ldsp_t lds, int l, const ZF& zgemm) {
    const int b = (int)blockIdx.x, G = (int)gridDim.x;
    if (G == 256) {
        if (b < 96) {
            zgemm(32 + b);
            __syncthreads();
            for (int i = 0; i < 2; ++i) gmlp_unit(p, lds, l, 2 * b + i);
        } else {
            const int c = b - 96;
            int s0, ns, g0, ng;
            if (c < 96) { s0 = 2 * c; ns = 2; g0 = 192 + c; ng = 1; }
            else        { s0 = 96 + c; ns = 1; g0 = 288 + 4 * (c - 96); ng = (c - 96 < 56) ? 4 : 0; }
#pragma unroll 1
            for (int i = 0; i < ns; ++i) ssd_unit(p, lds, l, s0 + i);
#pragma unroll 1
            for (int i = 0; i < ng; ++i) gmlp_unit(p, lds, l, g0 + i);
        }
    } else {
        for (int u = 32 + b; u < 128; u += G) { zgemm(u); __syncthreads(); }
        for (int u = b; u < 768; u += G) { if (u < 256) ssd_unit(p, lds, l, u); else gmlp_unit(p, lds, l, u - 256); }
    }
}

__device__ __forceinline__ void phase_scan(const Params& p) {
    const bf16_t* STATES = (const bf16_t*)(p.ws + WS_STATES); const float* ACS = (const float*)(p.ws + WS_ACS);
    bf16_t* PREV = (bf16_t*)(p.ws + WS_PREV);
    for (int idx = blockIdx.x * NT + threadIdx.x; idx < NB * SH * SHD * SN / 4; idx += gridDim.x * NT) {
        const int n4 = idx & 31, pp = (idx >> 5) & 63, h = (idx >> 11) & 15, b = idx >> 15;
        float4 st[NC]; float dec[NC];
#pragma unroll
        for (int c = 0; c < NC; ++c) {
            { const u32x2 sb = *(const u32x2*)(STATES + ((((size_t)(b * NC + c)) * SH + h) * SHD + pp) * SN + n4 * 4); st[c] = make_float4(bf_lo(sb.x), bf_hi(sb.x), bf_lo(sb.y), bf_hi(sb.y)); }
            dec[c] = ACS[((size_t)(b * NC + c) * CH + CH - 1) * SH + h];
        }
        float4 carry = make_float4(0.f, 0.f, 0.f, 0.f);
#pragma unroll
        for (int c = 0; c < NC; ++c) {
            u32x2 o; o.x = pk_bf16(carry.x, carry.y); o.y = pk_bf16(carry.z, carry.w);
            *(u32x2*)(PREV + ((((size_t)(b * NC + c)) * SH + h) * SHD + pp) * SN + n4 * 4) = o;
            const float d = __expf(dec[c]);
            carry.x = carry.x * d + st[c].x; carry.y = carry.y * d + st[c].y; carry.z = carry.z * d + st[c].z; carry.w = carry.w * d + st[c].w;
        }
    }
}

__device__ __forceinline__ void phase_yoff(const Params& p, ldsp_t lds, int l) {
    const int tid = threadIdx.x, lane = tid & 63, wid = __builtin_amdgcn_readfirstlane(tid >> 6), fr = lane & 15, fq = lane >> 4;
    const bf16_t* PROJ = (const bf16_t*)(p.ws + WS_PROJ); const float* ACS = (const float*)(p.ws + WS_ACS);
    const bf16_t* YD = (const bf16_t*)(p.ws + WS_YD); const bf16_t* PREV = (const bf16_t*)(p.ws + WS_PREV);
    bf16_t* YMIX = (bf16_t*)(p.ws + WS_YMIX);
    const float* conv_w = p.in[10] + (size_t)l * 4 * CONVD; const float* conv_b = p.in[11] + l * CONVD;
    ldsp_t CmS = lds; LAS float* red = (LAS float*)(lds + 52224);
    for (int u = blockIdx.x; u < 256; u += gridDim.x) {
        const int g = u & 1, tb = (u >> 1) & 31, b = u >> 6;
        const int tl0 = tb * 64, tg0 = b * S + tl0, bc = b * NC + (tb >> 1);
        {
            const int o = tid & 15, lg = tid >> 4, l0 = lg * 2, chx = 1280 + g * SN + o * 8, pcol = 3072 + chx;
            ConvW cw; load_convw(cw, conv_w, conv_b, chx);
            u32x4 raw[5];
#pragma unroll
            for (int r = 0; r < 5; ++r) raw[r] = ld_raw(PROJ, tg0 + l0 + r - 3, tl0 + l0 + r - 3, pcol);
#pragma unroll
            for (int i = 0; i < 2; ++i) { float ov[8]; conv8(cw, raw[i], raw[i + 1], raw[i + 2], raw[i + 3], ov); *(LAS u32x4*)(CmS + (l0 + i) * SP + o * 16) = pack8(ov); }
        }
        const int mt = wid & 3, ntb = 2 * (wid >> 2);
        const int trow = tg0 + 16 * mt + fr;
        f32x4 gval[8][2]; float ssq = 0.f;
        u32x4 pvr[2];
        {
            const bf16_t* src = PREV + (((size_t)bc * SH + g * 8) * SHD) * SN;
#pragma unroll
            for (int i = 0; i < 2; ++i) { const int q = tid + NT * i; pvr[i] = *(const u32x4*)(src + (q >> 4) * 128 + (q & 15) * 8); }
        }
#pragma unroll
        for (int hl = 0; hl < 8; ++hl) {
            const int h = g * 8 + hl;
            ldsp_t Pv = lds + 17408 + (hl & 1) * 17408;
#pragma unroll
            for (int i = 0; i < 2; ++i) { const int q = tid + NT * i; *(LAS u32x4*)(Pv + (q >> 4) * SP + (q & 15) * 16) = pvr[i]; }
            if (hl < 7) {
                const bf16_t* src = PREV + (((size_t)bc * SH + h + 1) * SHD) * SN;
#pragma unroll
                for (int i = 0; i < 2; ++i) { const int q = tid + NT * i; pvr[i] = *(const u32x4*)(src + (q >> 4) * 128 + (q & 15) * 8); }
            }
            __syncthreads();
            f32x4 acc[2] = {(f32x4){0.f, 0.f, 0.f, 0.f}, (f32x4){0.f, 0.f, 0.f, 0.f}};
#pragma unroll
            for (int ks = 0; ks < 4; ++ks) {
                const bf16x8 af = *(const LAS bf16x8*)(CmS + (16 * mt + fr) * SP + (32 * ks + 8 * fq) * 2);
#pragma unroll
                for (int j = 0; j < 2; ++j) {
                    const bf16x8 bfr = *(const LAS bf16x8*)(Pv + (16 * (ntb + j) + fr) * SP + (32 * ks + 8 * fq) * 2);
                    acc[j] = MFMA16(bfr, af, acc[j]);
                }
            }
            const float ea = __expf(ACS[(size_t)trow * SH + h]);
#pragma unroll
            for (int j = 0; j < 2; ++j) {
                const int p0 = 16 * (ntb + j) + 4 * fq;
                const u32x2 yd = *(const u32x2*)(YD + (size_t)trow * SW + h * SHD + p0);
                const u32x2 zz = *(const u32x2*)(PROJ + (size_t)trow * NPJ + 2048 + h * SHD + p0);
                f32x4 gv;
                gv[0] = (bf_lo(yd.x) + ea * acc[j][0]) * silu_f(bf_lo(zz.x)); gv[1] = (bf_hi(yd.x) + ea * acc[j][1]) * silu_f(bf_hi(zz.x));
                gv[2] = (bf_lo(yd.y) + ea * acc[j][2]) * silu_f(bf_lo(zz.y)); gv[3] = (bf_hi(yd.y) + ea * acc[j][3]) * silu_f(bf_hi(zz.y));
                gval[hl][j] = gv;
                ssq += gv[0] * gv[0] + gv[1] * gv[1] + gv[2] * gv[2] + gv[3] * gv[3];
            }
        }
        ssq += __shfl_xor(ssq, 16); ssq += __shfl_xor(ssq, 32);
        if (fq == 0) red[(wid >> 2) * 64 + 16 * mt + fr] = ssq;
        __syncthreads();
        const float tot = red[16 * mt + fr] + red[64 + 16 * mt + fr];
        const float rstd = rsqrtf(tot * (1.0f / 512.0f) + EPS);
        const float* nw = p.in[15] + l * SW;
#pragma unroll
        for (int hl = 0; hl < 8; ++hl) {
            const int h = g * 8 + hl;
#pragma unroll
            for (int j = 0; j < 2; ++j) {
                const int p0 = 16 * (ntb + j) + 4 * fq;
                const float4 w4 = *(const float4*)(nw + h * SHD + p0);
                u32x2 o2; o2.x = pk_bf16(gval[hl][j][0] * rstd * w4.x, gval[hl][j][1] * rstd * w4.y); o2.y = pk_bf16(gval[hl][j][2] * rstd * w4.z, gval[hl][j][3] * rstd * w4.w);
                *(u32x2*)(YMIX + (size_t)trow * D + 1024 + h * SHD + p0) = o2;
            }
        }
        __syncthreads();
    }
}
}

namespace mk {
#define MFMA32(a, b, c) __builtin_amdgcn_mfma_f32_32x32x16_bf16((a), (b), (c), 0, 0, 0)
constexpr int HLP = 4112;
__device__ __forceinline__ void phase_router(const Params& p, ldsp_t lds, int l, bool dummy = false) {
    const int tid = threadIdx.x, lane = tid & 63, wid = __builtin_amdgcn_readfirstlane(tid >> 6), fr = lane & 15, fq = lane >> 4, G = gridDim.x;
    const float* ADA = (const float*)(p.ws + WS_ADA); const bf16_t* X = (const bf16_t*)(p.ws + WS_X);
    bf16_t* H = (bf16_t*)(p.ws + WS_H);
    const bf16_t* RWH = (const bf16_t*)(p.ws + WS_RWH); const bf16_t* RWL = (const bf16_t*)(p.ws + WS_RWL);
    int* CNT = (int*)(p.ws + WS_CTL + CTL_CNT) + l * NE; int* LIST = (int*)(p.ws + WS_LIST); float* GW = (float*)(p.ws + WS_GW);
    if (dummy) { CNT += 4 * NE; LIST = (int*)(p.ws + WS_END); GW = (float*)(p.ws + WS_END + (size_t)NE * T * 4); }
    LAS float* LG = (LAS float*)(lds + 32 * HLP);
    LAS int* lcnt = (LAS int*)(lds + 32 * HLP + 8192);
    LAS int* lbase = lcnt + 64;
    LAS int* sinfo = lcnt + 128;
    const float* rbias = p.in[19];
    if (tid < 64) lcnt[tid] = 0;
    for (int rb = blockIdx.x; rb < T / 32; rb += G) {
        const int b = (rb * 32) / S;
        float4 Av[8], Bv[8];
#pragma unroll
        for (int j = 0; j < 8; ++j) {
            const int d = lane * 4 + 256 * j;
            const float4 nw = *(const float4*)(p.in[17] + l * D + d);
            const float4 sh = *(const float4*)(ADA + ((size_t)l * NB + b) * 6 * D + 3 * D + d);
            const float4 s2 = *(const float4*)(ADA + ((size_t)l * NB + b) * 6 * D + 4 * D + d);
            Av[j] = make_float4(nw.x * (1.f + s2.x), nw.y * (1.f + s2.y), nw.z * (1.f + s2.z), nw.w * (1.f + s2.w)); Bv[j] = sh;
        }
#pragma unroll 1
        for (int half = 0; half < 2; ++half) {
#pragma unroll
            for (int rr = 0; rr < 2; ++rr) {
                const int row = wid * 2 + rr, t = rb * 32 + half * 16 + row;
                float4 xv[8]; float ss = 0.f;
#pragma unroll
                for (int j = 0; j < 8; ++j) { const u32x2 xb = *(const u32x2*)(X + (size_t)t * D + lane * 4 + 256 * j); xv[j] = make_float4(bf_lo(xb.x), bf_hi(xb.x), bf_lo(xb.y), bf_hi(xb.y)); ss += xv[j].x * xv[j].x + xv[j].y * xv[j].y + xv[j].z * xv[j].z + xv[j].w * xv[j].w; }
#pragma unroll
                for (int o = 32; o > 0; o >>= 1) ss += __shfl_xor(ss, o);
                const float rstd = rsqrtf(ss * (1.0f / D) + EPS);
#pragma unroll
                for (int j = 0; j < 8; ++j) {
                    const int d = lane * 4 + 256 * j;
                    const float y0 = xv[j].x * rstd * Av[j].x + Bv[j].x, y1 = xv[j].y * rstd * Av[j].y + Bv[j].y, y2 = xv[j].z * rstd * Av[j].z + Bv[j].z, y3 = xv[j].w * rstd * Av[j].w + Bv[j].w;
                    u32x2 hv; hv.x = pk_bf16(y0, y1); hv.y = pk_bf16(y2, y3);
                    u32x2 lv; lv.x = pk_bf16(y0 - bf_lo(hv.x), y1 - bf_hi(hv.x)); lv.y = pk_bf16(y2 - bf_lo(hv.y), y3 - bf_hi(hv.y));
                    *(LAS u32x2*)(lds + row * HLP + d * 2) = hv;
                    *(LAS u32x2*)(lds + (16 + row) * HLP + d * 2) = lv;
                }
            }
            __syncthreads();
            {
                const int nt = wid & 3, kh = wid >> 2;
                f32x4 acc = (f32x4){0.f, 0.f, 0.f, 0.f};
                const bf16_t* bh = RWH + (size_t)(16 * nt + fr) * D + 8 * fq; const bf16_t* bl = RWL + (size_t)(16 * nt + fr) * D + 8 * fq;
#pragma unroll 8
                for (int ks = 0; ks < 32; ++ks) {
                    const int k0 = (kh * 32 + ks) * 32;
                    const bf16x8 ah = *(const LAS bf16x8*)(lds + fr * HLP + (k0 + 8 * fq) * 2);
                    const bf16x8 alo = *(const LAS bf16x8*)(lds + (16 + fr) * HLP + (k0 + 8 * fq) * 2);
                    const bf16x8 bhv = *(const bf16x8*)(bh + k0); const bf16x8 blv = *(const bf16x8*)(bl + k0);
                    acc = MFMA16(ah, bhv, acc); acc = MFMA16(ah, blv, acc); acc = MFMA16(alo, bhv, acc);
                }
#pragma unroll
                for (int r = 0; r < 4; ++r) LG[(kh * 16 + 4 * fq + r) * 64 + 16 * nt + fr] = acc[r];
            }
            __syncthreads();
#pragma unroll 1
            for (int rr = 0; rr < 2; ++rr) {
                const int row = wid * 2 + rr, t = rb * 32 + half * 16 + row;
                const float lg = LG[row * 64 + lane] + LG[(16 + row) * 64 + lane];
                const float sc = 1.0f / (1.0f + __expf(-lg)), v = sc + rbias[lane];
                float m1 = v; int i1 = lane;
#pragma unroll
                for (int o = 1; o < 8; o <<= 1) { const float ov = __shfl_xor(m1, o); const int oi = __shfl_xor(i1, o); if (ov > m1 || (ov == m1 && oi < i1)) { m1 = ov; i1 = oi; } }
                float m2 = (lane == i1) ? -1e30f : v; int i2 = lane;
#pragma unroll
                for (int o = 1; o < 8; o <<= 1) { const float ov = __shfl_xor(m2, o); const int oi = __shfl_xor(i2, o); if (ov > m2 || (ov == m2 && oi < i2)) { m2 = ov; i2 = oi; } }
                float gs = m1 + m2; int bg = lane >> 3;
#pragma unroll
                for (int o = 8; o < 64; o <<= 1) { const float ov = __shfl_xor(gs, o); const int og = __shfl_xor(bg, o); if (ov > gs || (ov == gs && og < bg)) { gs = ov; bg = og; } }
                const int e1 = __shfl(i1, bg * 8), e2 = __shfl(i2, bg * 8);
                const float u1 = __shfl(sc, e1), u2 = __shfl(sc, e2);
                if (lane == 0) {
                    const float inv = 1.0f / (u1 + u2);
                    GW[t * 2 + 0] = u1 * inv; GW[t * 2 + 1] = u2 * inv;
                    LAS int* si = sinfo + (half * 16 + row) * 4;
                    si[0] = e1; si[1] = __hip_atomic_fetch_add(lcnt + e1, 1, __ATOMIC_RELAXED, __HIP_MEMORY_SCOPE_WORKGROUP); si[2] = e2; si[3] = __hip_atomic_fetch_add(lcnt + e2, 1, __ATOMIC_RELAXED, __HIP_MEMORY_SCOPE_WORKGROUP);
                }
            }
            __syncthreads();
            if (tid < 64) { const int c = lcnt[tid]; lbase[tid] = c ? atomicAdd(&CNT[tid], c) : 0; lcnt[tid] = 0; }
            __syncthreads();
            {
                const int sl = tid >> 4, row = sl >> 1, k = sl & 1, cg = tid & 15;
                const int e = sinfo[(half * 16 + row) * 4 + 2 * k], pos = lbase[e] + sinfo[(half * 16 + row) * 4 + 2 * k + 1];
                if (cg == 0) LIST[e * T + pos] = (rb * 32 + half * 16 + row) * 2 + k;
                if (pos >= SCAP) {
                    const int tk = rb * 32 + half * 16 + row;
                    char* h8 = (char*)(p.ws + WS_H) + (size_t)tk * D;
#pragma unroll
                    for (int cc = 0; cc < 4; ++cc)
#pragma unroll
                        for (int j = 0; j < 4; ++j) {
                            const u32x4 v = *(const LAS u32x4*)(lds + row * HLP + (cg * 4 + cc) * 64 + j * 16);
                            u32x2 o; int t0 = 0, t1 = 0;
                            t0 = __builtin_amdgcn_cvt_pk_fp8_f32(bf_lo(v.x), bf_hi(v.x), t0, false); t0 = __builtin_amdgcn_cvt_pk_fp8_f32(bf_lo(v.y), bf_hi(v.y), t0, true);
                            t1 = __builtin_amdgcn_cvt_pk_fp8_f32(bf_lo(v.z), bf_hi(v.z), t1, false); t1 = __builtin_amdgcn_cvt_pk_fp8_f32(bf_lo(v.w), bf_hi(v.w), t1, true);
                            o.x = (unsigned)t0; o.y = (unsigned)t1;
                            *(u32x2*)(h8 + (cg * 4 + cc) * 32 + j * 8) = o;
                        }
                }
                if (pos < SCAP) {
                    char* hg = (char*)(p.ws + WS_HG);
#pragma unroll
                    for (int cc = 0; cc < 4; ++cc) {
                        const int ck = cg * 4 + cc;
#pragma unroll
                        for (int j = 0; j < 4; ++j) {
                            const u32x4 v = *(const LAS u32x4*)(lds + row * HLP + ck * 64 + j * 16);
                            u32x2 o; int t0 = 0, t1 = 0;
                            t0 = __builtin_amdgcn_cvt_pk_fp8_f32(bf_lo(v.x), bf_hi(v.x), t0, false); t0 = __builtin_amdgcn_cvt_pk_fp8_f32(bf_lo(v.y), bf_hi(v.y), t0, true);
                            t1 = __builtin_amdgcn_cvt_pk_fp8_f32(bf_lo(v.z), bf_hi(v.z), t1, false); t1 = __builtin_amdgcn_cvt_pk_fp8_f32(bf_lo(v.w), bf_hi(v.w), t1, true);
                            o.x = (unsigned)t0; o.y = (unsigned)t1;
                            *(u32x2*)(hg + ((size_t)((e * 64 + ck) * 4 + j) * SCAP + pos) * 8) = o;
                        }
                    }
                }
            }
            __syncthreads();
        }
    }
}

__device__ __forceinline__ void glds16_v(const void* gsrc, unsigned lds_dst) {
    unsigned keep;
    asm volatile("s_mov_b32 %0, m0\n\ts_mov_b32 m0, %2\n\ts_nop 0\n\tglobal_load_lds_dwordx4 %1, off nt\n\ts_mov_b32 m0, %0" : "=&s"(keep) : "v"(gsrc), "s"(lds_dst) : "memory");
}
template <int N> __device__ __forceinline__ void wait_vm() { asm volatile("s_waitcnt vmcnt(%0)" :: "n"(N) : "memory"); }

constexpr int MOE_L0 = 8192;
template <bool UP, int RH> struct K8 {
    static constexpr int KTOT = UP ? D : DE, KC = 32, NCH = KTOT / KC, WLD = UP ? DE : D, WCOLS = 256 / RH;
    static constexpr int S = (RH == 1) ? 3 : 4, DW = S - 1, ROWS = RH * 256, ASZ = ROWS * 32, STG = ASZ + 32 * WCOLS * 4, WP = 4 / RH, NPW = RH;
    static_assert(MOE_L0 + S * STG <= LDS_BYTES - 64, "MoE LDS map");
};
struct MoeCtx { int e, ns, ps, rows, cgi, rh, colw, rot; const char* wsrc; const char* Ablk; };

template <bool UP, int RH>
__device__ __forceinline__ void moe_setup(MoeCtx& c, const Params& p, int l, int e, int ns, int ps, int rows, const char* Ablk) {
    typedef K8<UP, RH> C;
    const int lane = threadIdx.x & 63, wid = __builtin_amdgcn_readfirstlane(threadIdx.x >> 6), r = lane & 31;
    c.e = e; c.ns = ns; c.ps = ps; c.rows = rows; c.Ablk = Ablk;
    if (UP) { if (RH == 1) { c.cgi = wid; c.rh = 0; } else { c.cgi = wid >> 1; c.rh = wid & 1; } c.colw = c.cgi * 16 + ((r >> 4) ? (C::WCOLS / 2 - 16) : 0); }
    else    { if (RH == 1) { c.cgi = wid; c.rh = 0; c.colw = c.cgi * 32; } else { c.cgi = 4 * ps + (wid >> 1); c.rh = wid & 1; c.colw = (wid >> 1) * 32; } }
    if (UP) { const int hl = (RH == 1) ? (lane >> 5) : ((lane >> 4) & 1), cl = (RH == 1) ? (lane & 31) : (lane & 15);
              c.wsrc = (const char*)((hl ? p.in[21] : p.in[20]) + ((size_t)l * NE + e) * D * DE + ns * 128 + (RH == 2 ? ps * 64 : 0) + cl * 4); }
    else c.wsrc = (const char*)(p.in[22] + ((size_t)l * NE + e) * DE * D + ns * 256 + (RH == 2 ? ps * 128 + (lane & 31) * 4 : lane * 4));
    c.wsrc += (size_t)(wid * 4 + (RH == 2 ? (lane >> 5) : 0)) * C::WLD * 4;
    c.rot = (e * 5) & (C::NCH - 1);
}
#define M8_CK(cc) ((((cc) < C::NCH ? (cc) : C::NCH - 1) + c.rot) & (C::NCH - 1))
#define M8_WISSUE(cc, st) do { const unsigned sb_ = ldsbase + (unsigned)(st) * C::STG; const int ck_ = M8_CK(cc); const int live_ = ((cc) < C::NCH) ? RH : 0; \
        _Pragma("unroll") for (int i_ = 0; i_ < C::WP; ++i_) glds16_v((const void*)(c.wsrc + ((size_t)ck_ * C::KC + i_ * live_) * C::WLD * 4), sb_ + wdst + i_ * 1024); } while (0)
template <bool UP, int RH>
__device__ __forceinline__ void moe_early(const MoeCtx& c, ldsp_t lds) {
    typedef K8<UP, RH> C;
    const int wid = __builtin_amdgcn_readfirstlane(threadIdx.x >> 6);
    const unsigned ldsbase = (unsigned)(size_t)lds + (unsigned)MOE_L0;
    const unsigned wdst = (unsigned)C::ASZ + (unsigned)(wid * 4) * (unsigned)(C::WCOLS * 4);
#pragma unroll
    for (int i = 0; i < C::DW - 1; ++i) M8_WISSUE(i, i);
    if constexpr (RH == 2) {
        const int tid = threadIdx.x, w2 = tid & 255, wv = (2 * w2 < c.rows) ? w2 : 0;
        const unsigned off = (unsigned)((tid >> 8) * (SCAP * 8) + wv * 16);
#pragma unroll
        for (int cc = 0; cc < 2; ++cc) {
            const char* ab = c.Ablk + (size_t)M8_CK(cc) * (4 * SCAP * 8) + off;
#pragma unroll
            for (int i = 0; i < C::NPW; ++i) glds16_v((const void*)(ab + i * 2 * (SCAP * 8)), ldsbase + (unsigned)cc * C::STG + (unsigned)wid * 1024u + (unsigned)i * 8192u);
        }
    }
}
template <bool UP, int RH, int NJ, bool GATH>
__device__ __forceinline__ void moe_main(f32x16 (&acc)[8], const MoeCtx& c, ldsp_t lds, const LAS int* rowsS) {
    typedef K8<UP, RH> C;
    constexpr int ROWS = C::ROWS, NPW = C::NPW, WP = C::WP, S = C::S, DW = C::DW, WCOLS = C::WCOLS;
    constexpr float WSC = UP ? 64.f : 32.f;
    const int tid = threadIdx.x, lane = tid & 63, wid = __builtin_amdgcn_readfirstlane(tid >> 6), r = lane & 31, hh = lane >> 5;
    const unsigned ldsbase = (unsigned)(size_t)lds + (unsigned)MOE_L0;
    const unsigned lane16 = (unsigned)lane * 16u, adst = (unsigned)wid * 1024u;
    const unsigned wdst = (unsigned)C::ASZ + (unsigned)(wid * 4) * (unsigned)(WCOLS * 4);
    const unsigned wrd = (unsigned)C::ASZ + (unsigned)((8 * hh) * WCOLS + c.colw + r) * 4u;
    const unsigned ard8 = (unsigned)(hh * (ROWS * 8)) + (unsigned)((32 * c.rh + r) * 8);
    unsigned goff[NPW];
#pragma unroll
    for (int i = 0; i < NPW; ++i) {
        if (GATH) { const int slot = rowsS[tid >> 1]; goff[i] = (unsigned)(UP ? (slot >> 1) : slot) * (unsigned)(UP ? D : DE) + (unsigned)((tid & 1) * 16); }
        else {
            const int w2 = (RH == 1) ? (tid & 127) : (tid & 255), wv = (2 * w2 < c.rows) ? w2 : 0;
            goff[i] = (RH == 1) ? (unsigned)((tid >> 7) * (SCAP * 8) + wv * 16) : (unsigned)((tid >> 8) * (SCAP * 8) + wv * 16 + i * 2 * (SCAP * 8));
        }
    }
    u32x4 ra0[NPW], ra1[NPW];
#define M8_AISSUE(cc, RA) do { const void* ab_ = (const void*)(c.Ablk + (size_t)M8_CK(cc) * (GATH ? 32 : 4 * SCAP * 8)); \
        _Pragma("unroll") for (int i_ = 0; i_ < NPW; ++i_) asm volatile("global_load_dwordx4 %0, %1, %2" : "=v"(RA[i_]) : "v"(goff[i_]), "s"(ab_) : "memory"); } while (0)
#define M8_ALAND(st, RA, N, AOK) do { \
        if (NPW == 1) asm volatile("s_waitcnt vmcnt(%1)" : "+v"(RA[0]) : "n"(N) : "memory"); \
        if (NPW == 2) asm volatile("s_waitcnt vmcnt(%2)" : "+v"(RA[0]), "+v"(RA[NPW > 1 ? 1 : 0]) : "n"(N) : "memory"); \
        if (!(AOK)) { } else \
        if (GATH) { ldsp_t ap_ = lds + MOE_L0 + (st) * C::STG + (unsigned)((tid & 1) * 2 * (ROWS * 8) + (tid >> 1) * 8); \
                    *(LAS u32x2*)(ap_) = (u32x2){RA[0].x, RA[0].y}; *(LAS u32x2*)(ap_ + ROWS * 8) = (u32x2){RA[0].z, RA[0].w}; } \
        else { ldsp_t ap_ = lds + MOE_L0 + (st) * C::STG + adst + lane16; \
               _Pragma("unroll") for (int i_ = 0; i_ < NPW; ++i_) *(LAS u32x4*)(ap_ + i_ * 8192) = RA[i_]; } } while (0)
#define M8_STEP(cq, RAI, RAC, AOK) do { \
        asm volatile("s_waitcnt lgkmcnt(0)" ::: "memory"); \
        __builtin_amdgcn_s_barrier();                       \
        asm volatile("" ::: "memory"); \
        M8_AISSUE((cq) + 2, RAI); \
        { const int sn_ = (st == 0) ? S - 1 : st - 1; M8_WISSUE((cq) + DW, sn_); } \
        { ldsp_t sp = lds + MOE_L0 + st * C::STG; \
          _Pragma("unroll") for (int ks = 0; ks < 2; ++ks) { \
            float w[8]; long af[NJ]; \
            _Pragma("unroll") for (int j = 0; j < 8; ++j) w[j] = *(const LAS float*)(sp + wrd + (ks * 16 + j) * (WCOLS * 4)); \
            _Pragma("unroll") for (int j = 0; j < NJ; ++j) af[j] = *(const LAS long*)(sp + ard8 + ks * (2 * ROWS * 8) + j * (RH * 256)); \
            int lo_ = 0, hi_ = 0; \
            lo_ = __builtin_amdgcn_cvt_pk_fp8_f32(w[0] * WSC, w[1] * WSC, lo_, false); lo_ = __builtin_amdgcn_cvt_pk_fp8_f32(w[2] * WSC, w[3] * WSC, lo_, true); \
            hi_ = __builtin_amdgcn_cvt_pk_fp8_f32(w[4] * WSC, w[5] * WSC, hi_, false); hi_ = __builtin_amdgcn_cvt_pk_fp8_f32(w[6] * WSC, w[7] * WSC, hi_, true); \
            const long wf = (long)(((unsigned long long)(unsigned)hi_ << 32) | (unsigned long long)(unsigned)lo_); \
            _Pragma("unroll") for (int j = 0; j < NJ; ++j) acc[j] = __builtin_amdgcn_mfma_f32_32x32x16_fp8_fp8(wf, af[j], acc[j], 0, 0, 0); } } \
        st = (st == S - 1) ? 0 : st + 1; \
        M8_ALAND(st, RAC, 2 * WP + NPW, AOK);               \
        if (DW == 2) wait_vm<WP + NPW>();                    \
    } while (0)
    int st = 0;
    constexpr bool EARLYA = (RH == 2) && !GATH;
    if constexpr (EARLYA) {
#pragma unroll
        for (int i = 0; i < NPW; ++i) ra1[i] = (u32x4){0u, 0u, 0u, 0u};
        M8_WISSUE(DW - 1, DW - 1);
        wait_vm<WP>();
    } else {
        M8_AISSUE(0, ra0); M8_AISSUE(1, ra1); M8_WISSUE(DW - 1, DW - 1);
        M8_ALAND(0, ra0, NPW + WP, true);
    }
#pragma unroll 1
    for (int cq = 0; cq < C::NCH; cq += 2) {
        M8_STEP(cq, ra0, ra1, !EARLYA || cq > 0);
        M8_STEP(cq + 1, ra1, ra0, true);
    }
    wait_vm<0>();
    asm volatile("s_waitcnt lgkmcnt(0)" ::: "memory");
#undef M8_STEP
#undef M8_ALAND
#undef M8_AISSUE
}
#undef M8_WISSUE
#undef M8_CK

template <bool UP, int RH, bool SRT>
__device__ __forceinline__ void moe_epilogue(const f32x16 (&acc)[8], const MoeCtx& c, const Params& p, const LAS int* rowsS) {
    const int lane = threadIdx.x & 63, hh = lane >> 5;
    int r_e = lane & 31; asm volatile("" : "+v"(r_e));
    const int e = c.e, ns = c.ns, ps = c.ps, rows = c.rows, cgi = c.cgi, rh = c.rh;
    if (UP) {
        const int cis = (RH == 2 ? ps * 64 : 0) + cgi * 16;
        char* actsb = (char*)(p.ws + WS_ACTS) + ((size_t)(e * 16 + ns * 4 + (cis >> 5)) * 4 + ((cis >> 3) & 3)) * (SCAP * 8);
        char* act8 = (char*)(p.ws + WS_ACT);
#pragma unroll
        for (int mt = 0; mt < 8; ++mt) {
            const int row = 32 * (RH * mt + rh) + r_e;
            const int slot = rowsS[row & 511];
#pragma unroll
            for (int q = 0; q < 2; ++q) {
                constexpr float ISC = 1.0f / 64.0f;
                const float a0 = silu_f(acc[mt][q * 4 + 0] * ISC) * (acc[mt][(q + 2) * 4 + 0] * ISC), a1 = silu_f(acc[mt][q * 4 + 1] * ISC) * (acc[mt][(q + 2) * 4 + 1] * ISC);
                const float a2 = silu_f(acc[mt][q * 4 + 2] * ISC) * (acc[mt][(q + 2) * 4 + 2] * ISC), a3 = silu_f(acc[mt][q * 4 + 3] * ISC) * (acc[mt][(q + 2) * 4 + 3] * ISC);
                int t8 = 0; t8 = __builtin_amdgcn_cvt_pk_fp8_f32(a0, a1, t8, false); t8 = __builtin_amdgcn_cvt_pk_fp8_f32(a2, a3, t8, true);
                if (row < rows) {
                    if (SRT) *(int*)(actsb + ((unsigned)(q * (SCAP * 8)) + (unsigned)row * 8u + 4u * (unsigned)hh)) = t8;
                    else *(int*)(act8 + (size_t)slot * DE + ns * 128 + cis + 8 * q + 4 * hh) = t8;
                }
            }
        }
    } else {
        char* O8 = (char*)(p.ws + WS_O);
#pragma unroll
        for (int mt = 0; mt < 8; ++mt) {
            const int row = 32 * (RH * mt + rh) + r_e;
            const int slot = rowsS[row & 511];
            const float gwv = ((const LAS float*)(rowsS + 1024))[row & 511] * (1.0f / 32.0f);
            int t8[4];
#pragma unroll
            for (int q = 0; q < 4; ++q) { int t = 0; t = __builtin_amdgcn_cvt_pk_fp8_f32(acc[mt][q * 4 + 0] * gwv, acc[mt][q * 4 + 1] * gwv, t, false); t = __builtin_amdgcn_cvt_pk_fp8_f32(acc[mt][q * 4 + 2] * gwv, acc[mt][q * 4 + 3] * gwv, t, true); t8[q] = t; }
            const int s0 = hh ? t8[0] : t8[2], s1 = hh ? t8[1] : t8[3];
            const int r0 = __shfl_xor(s0, 32), r1 = __shfl_xor(s1, 32);
            u32x4 o4;
            if (hh) { o4.x = (unsigned)r0; o4.y = (unsigned)t8[2]; o4.z = (unsigned)r1; o4.w = (unsigned)t8[3]; }
            else    { o4.x = (unsigned)t8[0]; o4.y = (unsigned)r0; o4.z = (unsigned)t8[1]; o4.w = (unsigned)r1; }
            if (row < rows) *(u32x4*)(O8 + (size_t)slot * D + ns * 256 + cgi * 32 + 16 * hh) = o4;
        }
    }
}
template <bool UP, int RH, bool GATH>
__device__ __forceinline__ void moe_run(f32x16 (&acc)[8], const MoeCtx& c, ldsp_t lds, const LAS int* rowsS) {
#pragma unroll
    for (int mt = 0; mt < 8; ++mt)
#pragma unroll
        for (int i = 0; i < 16; ++i) acc[mt][i] = 0.f;
    const int nmt = (c.rows + 31) >> 5, njmax = (RH == 2) ? ((nmt + 1) >> 1) : nmt;
    if (njmax <= 4)      moe_main<UP, RH, 4, GATH>(acc, c, lds, rowsS);
    else if (njmax <= 5) moe_main<UP, RH, 5, GATH>(acc, c, lds, rowsS);
    else if (njmax <= 6) moe_main<UP, RH, 6, GATH>(acc, c, lds, rowsS);
    else                 moe_main<UP, RH, 8, GATH>(acc, c, lds, rowsS);
}

template <bool UP>
__device__ __forceinline__ void phase_moe(const Params& p, ldsp_t lds, int l) {
    constexpr int NSL2 = UP ? 8 : 16, NUN = NE * NSL2;
    const int tid = threadIdx.x, G = gridDim.x;
    const int* CNT = (const int*)(p.ws + WS_CTL + CTL_CNT) + l * NE; const int* LIST = (const int*)(p.ws + WS_LIST);
    const char* Agat = UP ? (const char*)(p.ws + WS_H) : (const char*)(p.ws + WS_ACT);
    LAS int* rowsS = (LAS int*)lds;
    const int vid = *(const LAS int*)(lds + LDS_BYTES - 32);
    LAS int* perm = (LAS int*)(lds + LDS_BYTES - 64 - 256);
    __syncthreads();
    if (tid < 64) {
        const int cj = CNT[tid];
        int rank = 0;
#pragma unroll
        for (int i = 0; i < 64; ++i) { const int ci = __builtin_amdgcn_readlane(cj, i); rank += (ci > cj || (ci == cj && i < tid)) ? 1 : 0; }
        const int t = rank >> 3, pos = rank & 7;
        perm[((t & 1) ? 7 - pos : pos) * 8 + t] = tid;
    }
    __syncthreads();
#define MOE_SLOT(s_) (UP ? ((s_) < 4 ? (s_) : 11 - (s_)) : ((s_) ^ (((s_) >> 1) & 1)))
#define MOE_UNIT(u, e_, ns_, ps_, cnt_) do { const int xq_ = (u) & 7, jq_ = (u) >> 3, sub_ = jq_ % NSL2, sl_ = jq_ / NSL2; e_ = perm[xq_ * 8 + MOE_SLOT(sl_)]; ns_ = sub_ >> 1; ps_ = sub_ & 1; cnt_ = CNT[e_]; } while (0)
#define MOE_ROWS(buf, e_, m0_, rows_) do { const int sl_ = LIST[(e_) * T + (m0_) + (tid < (rows_) ? tid : 0)]; rowsS[(buf) * 512 + tid] = sl_; \
        if (!UP) ((LAS float*)(rowsS + 1024))[(buf) * 512 + tid] = ((const float*)(p.ws + WS_GW))[sl_]; } while (0)
#define MOE_ASRT(e_) ((const char*)(p.ws + (UP ? WS_HG : WS_ACTS) + (size_t)(e_) * (UP ? 64 : 16) * (4 * SCAP * 8)))
    int u = vid, e = 0, ns = 0, ps = 0, cnt = 0;
    while (u < NUN) { MOE_UNIT(u, e, ns, ps, cnt); if (cnt > 0) break; u += G; }
    if (u >= NUN) return;
    int buf = 0;
    MoeCtx ctx;
    { const int rows = cnt < SCAP ? cnt : SCAP; __syncthreads(); MOE_ROWS(buf, e, 0, rows); moe_setup<UP, 2>(ctx, p, l, e, ns, ps, rows, MOE_ASRT(e)); wait_vm<0>(); moe_early<UP, 2>(ctx, lds); }
    for (;;) {
        int un = u + G, en = 0, nsn = 0, psn = 0, cntn = 0;
        while (un < NUN) { MOE_UNIT(un, en, nsn, psn, cntn); if (cntn > 0) break; un += G; }
        const bool haven = un < NUN;
        f32x16 acc[8];
        moe_run<UP, 2, false>(acc, ctx, lds, rowsS + buf * 512);
        __syncthreads();
        MoeCtx nctx = ctx;
        const bool chain = haven && cnt <= SCAP;
        if (chain) { const int rows = cntn < SCAP ? cntn : SCAP; MOE_ROWS(buf ^ 1, en, 0, rows); moe_setup<UP, 2>(nctx, p, l, en, nsn, psn, rows, MOE_ASRT(en)); moe_early<UP, 2>(nctx, lds); }
        moe_epilogue<UP, 2, true>(acc, ctx, p, rowsS + buf * 512);
        if (cnt > SCAP) {
#pragma unroll 1
            for (int m0 = SCAP; m0 < cnt; m0 += 256) {
                const int rows = (cnt - m0 < 256) ? (cnt - m0) : 256;
                __syncthreads();
                MOE_ROWS(buf, e, m0, rows);
                __syncthreads();
                if (ps == 0) {
                    MoeCtx fc; moe_setup<UP, 1>(fc, p, l, e, ns, 0, rows, Agat);
                    wait_vm<0>(); moe_early<UP, 1>(fc, lds);
                    moe_run<UP, 1, true>(acc, fc, lds, rowsS + buf * 512);
                    __syncthreads();
                    moe_epilogue<UP, 1, false>(acc, fc, p, rowsS + buf * 512);
                }
            }
        }
        if (!haven) break;
        if (!chain) { const int rows = cntn < SCAP ? cntn : SCAP; __syncthreads(); MOE_ROWS(buf ^ 1, en, 0, rows); moe_setup<UP, 2>(nctx, p, l, en, nsn, psn, rows, MOE_ASRT(en)); wait_vm<0>(); moe_early<UP, 2>(nctx, lds); }
        ctx = nctx; u = un; e = en; ns = nsn; ps = psn; cnt = cntn; buf ^= 1;
    }
#undef MOE_ASRT
#undef MOE_ROWS
#undef MOE_UNIT
#undef MOE_SLOT
}
}

#ifndef MK_KIND_MASK
#define MK_KIND_MASK 0x3ff
#endif
#define KIND(k) (((MK_KIND_MASK) >> (k)) & 1)
#ifndef MK_REP_MASK
#define MK_REP_MASK 0
#endif
#define NREP(k) (1 + (((MK_REP_MASK) >> (k)) & 1))
namespace mk {
constexpr int N_PHASES = 20;
constexpr int LDS_MISC = LDS_BYTES - 64;

#ifdef MK_STREAMTEST
__device__ __forceinline__ void phase_streamtest(const Params& p) {
    const int tid = threadIdx.x, w = blockIdx.x;
    const float* base = p.in[20];
    float4 acc = make_float4(0.f, 0.f, 0.f, 0.f);
    if (MK_STREAMTEST == 1) {
        const float4* src = (const float4*)(base + (size_t)w * 262144) + tid;
#pragma unroll 8
        for (int i = 0; i < 128; ++i) { const float4 v = src[(size_t)i * 512]; acc.x += v.x; acc.y += v.y; acc.z += v.z; acc.w += v.w; }
    } else {
        const int e = w >> 2, ns = w & 3;
        const float4* src = (const float4*)(base + (size_t)e * D * DE + ns * 128 + (size_t)(tid >> 5) * DE) + (tid & 31);
#pragma unroll 8
        for (int i = 0; i < 128; ++i) { const float4 v = src[(size_t)i * 16 * DE / 4]; acc.x += v.x; acc.y += v.y; acc.z += v.z; acc.w += v.w; }
    }
    const float s = acc.x + acc.y + acc.z + acc.w;
    if (s != s) ((float*)(p.ws + WS_END))[tid] = s;
}
#endif
struct SkipZOrder : pg8::StaticOrder {
    __device__ bool next(int i, pg8::Unit& u) const {
        const long L = (long)i * G + c;
        if (L < 480) { if (!pg8::StaticOrder::next(i, u)) return false; if (u.pn >= 8) u.pn += 4; return true; }
        if (L < 512) { const int z = (int)L - 480; u.pm = z >> 2; u.pn = 8 + (z & 3); return true; }
        return false;
    }
};
struct OneUnitOrder {
    int pm, pn;
    __device__ bool next(int i, pg8::Unit& u) const { if (i) return false; u.pm = pm; u.pn = pn; return true; }
    __device__ __forceinline__ void a_ready(const pg8::Unit&) const {}
    __device__ __forceinline__ void done(const pg8::Unit&) const {}
};
template <int L>
__device__ __forceinline__ void run_layer(const Params& p, ldsp_t lds, const XcdBarrier& bar, int lo, int hi) {
    constexpr int PB = 1 + 9 * L;
#define IN(k) (lo <= (k) && (k) < hi)
#define SEAM(k) do { if (IN(k) && IN((k) + 1)) xcd_barrier(bar); } while (0)
    if (KIND(1) && IN(PB + 0)) { if (L == 0) { { phase_norm<0>(p, 0); if constexpr ((NREP(1)) > 1) { __syncthreads(); phase_norm<0>(p, 0); __syncthreads(); } } } else phase_norm<1>(p, L); }
    SEAM(PB + 0);
    if (KIND(2) && IN(PB + 1)) {
        pg8::Gemm g{(const pg8::bf16_t*)(p.ws + WS_H), (const pg8::bf16_t*)(p.ws + WS_WTIN) + (size_t)L * NPAD * D, T, NPAD, D};
        SkipZOrder So; So.init(T, NPAD - 1024, (int)gridDim.x, (int)blockIdx.x);
        EpiProj E{(bf16_t*)(p.ws + WS_PROJ), (float*)(p.ws + WS_DT), p.in[12] + L * SH};
        { pg8::gemm_phase<EpiProj, SkipZOrder, true, true>((PG8_LAS unsigned char*)lds, g, So, E); if constexpr ((NREP(2)) > 1) { __syncthreads(); pg8::gemm_phase<EpiProj, SkipZOrder, true, true>((PG8_LAS unsigned char*)lds, g, So, E); __syncthreads(); } }
    }
    SEAM(PB + 1);
    if (KIND(3) && IN(PB + 2)) {
        auto zgemm = [&](int zu) {
            pg8::Gemm g{(const pg8::bf16_t*)(p.ws + WS_H), (const pg8::bf16_t*)(p.ws + WS_WTIN) + (size_t)L * NPAD * D, T, NPAD, D};
            OneUnitOrder So{zu >> 2, 8 + (zu & 3)};
            EpiProj E{(bf16_t*)(p.ws + WS_PROJ), (float*)(p.ws + WS_DT), p.in[12] + L * SH};
            pg8::gemm_phase<EpiProj, OneUnitOrder, true, true>((PG8_LAS unsigned char*)lds, g, So, E);
        };
        phase_mix(p, lds, L, zgemm); if constexpr ((NREP(3)) > 1) { __syncthreads(); phase_mix(p, lds, L, zgemm); __syncthreads(); }
    }
    SEAM(PB + 2);
    if (KIND(4) && IN(PB + 3)) { phase_scan(p); if constexpr ((NREP(4)) > 1) { __syncthreads(); phase_scan(p); __syncthreads(); } }
    SEAM(PB + 3);
    if (KIND(5) && IN(PB + 4)) { phase_yoff(p, lds, L); if constexpr ((NREP(5)) > 1) { __syncthreads(); phase_yoff(p, lds, L); __syncthreads(); } }
    SEAM(PB + 4);
    if (KIND(6) && IN(PB + 5)) {
        pg8::Gemm g{(const pg8::bf16_t*)(p.ws + WS_YMIX), (const pg8::bf16_t*)(p.ws + WS_WTOUT) + (size_t)L * D * D, T, D, D};
        pg8::StaticOrder So; So.init(T, D, (int)gridDim.x, (int)blockIdx.x);
        EpiRes<(L == 0)> E{(L == 0) ? p.in[0] : (const float*)nullptr, (bf16_t*)(p.ws + WS_X), (const float*)(p.ws + WS_ADA) + (size_t)L * NB * 6 * D + 2 * D};
        { pg8::gemm_phase<EpiRes<(L == 0)>, pg8::StaticOrder, true, true>((PG8_LAS unsigned char*)lds, g, So, E); if constexpr (((L == 0 ? NREP(6) : 1)) > 1) { __syncthreads(); pg8::gemm_phase<EpiRes<(L == 0)>, pg8::StaticOrder, true, true>((PG8_LAS unsigned char*)lds, g, So, E); __syncthreads(); } }
    }
    SEAM(PB + 5);
    if (KIND(7) && IN(PB + 6)) { phase_router(p, lds, L); if constexpr ((NREP(7)) > 1) { __syncthreads(); phase_router(p, lds, L, true); __syncthreads(); } }
    SEAM(PB + 6);
    if (KIND(8) && IN(PB + 7)) { phase_moe<true>(p, lds, L); if constexpr ((NREP(8)) > 1) { __syncthreads(); phase_moe<true>(p, lds, L); __syncthreads(); } }
    SEAM(PB + 7);
    if (KIND(9) && IN(PB + 8)) { phase_moe<false>(p, lds, L); if constexpr ((NREP(9)) > 1) { __syncthreads(); phase_moe<false>(p, lds, L); __syncthreads(); } }
    SEAM(PB + 8);
#undef IN
#undef SEAM
}

__global__ void __launch_bounds__(NT, 2) mk_fwd(Params p) {
    extern __shared__ __attribute__((aligned(16))) unsigned char lds_raw[];
    ldsp_t lds = (ldsp_t)lds_raw;
    const int lo = p.ph_lo, hi = p.ph_hi;
    volatile LAS unsigned* misc = (volatile LAS unsigned*)(lds + LDS_MISC);
    if (threadIdx.x < 16) misc[threadIdx.x] = 0u;
    __syncthreads();
    XcdBarrier bar; bar.bar = (unsigned*)(p.ws + WS_CTL); bar.x = 0; bar.st = misc;
    if (hi - lo > 1) bar = xcd_barrier_post((unsigned*)(p.ws + WS_CTL), misc);
    if (threadIdx.x == 0) { const unsigned myx = xb_xcc_id() & 7u; misc[9] = myx; misc[10] = __hip_atomic_fetch_add((unsigned*)(p.ws + WS_CTL + CTL_CNT + 4096) + myx * 16 + (lo > 0 ? 8 : 0), 1u, __ATOMIC_RELAXED, __HIP_MEMORY_SCOPE_AGENT); misc[8] = blockIdx.x; }
#ifdef MK_STREAMTEST
    if (lo <= 0) { phase_streamtest(p); __syncthreads(); }
#endif
    if (KIND(0) && lo <= 0 && 0 < hi) { phase_prologue(p, lds, 2, (int)blockIdx.x, (int)gridDim.x); if constexpr ((NREP(0)) > 1) { __syncthreads(); phase_prologue(p, lds, 2, (int)blockIdx.x, (int)gridDim.x); __syncthreads(); } }
    if (lo <= 0 && 1 < hi) xcd_barrier(bar);
    if (hi - lo > 1 && threadIdx.x == 0) {
        bool even = (gridDim.x & 7u) == 0u;
        for (int j = 0; j < 16; ++j) { const unsigned c = xb_ld(&bar.bar[XB_XCNT(j)]); if (c != ((j < 8) ? gridDim.x / 8u : 0u)) even = false; }
        if (even) misc[8] = misc[9] + 8u * misc[10];
    }
    __syncthreads();
    run_layer<0>(p, lds, bar, lo, hi);
#ifdef MK_XBAR
    for (int xb = 0; xb < MK_XBAR; ++xb) xcd_barrier(bar);
#endif
    run_layer<1>(p, lds, bar, lo, hi);
    if (KIND(1) && lo <= 19 && 19 < hi) { phase_norm<2>(p, 1); if constexpr ((NREP(1)) > 1) { __syncthreads(); phase_norm<2>(p, 1); __syncthreads(); } }
}
}

extern "C" void kernel_launch(void* const* d_in, const int* in_sizes, int n_in, void* d_out, int out_size, void* d_ws, size_t ws_size, hipStream_t stream) {
    using namespace mk;
    static int grid = 0;
    if (grid == 0) {
        if (n_in != 24 || ws_size < WS_END) { fprintf(stderr, "kernel_launch: unexpected inputs (n_in %d, ws %zu < %zu)\n", n_in, ws_size, (size_t)WS_END); grid = -1; return; }
        int dev = 0, cus = 0, per_cu = 0;
        if (hipGetDevice(&dev) != hipSuccess || hipDeviceGetAttribute(&cus, hipDeviceAttributeMultiprocessorCount, dev) != hipSuccess) { grid = -1; return; }
        if (hipFuncSetAttribute((const void*)mk_fwd, hipFuncAttributeMaxDynamicSharedMemorySize, LDS_BYTES) != hipSuccess) { fprintf(stderr, "kernel_launch: hipFuncSetAttribute failed\n"); grid = -1; return; }
        if (hipOccupancyMaxActiveBlocksPerMultiprocessor(&per_cu, (const void*)mk_fwd, NT, LDS_BYTES) != hipSuccess || per_cu < 1) fprintf(stderr, "kernel_launch: occupancy query says %d\n", per_cu);
        (void)hipGetLastError();
        grid = cus;
    }
    if (grid < 0) return;
    (void)in_sizes; (void)out_size;
    if (hipMemsetAsync((char*)d_ws + WS_CTL, 0, CTL_BYTES, stream) != hipSuccess) return;
    Params prm{};
    for (int i = 0; i < 24; ++i) prm.in[i] = (const float*)d_in[i];
    prm.out = (float*)d_out; prm.ws = (unsigned char*)d_ws;
#if MK_N_LAUNCHES == 1
    prm.ph_lo = 0; prm.ph_hi = N_PHASES;
    hipLaunchKernelGGL(mk_fwd, dim3(grid), dim3(NT), LDS_BYTES, stream, prm);
#else
    for (int k = 0; k < N_PHASES; ++k) { prm.ph_lo = k; prm.ph_hi = k + 1; hipLaunchKernelGGL(mk_fwd, dim3(grid), dim3(NT), LDS_BYTES, stream, prm); }
#endif
    const hipError_t le = hipPeekAtLastError();
    if (le != hipSuccess) fprintf(stderr, "kernel_launch: launch failed: %s\n", hipGetErrorName(le));
}
```
